# Optimizing an MI355X kernel written in HIP

```python
import jax, jax.numpy as jnp
from jax import lax
import numpy as np

D_MODEL = 1024
BATCH = 2
SEQ = 8192
DEPTH = 1

D_MIX = D_MODEL
NSA_HEADS = 8
NSA_KV_HEADS = 2
NSA_HEAD_DIM = 64
NSA_WIDTH = NSA_HEADS * NSA_HEAD_DIM
NSA_KV_WIDTH = NSA_KV_HEADS * NSA_HEAD_DIM
CMP_LEN = 32
CMP_STRIDE = 16
CMP_HIDDEN = 2 * NSA_HEAD_DIM
SLC_BLOCK = 64
SLC_TOPN = 16
WINDOW = 512
Q_BLOCK = 128
HG_HEADS = 4
HG_KEY_DIM = 128
HG_VAL_DIM = 128
HG_WIDTH = HG_HEADS * HG_VAL_DIM
HG_CHUNK = 64
ROPE_THETA = 500000.0
ROT_DIM = NSA_HEAD_DIM // 4
D_FF = 4 * D_MODEL
EPS = 1e-6
NEG = -1e30
IN_SPLITS = (NSA_WIDTH, NSA_KV_WIDTH, NSA_KV_WIDTH, NSA_KV_WIDTH, NSA_KV_WIDTH,
             NSA_KV_WIDTH, NSA_KV_WIDTH, NSA_HEADS * 3,
             HG_HEADS * HG_KEY_DIM, HG_HEADS * HG_KEY_DIM, HG_WIDTH, HG_WIDTH)
D_IN = sum(IN_SPLITS)

kernel_name = 'hymba_nsa_hgrn2_block'


def rms_norm(x, gain):
    xf = x.astype(jnp.float32)
    y = xf * lax.rsqrt(jnp.mean(xf * xf, axis=-1, keepdims=True) + EPS)
    return (y * gain.astype(jnp.float32)).astype(x.dtype)


def rope(x, cos, sin):
    half = ROT_DIM // 2
    c, s = cos.astype(x.dtype), sin.astype(x.dtype)
    x1, x2 = x[..., :half], x[..., half:ROT_DIM]
    return jnp.concatenate([x1 * c - x2 * s, x2 * c + x1 * s, x[..., ROT_DIM:]], axis=-1)


def masked_softmax(s, mask):
    return jax.nn.softmax(jnp.where(mask, s, NEG), axis=-1) * mask


def cmp_to_slc_matrix(n_cmp, n_slc):
    tok = np.arange(n_cmp)[:, None] * CMP_STRIDE + np.arange(CMP_LEN)[None, :]
    blk = tok // SLC_BLOCK
    return (blk[:, :, None] == np.arange(n_slc)[None, None, :]).mean(axis=1).astype(np.float32)


def nsa_mixer(q, kc, vc, ks, vs, kw, vw, gates, q_gain, k_gain,
              pe_k, w1_k, w2_k, pe_v, w1_v, w2_v, cos, sin):
    B, S, _ = q.shape
    G, HPG, DK = NSA_KV_HEADS, NSA_HEADS // NSA_KV_HEADS, NSA_HEAD_DIM
    dtype = q.dtype
    q = q.reshape(B, S, G, HPG, DK).transpose(0, 2, 3, 1, 4)
    q = rope(rms_norm(q, q_gain), cos, sin)

    def kv_heads(t):
        return t.reshape(B, S, G, DK).transpose(0, 2, 1, 3)

    def prep_k(t):
        return rope(rms_norm(kv_heads(t), k_gain), cos, sin)

    kc, ks, kw = prep_k(kc), prep_k(ks), prep_k(kw)
    vc, vs, vw = kv_heads(vc), kv_heads(vs), kv_heads(vw)
    gates = jax.nn.sigmoid(gates.astype(jnp.float32)).reshape(B, S, G, HPG, 3).transpose(0, 2, 3, 1, 4)

    n_cmp = (S - CMP_LEN) // CMP_STRIDE + 1
    tok_idx = jnp.arange(n_cmp)[:, None] * CMP_STRIDE + jnp.arange(CMP_LEN)[None, :]

    def compress(t, pe, w1, w2):
        blocks = t[:, :, tok_idx] + pe
        flat = blocks.reshape(B, G, n_cmp, CMP_LEN * DK)
        return jax.nn.silu(flat @ w1) @ w2

    kc = compress(kc, pe_k, w1_k, w2_k)
    vc = compress(vc, pe_v, w1_v, w2_v)
    cmp_end = jnp.arange(n_cmp) * CMP_STRIDE + CMP_LEN - 1

    n_slc = S // SLC_BLOCK
    n_top = min(SLC_TOPN, n_slc)
    ks_blocks = ks.reshape(B, G, n_slc, SLC_BLOCK, DK)
    vs_blocks = vs.reshape(B, G, n_slc, SLC_BLOCK, DK)
    slc_map = jnp.asarray(cmp_to_slc_matrix(n_cmp, n_slc))
    kw_pad = jnp.pad(kw, ((0, 0), (0, 0), (WINDOW, 0), (0, 0)))
    vw_pad = jnp.pad(vw, ((0, 0), (0, 0), (WINDOW, 0), (0, 0)))
    scale = DK ** -0.5
    gather = jax.vmap(jax.vmap(lambda blocks, ix: blocks[ix]))
    j_blk = jnp.arange(n_slc)

    def block_fn(blk):
        q0 = blk * Q_BLOCK
        qb = lax.dynamic_slice_in_dim(q, q0, Q_BLOCK, axis=3)
        gb = lax.dynamic_slice_in_dim(gates, q0, Q_BLOCK, axis=3)
        t = q0 + jnp.arange(Q_BLOCK)
        s = jnp.einsum('bghqd,bgnd->bghqn', qb, kc).astype(jnp.float32) * scale
        p_cmp = masked_softmax(s, cmp_end[None, :] <= t[:, None])
        o_cmp = jnp.einsum('bghqn,bgnd->bghqd', p_cmp.astype(dtype), vc)
        imp = jnp.einsum('bghqn,nj->bgqj', p_cmp, slc_map)
        cur = t // SLC_BLOCK
        forced = (j_blk[None, :] == 0) | (j_blk[None, :] == cur[:, None]) | (j_blk[None, :] == cur[:, None] - 1)
        valid = j_blk[None, :] <= cur[:, None]
        imp = jnp.where(forced, jnp.inf, jnp.where(valid, imp, -jnp.inf))
        _, idx = lax.top_k(imp, n_top)
        k_sel = gather(ks_blocks, idx).reshape(B, G, Q_BLOCK, n_top * SLC_BLOCK, DK)
        v_sel = gather(vs_blocks, idx).reshape(B, G, Q_BLOCK, n_top * SLC_BLOCK, DK)
        pos = (idx[..., None] * SLC_BLOCK + jnp.arange(SLC_BLOCK)).reshape(B, G, Q_BLOCK, n_top * SLC_BLOCK)
        s = jnp.einsum('bghqd,bgqkd->bghqk', qb, k_sel).astype(jnp.float32) * scale
        p = masked_softmax(s, (pos <= t[:, None])[:, :, None])
        o_slc = jnp.einsum('bghqk,bgqkd->bghqd', p.astype(dtype), v_sel)
        kwb = lax.dynamic_slice_in_dim(kw_pad, q0, Q_BLOCK + WINDOW, axis=2)
        vwb = lax.dynamic_slice_in_dim(vw_pad, q0, Q_BLOCK + WINDOW, axis=2)
        kpos = q0 - WINDOW + jnp.arange(Q_BLOCK + WINDOW)
        wmask = (kpos[None, :] <= t[:, None]) & (kpos[None, :] > t[:, None] - WINDOW) & (kpos[None, :] >= 0)
        s = jnp.einsum('bghqd,bgkd->bghqk', qb, kwb).astype(jnp.float32) * scale
        p = masked_softmax(s, wmask)
        o_win = jnp.einsum('bghqk,bgkd->bghqd', p.astype(dtype), vwb)
        return (gb[..., 0:1] * o_cmp + gb[..., 1:2] * o_slc + gb[..., 2:3] * o_win).astype(dtype)

    out = lax.map(block_fn, jnp.arange(S // Q_BLOCK))
    return out.transpose(1, 0, 4, 2, 3, 5).reshape(B, S, NSA_WIDTH)


def hgrn2_mixer(q, f_logit, i, g, lb, out_gain):
    B, S, _ = q.shape
    H, DK, DV, C = HG_HEADS, HG_KEY_DIM, HG_VAL_DIM, HG_CHUNK
    n_chunk = S // C
    lbf = lb.astype(jnp.float32)
    f = lbf + (1.0 - lbf) * jax.nn.sigmoid(f_logit.astype(jnp.float32))
    logf = jnp.log(f)
    k = 1.0 - f
    qf = jax.nn.silu(q.astype(jnp.float32))
    v = i.astype(jnp.float32)

    def chunks(t, d):
        return t.reshape(B, n_chunk, C, H, d).transpose(1, 0, 3, 2, 4)

    causal = jnp.tril(jnp.ones((C, C), bool))

    def step(state, xs):
        qc, kc, vc, lc = xs
        bc = jnp.cumsum(lc, axis=2)
        diff = jnp.where(causal[:, :, None], bc[:, :, :, None, :] - bc[:, :, None, :, :], -jnp.inf)
        a = jnp.einsum('bhtd,bhsd,bhtsd->bhts', qc, kc, jnp.exp(diff))
        o = jnp.einsum('bhtd,bhdv->bhtv', qc * jnp.exp(bc), state) + jnp.einsum('bhts,bhsv->bhtv', a, vc)
        b_last = bc[:, :, -1:, :]
        state = jnp.exp(b_last[:, :, 0, :])[..., None] * state + jnp.einsum('bhsd,bhsv->bhdv', kc * jnp.exp(b_last - bc), vc)
        return state, o

    s0 = jnp.zeros((B, H, DK, DV), jnp.float32)
    _, o = lax.scan(step, s0, (chunks(qf, DK), chunks(k, DK), chunks(v, DV), chunks(logf, DK)))
    o = o.transpose(1, 0, 3, 2, 4).reshape(B, S, H, DV)
    o = rms_norm(o, out_gain) * jax.nn.silu(g.astype(jnp.float32).reshape(B, S, H, DV))
    return o.reshape(B, S, HG_WIDTH).astype(q.dtype)


def setup_inputs(seed: int = 0) -> dict:
    key = jax.random.key(seed)
    ks = jax.random.split(key, 18)
    f32 = jnp.float32

    def w(k, shape, fan_in):
        return jax.random.normal(k, shape, f32) * fan_in ** -0.5

    def gain(k, shape):
        return 1.0 + 0.02 * jax.random.normal(k, shape, f32)

    L = DEPTH
    return {
        'x': jax.random.normal(ks[0], (BATCH, SEQ, D_MODEL), f32),
        'attn_norm': gain(ks[1], (L, D_MODEL)),
        'w_in': w(ks[2], (L, D_MODEL, D_IN), D_MODEL),
        'q_norm': gain(ks[3], (L, NSA_HEAD_DIM)),
        'k_norm': gain(ks[4], (L, NSA_HEAD_DIM)),
        'cmp_pe_k': 0.02 * jax.random.normal(ks[5], (L, CMP_LEN, NSA_HEAD_DIM), f32),
        'cmp_w1_k': w(ks[6], (L, CMP_LEN * NSA_HEAD_DIM, CMP_HIDDEN), CMP_LEN * NSA_HEAD_DIM),
        'cmp_w2_k': w(ks[7], (L, CMP_HIDDEN, NSA_HEAD_DIM), CMP_HIDDEN),
        'cmp_pe_v': 0.02 * jax.random.normal(ks[8], (L, CMP_LEN, NSA_HEAD_DIM), f32),
        'cmp_w1_v': w(ks[9], (L, CMP_LEN * NSA_HEAD_DIM, CMP_HIDDEN), CMP_LEN * NSA_HEAD_DIM),
        'cmp_w2_v': w(ks[10], (L, CMP_HIDDEN, NSA_HEAD_DIM), CMP_HIDDEN),
        'nsa_out_norm': gain(ks[11], (L, NSA_WIDTH)),
        'hgrn_lb': 0.5 * jax.random.normal(ks[12], (L + 1, HG_HEADS * HG_KEY_DIM), f32),
        'hgrn_out_norm': gain(ks[13], (L, HG_VAL_DIM)),
        'w_out': w(ks[14], (L, D_MIX, D_MODEL), D_MIX),
        'mlp_norm': gain(ks[15], (L, D_MODEL)),
        'w_mlp_in': w(ks[16], (L, D_MODEL, D_FF), D_MODEL),
        'w_mlp_out': w(ks[17], (L, D_FF, D_MODEL), D_FF),
    }


def reference(x, attn_norm, w_in, q_norm, k_norm, cmp_pe_k, cmp_w1_k, cmp_w2_k,
              cmp_pe_v, cmp_w1_v, cmp_w2_v, nsa_out_norm, hgrn_lb, hgrn_out_norm,
              w_out, mlp_norm, w_mlp_in, w_mlp_out):
    B, S, _ = x.shape
    pos = jnp.arange(S, dtype=jnp.float32)
    inv_freq = ROPE_THETA ** (-jnp.arange(0, ROT_DIM, 2, dtype=jnp.float32) / ROT_DIM)
    ang = pos[:, None] * inv_freq[None, :]
    cos, sin = jnp.cos(ang), jnp.sin(ang)
    lb_all = jnp.cumsum(jax.nn.softmax(hgrn_lb.astype(jnp.float32), axis=0), axis=0)
    split_at = [int(v) for v in np.cumsum(IN_SPLITS)[:-1]]
    for l in range(DEPTH):
        h = rms_norm(x, attn_norm[l])
        proj = h @ w_in[l]
        (nq, nkc, nvc, nks, nvs, nkw, nvw, ngate, hq, hf, hi, hg) = jnp.split(proj, split_at, axis=-1)
        y_nsa = nsa_mixer(nq, nkc, nvc, nks, nvs, nkw, nvw, ngate, q_norm[l], k_norm[l],
                          cmp_pe_k[l], cmp_w1_k[l], cmp_w2_k[l], cmp_pe_v[l], cmp_w1_v[l], cmp_w2_v[l],
                          cos, sin)
        y_nsa = rms_norm(y_nsa, nsa_out_norm[l])
        y_hg = hgrn2_mixer(hq, hf, hi, hg, lb_all[l], hgrn_out_norm[l])
        x = x + jnp.concatenate([y_nsa, y_hg], axis=-1) @ w_out[l]
        h = rms_norm(x, mlp_norm[l])
        x = x + jnp.square(jax.nn.relu(h @ w_mlp_in[l])) @ w_mlp_out[l]
    return x
```

```cpp
#include <hip/hip_runtime.h>
#include <hip/hip_cooperative_groups.h>
#include <cstdio>
#include <cstdint>
#include <cmath>
namespace cg = cooperative_groups;

#define LAS __attribute__((address_space(3)))
typedef _Float16 h16;
typedef _Float16 h16x2 __attribute__((ext_vector_type(2)));
typedef _Float16 h16x4 __attribute__((ext_vector_type(4)));
typedef _Float16 h16x8 __attribute__((ext_vector_type(8)));
typedef __bf16 b16x2 __attribute__((ext_vector_type(2)));
typedef __bf16 b16x8 __attribute__((ext_vector_type(8)));
typedef short s16x8 __attribute__((ext_vector_type(8)));
typedef short s16x4 __attribute__((ext_vector_type(4)));
typedef float f32x2 __attribute__((ext_vector_type(2)));
typedef float f32x4 __attribute__((ext_vector_type(4)));
typedef float f32x16 __attribute__((ext_vector_type(16)));
typedef unsigned u32x2 __attribute__((ext_vector_type(2)));
typedef unsigned u32x4 __attribute__((ext_vector_type(4)));
typedef unsigned short u16;

__device__ __forceinline__ unsigned pkh(float lo, float hi) { f32x2 v = {lo, hi}; h16x2 h = __builtin_convertvector(v, h16x2); return __builtin_bit_cast(unsigned, h); }
__device__ __forceinline__ unsigned pkb(float lo, float hi) { f32x2 v = {lo, hi}; b16x2 h = __builtin_convertvector(v, b16x2); return __builtin_bit_cast(unsigned, h); }
__device__ __forceinline__ float h2f(u16 v) { return (float)__builtin_bit_cast(h16, v); }
__device__ __forceinline__ float b2f(u16 v) { return __builtin_bit_cast(float, (unsigned)v << 16); }
__device__ __forceinline__ u16 f2h(float f) { return __builtin_bit_cast(u16, (h16)f); }
__device__ __forceinline__ u16 f2b(float f) { return (u16)(pkb(f, 0.f) & 0xffffu); }
__device__ __forceinline__ float wave_sum(float v) {
#pragma unroll
    for (int o = 1; o < 64; o <<= 1) v += __shfl_xor(v, o);
    return v;
}
__device__ __forceinline__ float sigmoid_f(float x) { return __builtin_amdgcn_rcpf(1.f + __expf(-x)); }

constexpr int BATCH = 2, SEQ = 8192, DM = 1024, MT = BATCH * SEQ, DIN = 3352, DINP = 3584, FF = 4096;
constexpr int NG = 2, HPG = 4, HD = 64, NQH = 8;
constexpr int NCMP = 511, NSLC = 128, NTOP = 16, WINDOW = 512;
constexpr int HGH = 4, HGD = 128;
constexpr float EPS = 1e-6f;
constexpr int C_Q = 0, C_KC = 512, C_VC = 640, C_KS = 768, C_VS = 896, C_KW = 1024, C_VW = 1152, C_GATE = 1280,
              C_HQ = 1304, C_HF = 1816, C_HI = 2328, C_HG = 2840;

constexpr size_t MiB = 1u << 20;
constexpr size_t WS_CTL = 0;
constexpr size_t WS_WIN_T = 1 * MiB;
constexpr size_t WS_WOUT_T = 8 * MiB;
constexpr size_t WS_W1_T = 10 * MiB;
constexpr size_t WS_W2_T = 18 * MiB;
constexpr size_t WS_CW1K_T = 26 * MiB;
constexpr size_t WS_CW1V_T = 26 * MiB + 512 * 1024;
constexpr size_t WS_CW2K_T = 27 * MiB;
constexpr size_t WS_CW2V_T = 27 * MiB + 16 * 1024;
constexpr size_t WS_PEK = 27 * MiB + 32 * 1024;
constexpr size_t WS_PEV = 27 * MiB + 40 * 1024;
constexpr size_t WS_LB = 27 * MiB + 48 * 1024;
constexpr size_t WS_ROPE = 27 * MiB + 256 * 1024;
constexpr size_t WS_XH = 28 * MiB;
constexpr size_t WS_HL = 28 * MiB;
constexpr size_t WS_X1H = 28 * MiB;
constexpr size_t WS_Q = 60 * MiB;
constexpr size_t WS_KC = 76 * MiB;
constexpr size_t WS_KS = 80 * MiB;
constexpr size_t WS_KW = 84 * MiB;
constexpr size_t WS_VC = 88 * MiB;
constexpr size_t WS_VST = 92 * MiB;
constexpr size_t WS_VWT = 96 * MiB;
constexpr size_t WS_GATES = 100 * MiB;
constexpr size_t WS_KCMP = 101 * MiB + 512 * 1024;
constexpr size_t WS_VCMPT = 101 * MiB + 768 * 1024;
constexpr size_t WS_HD = 102 * MiB;
constexpr size_t WS_SSQ = 102 * MiB + 512 * 1024;
constexpr size_t WS_SSQ1 = 103 * MiB;
constexpr size_t WS_HQ = 104 * MiB;
constexpr size_t WS_HLOGF = 120 * MiB;
constexpr size_t WS_HV = 136 * MiB;
constexpr size_t WS_HG = 152 * MiB;
constexpr size_t WS_OWIN = 168 * MiB;
constexpr size_t WS_HS = 184 * MiB;
constexpr size_t WS_Y = 216 * MiB;
constexpr size_t WS_HID = 104 * MiB;
constexpr size_t WS_END = 256 * MiB;

constexpr int NWAVES = 8, NTHREADS = 512;
constexpr int LDS_BYTES = 147456;

#define MK_LANE() ((int)__builtin_amdgcn_mbcnt_hi(~0u, __builtin_amdgcn_mbcnt_lo(~0u, 0u)))
namespace pg8 {
#define PG8_LAS __attribute__((address_space(3)))
typedef unsigned short bf16_t;
typedef short bf16x8 __attribute__((ext_vector_type(8)));
typedef float f32x4 __attribute__((ext_vector_type(4)));
typedef unsigned u32x4 __attribute__((ext_vector_type(4)));
constexpr int BM = 256, BK = 64, HALF = 128, HTB = HALF * BK * 2  , STAGE_BYTES = 8 * HTB, NXCD = 8, WGM = 8;

__host__ __device__ __forceinline__ int lds_byte(int r, int c) { const int st = (r >> 4) * 2 + (c >> 5), rr = r & 15, cc = c & 31, ob = rr * 64 + cc * 2; return st * 1024 + (ob ^ (((ob >> 9) & 1) << 5)); }
__host__ __device__ __forceinline__ void stage_rc(int b, int& R, int& C) { const int st = b / 1024, sb = b % 1024, swz = sb ^ (((sb >> 9) & 1) << 5); R = (st >> 1) * 16 + swz / 64; C = (st & 1) * 32 + (swz % 64) / 2; }
__host__ __device__ __forceinline__ int perm32(int rho) { const int n = rho >> 4, i = rho & 15; return 8 * (i >> 2) + 4 * n + (i & 3); }

struct Unit { int pm, pn; };
struct Gemm { const bf16_t* A; const bf16_t* Bt; int M, N, K; };

struct StaticOrder {
    int nM, nN, nwg, G, c;
    __host__ __device__ void init(int M, int N, int G_, int c_) { nM = M / BM; nN = N / BM; nwg = nM * nN; G = G_; c = c_; }
    __host__ __device__ bool next(int i, Unit& u) const {
        const long L = (long)i * G + c; if (L >= nwg) return false;
        int wgid = (int)L; { const int q = nwg / NXCD, r = nwg % NXCD, xcd = wgid % NXCD, off = wgid / NXCD; wgid = (xcd < r ? xcd * (q + 1) : r * (q + 1) + (xcd - r) * q) + off; }
        const int nig = WGM * nN, gid = wgid / nig, fm = gid * WGM, gsz = (nM - fm) < WGM ? (nM - fm) : WGM;
        u.pm = fm + ((wgid % nig) % gsz); u.pn = (wgid % nig) / gsz; return true;
    }
    __device__ __forceinline__ void a_ready(const Unit&) const {}
    __device__ __forceinline__ void done(const Unit&) const {}
};

#define PG8_MFMA(a, b, c) __builtin_amdgcn_mfma_f32_16x16x32_f16(__builtin_bit_cast(h16x8, (a)), __builtin_bit_cast(h16x8, (b)), (c), 0, 0, 0)
struct EpiOutProj {
    static constexpr bool PERM = false, AFTER_DRAIN = false;
    const float* x; u16* x1h; float* ssq1;
    __device__ __forceinline__ void operator()(const f32x4 (&acc)[2][2][4][2], const Unit& u, int wr, int wc, int fr, int fq) const {
        const int col0 = u.pn * BM + wc * 32 + 4 * fq;
#pragma unroll
        for (int ai = 0; ai < 2; ++ai) {
            f32x4 xr[4][2][2];
#pragma unroll
            for (int m = 0; m < 4; ++m) {
                const size_t off = (size_t)(u.pm * BM + ai * HALF + wr * 64 + m * 16 + fr) * DM + col0;
#pragma unroll
                for (int bj = 0; bj < 2; ++bj)
#pragma unroll
                    for (int n = 0; n < 2; ++n) xr[m][bj][n] = *(const f32x4*)(x + off + bj * HALF + n * 16);
            }
#pragma unroll
            for (int m = 0; m < 4; ++m) {
                const int row = u.pm * BM + ai * HALF + wr * 64 + m * 16 + fr;
                const size_t off = (size_t)row * DM + col0;
                float ss = 0.f;
#pragma unroll
                for (int bj = 0; bj < 2; ++bj)
#pragma unroll
                    for (int n = 0; n < 2; ++n) {
                        const f32x4 v = acc[ai][bj][m][n] + xr[m][bj][n];
                        u32x2 w; w.x = pkh(v[0], v[1]); w.y = pkh(v[2], v[3]);
                        *(u32x2*)(x1h + off + bj * HALF + n * 16) = w;
                        ss += (v[0] * v[0] + v[1] * v[1]) + (v[2] * v[2] + v[3] * v[3]);
                    }
                ss += __shfl_xor(ss, 16); ss += __shfl_xor(ss, 32);
                if (fq == 0) ssq1[(size_t)row * 16 + u.pn * 4 + wc] = ss;
            }
        }
    }
};
struct EpiUp {
    static constexpr bool PERM = true, AFTER_DRAIN = false;
    u16* hid; const float* ssq1;
    __device__ __forceinline__ void operator()(const f32x4 (&acc)[2][2][4][2], const Unit& u, int wr, int wc, int fr, int fq) const {
        const int col0 = u.pn * BM + wc * 32 + 8 * fq;
#pragma unroll
        for (int ai = 0; ai < 2; ++ai)
#pragma unroll
            for (int mp = 0; mp < 4; mp += 2) {
                f32x4 sv[2][4];
#pragma unroll
                for (int mm = 0; mm < 2; ++mm) { const f32x4* sp = (const f32x4*)(ssq1 + (size_t)(u.pm * BM + ai * HALF + wr * 64 + (mp + mm) * 16 + fr) * 16);
#pragma unroll
                    for (int q4 = 0; q4 < 4; ++q4) sv[mm][q4] = sp[q4]; }
#pragma unroll
                for (int mm = 0; mm < 2; ++mm) {
                    const int m = mp + mm;
                    const int row = u.pm * BM + ai * HALF + wr * 64 + m * 16 + fr;
                    float tot = 0.f;
#pragma unroll
                    for (int q4 = 0; q4 < 4; ++q4) tot += (sv[mm][q4][0] + sv[mm][q4][1]) + (sv[mm][q4][2] + sv[mm][q4][3]);
                    const float rs = __builtin_amdgcn_rsqf(tot * (1.0f / DM) + EPS);
                    u16* rowp = hid + (size_t)row * FF + col0;
#pragma unroll
                    for (int bj = 0; bj < 2; ++bj) {
                        f32x4 v0 = acc[ai][bj][m][0] * rs, v1 = acc[ai][bj][m][1] * rs;
#pragma unroll
                        for (int e = 0; e < 4; ++e) { const float a = fmaxf(v0[e], 0.f), b = fmaxf(v1[e], 0.f); v0[e] = a * a; v1[e] = b * b; }
                        u32x4 w; w.x = pkh(v0[0], v0[1]); w.y = pkh(v0[2], v0[3]); w.z = pkh(v1[0], v1[1]); w.w = pkh(v1[2], v1[3]);
                        *(u32x4*)(rowp + bj * HALF) = w;
                    }
                }
            }
    }
};
struct EpiDown {
    static constexpr bool PERM = false, AFTER_DRAIN = false;
    float* out; const u16* x1h;
    __device__ __forceinline__ void operator()(const f32x4 (&acc)[2][2][4][2], const Unit& u, int wr, int wc, int fr, int fq) const {
        const int col0 = u.pn * BM + wc * 32 + 4 * fq;
#pragma unroll
        for (int ai = 0; ai < 2; ++ai) {
            u32x2 xr[4][2][2];
#pragma unroll
            for (int m = 0; m < 4; ++m) {
                const size_t off = (size_t)(u.pm * BM + ai * HALF + wr * 64 + m * 16 + fr) * DM + col0;
#pragma unroll
                for (int bj = 0; bj < 2; ++bj)
#pragma unroll
                    for (int n = 0; n < 2; ++n) xr[m][bj][n] = *(const u32x2*)(x1h + off + bj * HALF + n * 16);
            }
#pragma unroll
            for (int m = 0; m < 4; ++m) {
                const size_t off = (size_t)(u.pm * BM + ai * HALF + wr * 64 + m * 16 + fr) * DM + col0;
#pragma unroll
                for (int bj = 0; bj < 2; ++bj)
#pragma unroll
                    for (int n = 0; n < 2; ++n) {
                        const h16x4 r = __builtin_bit_cast(h16x4, xr[m][bj][n]);
                        f32x4 o = acc[ai][bj][m][n]; o[0] += (float)r[0]; o[1] += (float)r[1]; o[2] += (float)r[2]; o[3] += (float)r[3];
                        *(f32x4*)(out + off + bj * HALF + n * 16) = o;
                    }
            }
        }
    }
};
struct EpiInProj {
    static constexpr bool PERM = true, AFTER_DRAIN = false;
    unsigned char* ws; const float* qg; const float* kg;
    __device__ __forceinline__ void operator()(const f32x4 (&acc)[2][2][4][2], const Unit& u, int wr, int wc, int fr, int fq) const {
        const int pn = u.pn;
        const bool normed = (pn < 2) || (pn < 5 && wc < 2);
        float gn[2][8];
        if (normed) {
            const float* gp = pn < 2 ? qg : kg;
#pragma unroll
            for (int bj = 0; bj < 2; ++bj) { const f32x4 a = *(const f32x4*)(gp + 32 * bj + 8 * fq), b = *(const f32x4*)(gp + 32 * bj + 8 * fq + 4);
#pragma unroll
                for (int e = 0; e < 4; ++e) { gn[bj][e] = a[e]; gn[bj][4 + e] = b[e]; } }
        }
        float lbv[2][8];
        if (pn == 7 || pn == 8) {
            const float* lp = (const float*)(ws + WS_LB) + 256 * (pn - 7) + 64 * wc + 8 * fq;
#pragma unroll
            for (int bj = 0; bj < 2; ++bj) { const f32x4 a = *(const f32x4*)(lp + 32 * bj), b = *(const f32x4*)(lp + 32 * bj + 4);
#pragma unroll
                for (int e = 0; e < 4; ++e) { lbv[bj][e] = a[e]; lbv[bj][4 + e] = b[e]; } }
        }
#pragma unroll
        for (int ai = 0; ai < 2; ++ai) {
            f32x4 rpv[4][4];
#pragma unroll
            for (int m = 0; m < 4; ++m) {
                if (normed && (m & 1) == 0) {
#pragma unroll
                    for (int mm = m; mm < m + 2; ++mm) { const int t_ = (u.pm * BM + ai * HALF + wr * 64 + mm * 16 + fr) & (SEQ - 1); const f32x4* rp_ = (const f32x4*)((const float*)(ws + WS_ROPE) + (size_t)t_ * 16);
#pragma unroll
                        for (int q4 = 0; q4 < 4; ++q4) rpv[mm][q4] = rp_[q4]; }
                }
                const int row = u.pm * BM + ai * HALF + wr * 64 + m * 16 + fr;
                const int b = row >> 13, t = row & (SEQ - 1);
                float v[2][8];
#pragma unroll
                for (int bj = 0; bj < 2; ++bj)
#pragma unroll
                    for (int e = 0; e < 4; ++e) { v[bj][e] = acc[ai][bj][m][0][e]; v[bj][4 + e] = acc[ai][bj][m][1][e]; }
                if (normed) {
                    float ss = 0.f;
#pragma unroll
                    for (int bj = 0; bj < 2; ++bj)
#pragma unroll
                        for (int e = 0; e < 8; ++e) ss += v[bj][e] * v[bj][e];
                    ss += __shfl_xor(ss, 16); ss += __shfl_xor(ss, 32);
                    const float rstd = 1.0f / sqrtf(ss * (1.0f / 64.f) + EPS);
#pragma unroll
                    for (int bj = 0; bj < 2; ++bj)
#pragma unroll
                        for (int e = 0; e < 8; ++e) v[bj][e] = v[bj][e] * rstd * gn[bj][e];
                    const f32x4 r0 = rpv[m][0], r1 = rpv[m][1], r2 = rpv[m][2], r3 = rpv[m][3];
                    const float cs[8] = {r0[0], r0[2], r1[0], r1[2], r2[0], r2[2], r3[0], r3[2]};
                    const float sn[8] = {r0[1], r0[3], r1[1], r1[3], r2[1], r2[3], r3[1], r3[3]};
#pragma unroll
                    for (int e = 0; e < 8; ++e) {
                        const float other = __shfl_xor(v[0][e], 16);
                        const float r1v = v[0][e] * cs[e] - other * sn[e];
                        const float r2v = v[0][e] * cs[e] + other * sn[e];
                        v[0][e] = fq == 0 ? r1v : (fq == 1 ? r2v : v[0][e]);
                    }
                    const float sc = pn < 2 ? 0.125f * 1.4426950408889634f : 1.0f;
                    u16* dst;
                    if (pn < 2) dst = (u16*)(ws + WS_Q) + (size_t)row * 512 + (4 * pn + wc) * 64 + 8 * fq;
                    else dst = (u16*)(ws + (pn == 2 ? WS_KC : pn == 3 ? WS_KS : WS_KW)) + ((size_t)(b * NG + wc) * SEQ + t) * 64 + 8 * fq;
#pragma unroll
                    for (int bj = 0; bj < 2; ++bj) {
                        u32x4 w; w.x = pkh(v[bj][0] * sc, v[bj][1] * sc); w.y = pkh(v[bj][2] * sc, v[bj][3] * sc); w.z = pkh(v[bj][4] * sc, v[bj][5] * sc); w.w = pkh(v[bj][6] * sc, v[bj][7] * sc);
                        *(u32x4*)(dst + 32 * bj) = w;
                    }
                } else if (pn < 5) {
                    const int g = wc - 2;
                    if (pn == 2) {
                        u16* dst = (u16*)(ws + WS_VC) + ((size_t)(b * NG + g) * SEQ + t) * 64 + 8 * fq;
#pragma unroll
                        for (int bj = 0; bj < 2; ++bj) {
                            u32x4 w; w.x = pkh(v[bj][0], v[bj][1]); w.y = pkh(v[bj][2], v[bj][3]); w.z = pkh(v[bj][4], v[bj][5]); w.w = pkh(v[bj][6], v[bj][7]);
                            *(u32x4*)(dst + 32 * bj) = w;
                        }
                    } else {
                        u16* dst = (u16*)(ws + (pn == 3 ? WS_VST : WS_VWT)) + (((size_t)(b * NG + g) * 128 + (t >> 6)) * 64 + 8 * fq) * 64 + (t & 63);
#pragma unroll
                        for (int bj = 0; bj < 2; ++bj)
#pragma unroll
                            for (int e = 0; e < 8; ++e) dst[(32 * bj + e) * 64] = f2h(v[bj][e]);
                    }
                } else if (pn < 13) {
                    const int kind = (pn - 5) >> 1;
                    const int col = 256 * ((pn - 5) & 1) + 64 * wc + 8 * fq;
                    u16* dst = (u16*)(ws + (kind == 0 ? WS_HQ : kind == 1 ? WS_HLOGF : kind == 2 ? WS_HV : WS_HG)) + (size_t)row * 512 + col;
#pragma unroll
                    for (int bj = 0; bj < 2; ++bj) {
                        float o[8];
#pragma unroll
                        for (int e = 0; e < 8; ++e) {
                            const float x = v[bj][e];
                            if (kind == 0 || kind == 3) o[e] = x * sigmoid_f(x);
                            else if (kind == 1) { const float l = lbv[bj][e]; o[e] = __logf(l + (1.f - l) * sigmoid_f(x)); }
                            else o[e] = x;
                        }
                        u32x4 w;
                        if (kind == 0 || kind == 2) { w.x = pkb(o[0], o[1]); w.y = pkb(o[2], o[3]); w.z = pkb(o[4], o[5]); w.w = pkb(o[6], o[7]); }
                        else { w.x = pkh(o[0], o[1]); w.y = pkh(o[2], o[3]); w.z = pkh(o[4], o[5]); w.w = pkh(o[6], o[7]); }
                        *(u32x4*)(dst + 32 * bj) = w;
                    }
                } else {
                    if (wc == 0 && fq < 3) {
                        float* dst = (float*)(ws + WS_GATES) + (size_t)row * 24 + 8 * fq;
                        f32x4 a, c;
#pragma unroll
                        for (int e = 0; e < 4; ++e) { a[e] = sigmoid_f(v[0][e]); c[e] = sigmoid_f(v[0][4 + e]); }
                        *(f32x4*)dst = a; *(f32x4*)(dst + 4) = c;
                    }
                }
            }
        }
    }
};
template <class Epi, class Sched, bool ALIGN_EPI = false, bool SP2 = false>
__device__ __forceinline__ void gemm_phase(PG8_LAS unsigned char* lds, const Gemm g, const Sched& S, const Epi& E, int wave_in) {
    const int tid = threadIdx.x, wid = __builtin_amdgcn_readfirstlane(tid >> 6), lane = tid & 63, wr = wid >> 2, wc = wid & 3, fr = lane & 15, fq = lane >> 4;
    const int K = g.K, nt = K / BK;
    unsigned voffA[2], voffB[2];
#pragma unroll
    for (int i = 0; i < 2; ++i) { int R, C; stage_rc(tid * 16 + i * 8192, R, C); const int Rb = Epi::PERM ? ((R & ~31) + perm32(R & 31)) : R;
        voffA[i] = (unsigned)(R * K + C) * 2u; voffB[i] = (unsigned)(Rb * K + C) * 2u; }
    const size_t kstep = (size_t)(BK * 2);
    const size_t hstep = (size_t)HALF * K * 2;
    const size_t tstep = 2 * hstep;
    const unsigned ldsw = (unsigned)wid * 1024u;
    const int aoff = lds_byte(wr * 64 + fr, fq * 8), boff = lds_byte(wc * 32 + fr, fq * 8);
#define PG8_SA(b, h) (((b) * 2 + (h)) * HTB)
#define PG8_SB(b, h) ((4 + (b) * 2 + (h)) * HTB)
#define PG8_STAGE(bufoff, gbase, voff) do { _Pragma("unroll") for (int _i = 0; _i < 2; ++_i) \
        __builtin_amdgcn_global_load_lds((const unsigned*)((const char*)(gbase) + (voff)[_i]), (PG8_LAS unsigned*)(lds + (bufoff) + ldsw + _i * 8192), 16, 0, 0); } while (0)
#define PG8_LDA(dst, b, h) do { _Pragma("unroll") for (int m = 0; m < 4; ++m) _Pragma("unroll") for (int k = 0; k < 2; ++k) dst[m][k] = *(const PG8_LAS bf16x8*)(lds + PG8_SA(b, h) + aoff + m * 2048 + k * 1024); } while (0)
#define PG8_LDB(dst, b, h) do { _Pragma("unroll") for (int n = 0; n < 2; ++n) _Pragma("unroll") for (int k = 0; k < 2; ++k) dst[n][k] = *(const PG8_LAS bf16x8*)(lds + PG8_SB(b, h) + boff + n * 2048 + k * 1024); } while (0)
#define PG8_MMA(ai, bj, At, Bt) do { __builtin_amdgcn_s_setprio(1); _Pragma("unroll") for (int m = 0; m < 4; ++m) _Pragma("unroll") for (int n = 0; n < 2; ++n) _Pragma("unroll") for (int k = 0; k < 2; ++k) \
        acc[ai][bj][m][n] = PG8_MFMA(Bt[n][k], At[m][k], acc[ai][bj][m][n]); __builtin_amdgcn_s_setprio(0); } while (0)
#define PG8_WAIT_V(n) asm volatile("s_waitcnt vmcnt(" #n ")" ::: "memory")
#define PG8_WAIT_L(n) asm volatile("s_waitcnt lgkmcnt(" #n ")" ::: "memory")
#define PG8_BAR __builtin_amdgcn_s_barrier()
#define PG8_SCHED __builtin_amdgcn_sched_barrier(0)
    Unit cur, nxt; int ui = 0;
    if (!S.next(0, cur)) return;
    f32x4 acc[2][2][4][2];
#pragma unroll
    for (int a = 0; a < 2; ++a)
#pragma unroll
        for (int b = 0; b < 2; ++b)
#pragma unroll
            for (int m = 0; m < 4; ++m)
#pragma unroll
                for (int n = 0; n < 2; ++n) acc[a][b][m][n] = (f32x4){0.f, 0.f, 0.f, 0.f};
    bf16x8 At[4][2], B0[2][2], B1[2][2];
    const char* cA = (const char*)g.A + (size_t)cur.pm * tstep; const char* cB = (const char*)g.Bt + (size_t)cur.pn * tstep;
    S.a_ready(cur);
    if constexpr (SP2) {
        PG8_STAGE(PG8_SB(0, 0), cB, voffB); PG8_STAGE(PG8_SB(0, 1), cB + hstep, voffB); PG8_STAGE(PG8_SA(0, 0), cA, voffA); PG8_STAGE(PG8_SA(0, 1), cA + hstep, voffA);
        if (wr == 1) PG8_BAR;
        PG8_WAIT_V(2); PG8_BAR;
        PG8_STAGE(PG8_SB(1, 0), cB + kstep, voffB); PG8_STAGE(PG8_SA(1, 0), cA + kstep, voffA); PG8_STAGE(PG8_SB(1, 1), cB + hstep + kstep, voffB);
        PG8_WAIT_V(6); PG8_BAR;
    } else {
        PG8_STAGE(PG8_SB(0, 0), cB, voffB); PG8_STAGE(PG8_SA(0, 0), cA, voffA); PG8_STAGE(PG8_SB(0, 1), cB + hstep, voffB); PG8_STAGE(PG8_SA(0, 1), cA + hstep, voffA);
        if (wr == 1) PG8_BAR;
        PG8_WAIT_V(4); PG8_BAR;
        PG8_STAGE(PG8_SB(1, 0), cB + kstep, voffB); PG8_STAGE(PG8_SA(1, 0), cA + kstep, voffA); PG8_STAGE(PG8_SB(1, 1), cB + hstep + kstep, voffB);
        PG8_WAIT_V(6); PG8_BAR;
    }
    for (;;) {
        const bool has_next = S.next(ui + 1, nxt);
        const char* nA = has_next ? (const char*)g.A + (size_t)nxt.pm * tstep : cA; const char* nB = has_next ? (const char*)g.Bt + (size_t)nxt.pn * tstep : cB;
        for (int t = 0; t < nt; t += 2) {
            const bool last = (t == nt - 2);
            const char* a1 = cA + (size_t)(t + 1) * kstep;
            const char* a2 = last ? nA : cA + (size_t)(t + 2) * kstep; const char* b2 = last ? nB : cB + (size_t)(t + 2) * kstep;
            const char* a3 = a2 + kstep; const char* b3 = b2 + kstep;
            if (last && has_next) S.a_ready(nxt);
            if constexpr (SP2) {
            PG8_LDB(B0, 0, 0); PG8_LDB(B1, 0, 1); PG8_SCHED; PG8_LDA(At, 0, 0); PG8_STAGE(PG8_SA(1, 1), a1 + hstep, voffA);
            PG8_WAIT_V(8); PG8_WAIT_L(0); PG8_BAR; PG8_MMA(0, 0, At, B0); PG8_MMA(0, 1, At, B1); PG8_BAR; PG8_SCHED;
            PG8_LDA(At, 0, 1); PG8_STAGE(PG8_SB(0, 0), b2, voffB); PG8_STAGE(PG8_SB(0, 1), b2 + hstep, voffB); PG8_STAGE(PG8_SA(0, 0), a2, voffA);
            PG8_WAIT_V(8); PG8_WAIT_L(0); PG8_BAR; PG8_MMA(1, 0, At, B0); PG8_MMA(1, 1, At, B1); PG8_BAR; PG8_SCHED;
            PG8_LDB(B0, 1, 0); PG8_LDB(B1, 1, 1); PG8_SCHED; PG8_LDA(At, 1, 0); PG8_STAGE(PG8_SA(0, 1), a2 + hstep, voffA);
            PG8_WAIT_V(8); PG8_WAIT_L(0); PG8_BAR; PG8_MMA(0, 0, At, B0); PG8_MMA(0, 1, At, B1); PG8_BAR; PG8_SCHED;
            PG8_LDA(At, 1, 1); PG8_STAGE(PG8_SB(1, 0), b3, voffB); PG8_STAGE(PG8_SB(1, 1), b3 + hstep, voffB); PG8_STAGE(PG8_SA(1, 0), a3, voffA);
            PG8_WAIT_V(8); PG8_WAIT_L(0); PG8_BAR; PG8_MMA(1, 0, At, B0); PG8_MMA(1, 1, At, B1); PG8_BAR; PG8_SCHED;
            } else {
            PG8_LDB(B0, 0, 0); PG8_SCHED; PG8_LDA(At, 0, 0); PG8_STAGE(PG8_SA(1, 1), a1 + hstep, voffA);
            PG8_WAIT_L(8); PG8_BAR; PG8_WAIT_L(0); PG8_MMA(0, 0, At, B0); PG8_BAR; PG8_SCHED;
            PG8_LDB(B1, 0, 1); PG8_STAGE(PG8_SB(0, 0), b2, voffB);
            PG8_BAR; PG8_WAIT_L(0); PG8_MMA(0, 1, At, B1); PG8_BAR;
            PG8_LDA(At, 0, 1); PG8_STAGE(PG8_SA(0, 0), a2, voffA);
            PG8_BAR; PG8_WAIT_L(0); PG8_MMA(1, 0, At, B0); PG8_BAR; PG8_SCHED;
            PG8_STAGE(PG8_SB(0, 1), b2 + hstep, voffB);
            PG8_WAIT_V(6); PG8_BAR; PG8_MMA(1, 1, At, B1); PG8_BAR;
            PG8_LDB(B0, 1, 0); PG8_SCHED; PG8_LDA(At, 1, 0); PG8_STAGE(PG8_SA(0, 1), a2 + hstep, voffA);
            PG8_WAIT_L(8); PG8_BAR; PG8_WAIT_L(0); PG8_MMA(0, 0, At, B0); PG8_BAR; PG8_SCHED;
            PG8_LDB(B1, 1, 1); PG8_STAGE(PG8_SB(1, 0), b3, voffB);
            PG8_BAR; PG8_WAIT_L(0); PG8_MMA(0, 1, At, B1); PG8_BAR;
            PG8_LDA(At, 1, 1); PG8_STAGE(PG8_SA(1, 0), a3, voffA);
            PG8_BAR; PG8_WAIT_L(0); PG8_MMA(1, 0, At, B0); PG8_BAR; PG8_SCHED;
            PG8_STAGE(PG8_SB(1, 1), b3 + hstep, voffB);
            PG8_WAIT_V(6); PG8_BAR; PG8_MMA(1, 1, At, B1); PG8_BAR;
            }
        }
        if constexpr (ALIGN_EPI) { if (wr == 0) PG8_BAR; }
        if constexpr (!Epi::AFTER_DRAIN) { E(acc, cur, wr, wc, fr, fq); S.done(cur); }
        if (!has_next) break;
#pragma unroll
        for (int a = 0; a < 2; ++a)
#pragma unroll
            for (int b = 0; b < 2; ++b)
#pragma unroll
                for (int m = 0; m < 4; ++m)
#pragma unroll
                    for (int n = 0; n < 2; ++n) acc[a][b][m][n] = (f32x4){0.f, 0.f, 0.f, 0.f};
        cur = nxt; cA = nA; cB = nB; ++ui;
        if constexpr (ALIGN_EPI) { if (wr == 1) PG8_BAR; }
    }
    PG8_WAIT_V(0);
    if constexpr (!ALIGN_EPI) { if (wr == 0) PG8_BAR; }
    PG8_BAR;
    if constexpr (Epi::AFTER_DRAIN) { E.fused(acc, cur, wr, wc, fr, fq, lds, wid, lane); S.done(cur); }
#undef PG8_SA
#undef PG8_SB
#undef PG8_STAGE
#undef PG8_LDA
#undef PG8_LDB
#undef PG8_MMA
#undef PG8_WAIT_V
#undef PG8_WAIT_L
#undef PG8_BAR
#undef PG8_SCHED
}
}
#define LDS_WAIT() asm volatile("s_waitcnt lgkmcnt(0)" ::: "memory")
#define VM_WAIT() asm volatile("s_waitcnt vmcnt(0)" ::: "memory")

struct Params {
    const float* in[18];
    float* out;
    unsigned char* ws;
    float invf[8];
    int ph_lo, ph_hi;
};

__device__ __forceinline__ void sincos_acc(float ang, float& s, float& c) {
    const double x = (double)ang;
    const double k = rint(x * 0.6366197723675814);
    double r = fma(-k, 1.5707963267948966, x); r = fma(-k, 6.123233995736766e-17, r);
    const int q = ((int)k) & 3;
    const double r2 = r * r;
    const double sp = r * (1.0 + r2 * (-1.0 / 6 + r2 * (1.0 / 120 + r2 * (-1.0 / 5040 + r2 * (1.0 / 362880 + r2 * (-1.0 / 39916800 + r2 * (1.0 / 6227020800.0)))))));
    const double cp = 1.0 + r2 * (-0.5 + r2 * (1.0 / 24 + r2 * (-1.0 / 720 + r2 * (1.0 / 40320 + r2 * (-1.0 / 3628800 + r2 * (1.0 / 479001600.0 + r2 * (-1.0 / 87178291200.0)))))));
    double ss, cc;
    if (q == 0) { ss = sp; cc = cp; } else if (q == 1) { ss = cp; cc = -sp; } else if (q == 2) { ss = -sp; cc = -cp; } else { ss = -cp; cc = sp; }
    s = (float)ss; c = (float)cc;
}

struct ColId { __device__ __forceinline__ int operator()(int n) const { return n; } };
struct ColWin {
    __device__ __forceinline__ int operator()(int P) const {
        const int pn = P >> 8, p = P & 255, bj = p >> 7, wc = (p >> 5) & 3, j = p & 31;
        const int Lp = 256 * pn + 64 * wc + 32 * bj + j;
        return Lp < 1280 ? Lp : (Lp < 3328 ? Lp + 24 : (Lp < 3352 ? Lp - 3328 + 1280 : -1));
    }
};
template <class SrcCol>
__device__ __forceinline__ void p0_transpose_item(const float* __restrict__ W, int K, int Nsrc, u16* WT, const float* rowscale, SrcCol sc, LAS float* scr, int kb, int nb, int lane) {
    const int k0 = 64 * kb, n0 = 32 * nb;
    const int scol = sc(n0 + (lane & 31));
#pragma unroll
    for (int i = 0; i < 32; ++i) {
        const int kk = 2 * i + (lane >> 5);
        float v = scol >= 0 ? W[(size_t)(k0 + kk) * Nsrc + scol] : 0.f;
        if (rowscale) v *= rowscale[k0 + kk];
        scr[kk * 33 + (lane & 31)] = v;
    }
    LDS_WAIT(); asm volatile("" ::: "memory");
    const int c = lane & 7;
#pragma unroll
    for (int j = 0; j < 4; ++j) {
        const int n = (lane >> 3) + 8 * j; const LAS float* s = scr + (8 * c) * 33 + n;
        u32x4 o; o.x = pkh(s[0 * 33], s[1 * 33]); o.y = pkh(s[2 * 33], s[3 * 33]); o.z = pkh(s[4 * 33], s[5 * 33]); o.w = pkh(s[6 * 33], s[7 * 33]);
        *(u32x4*)(WT + (size_t)(n0 + n) * K + k0 + 8 * c) = o;
    }
    LDS_WAIT(); asm volatile("" ::: "memory");
}

__device__ __forceinline__ void p0_late_transposes(const Params& p, LAS unsigned char* lds, int gw, int NGW, int wave, int lane) {
    unsigned char* ws = p.ws;
    LAS float* scr = (LAS float*)(lds + wave * 16384);
    constexpr int I_WOUT = 16 * 32, I_W1 = 16 * (FF / 32), I_W2 = (FF / 64) * 32, I_C1 = 32 * 4, I_C2 = 2 * 2;
    constexpr int NITEMS = I_WOUT + I_W1 + I_W2 + 2 * I_C1 + 2 * I_C2;
    for (int it = gw; it < NITEMS; it += NGW) {
        int r = it;
        if (r < I_C1) { p0_transpose_item(p.in[6], 2048, 128, (u16*)(ws + WS_CW1K_T), nullptr, ColId(), scr, r / 4, r % 4, lane); continue; } r -= I_C1;
        if (r < I_C1) { p0_transpose_item(p.in[9], 2048, 128, (u16*)(ws + WS_CW1V_T), nullptr, ColId(), scr, r / 4, r % 4, lane); continue; } r -= I_C1;
        if (r < I_C2) { p0_transpose_item(p.in[7], 128, 64, (u16*)(ws + WS_CW2K_T), nullptr, ColId(), scr, r / 2, r % 2, lane); continue; } r -= I_C2;
        if (r < I_C2) { p0_transpose_item(p.in[10], 128, 64, (u16*)(ws + WS_CW2V_T), nullptr, ColId(), scr, r / 2, r % 2, lane); continue; } r -= I_C2;
        if (r < I_WOUT) { p0_transpose_item(p.in[14], DM, DM, (u16*)(ws + WS_WOUT_T), nullptr, ColId(), scr, r / 32, r % 32, lane); continue; } r -= I_WOUT;
        if (r < I_W1) { p0_transpose_item(p.in[16], DM, FF, (u16*)(ws + WS_W1_T), p.in[15], ColId(), scr, r / (FF / 32), r % (FF / 32), lane); continue; } r -= I_W1;
        p0_transpose_item(p.in[17], FF, DM, (u16*)(ws + WS_W2_T), nullptr, ColId(), scr, r / 32, r % 32, lane);
    }
}
__device__ __forceinline__ void p0_prologue(const Params& p, LAS unsigned char* lds, int gw, int NGW, int wave, int lane) {
    unsigned char* ws = p.ws;
    LAS float* scr = (LAS float*)(lds + wave * 16384);
    constexpr int I_WIN = 16 * (DINP / 32);
    for (int it = gw; it < I_WIN; it += NGW) p0_transpose_item(p.in[2], DM, DIN, (u16*)(ws + WS_WIN_T), nullptr, ColWin(), scr, it / (DINP / 32), it % (DINP / 32), lane);
    {
        const float* gn = p.in[1];
        f32x4 gv[4];
#pragma unroll
        for (int j = 0; j < 4; ++j) gv[j] = ((const f32x4*)gn)[lane + 64 * j];
        for (int m = gw; m < MT; m += 4 * NGW) {
            f32x4 v[4][4]; float s[4];
#pragma unroll
            for (int r = 0; r < 4; ++r) {
                const int mr = m + r * NGW; const f32x4* xr = (const f32x4*)(p.in[0] + (size_t)(mr < MT ? mr : m) * DM) + lane;
#pragma unroll
                for (int j = 0; j < 4; ++j) v[r][j] = __builtin_nontemporal_load(xr + 64 * j);
            }
#pragma unroll
            for (int r = 0; r < 4; ++r) {
                float a = 0.f;
#pragma unroll
                for (int j = 0; j < 4; ++j) a += (v[r][j][0] * v[r][j][0] + v[r][j][1] * v[r][j][1]) + (v[r][j][2] * v[r][j][2] + v[r][j][3] * v[r][j][3]);
                s[r] = a;
            }
#pragma unroll
            for (int o = 1; o < 64; o <<= 1) {
#pragma unroll
                for (int r = 0; r < 4; ++r) s[r] += __shfl_xor(s[r], o);
            }
#pragma unroll
            for (int r = 0; r < 4; ++r) {
                const int mr = m + r * NGW;
                if (mr < MT) {
                    const float rstd = 1.0f / sqrtf(s[r] * (1.f / DM) + EPS);
                    u32x2* o8 = (u32x2*)((u16*)(ws + WS_XH) + (size_t)mr * DM) + lane;
#pragma unroll
                    for (int j = 0; j < 4; ++j) { u32x2 ww; ww.x = pkh(v[r][j][0] * rstd * gv[j][0], v[r][j][1] * rstd * gv[j][1]); ww.y = pkh(v[r][j][2] * rstd * gv[j][2], v[r][j][3] * rstd * gv[j][3]); o8[64 * j] = ww; }
                }
            }
        }
    }
    const int gt = gw * 64 + lane, NGT = NGW * 64;
    for (int i = gt; i < SEQ * 8; i += NGT) {
        const int pos = i >> 3, f = i & 7; float s, c; sincos_acc((float)pos * p.invf[f], s, c);
        ((f32x2*)(ws + WS_ROPE))[i] = (f32x2){c, s};
    }
    for (int i = gt; i < 512; i += NGT) {
        const float a = p.in[12][i], c = p.in[12][512 + i]; const float m = fmaxf(a, c); const float ea = expf(a - m), ec = expf(c - m);
        ((float*)(ws + WS_LB))[i] = ea / (ea + ec);
    }
    for (int i = gt; i < 2048; i += NGT) { ((u16*)(ws + WS_PEK))[i] = f2h(p.in[5][i]); ((u16*)(ws + WS_PEV))[i] = f2h(p.in[8][i]); }
}

#define XB_TMO      128
#define XB_XCNT(j)  (256  + 64 * (j))
#define XB_XSUB(j)  (1280 + 64 * (j))
#define XB_XGEN(j)  (2304 + 64 * (j))
#define XB_TOP      3328
#define XB_TOPGEN   3392
#define XCD_BAR_WORDS 3456
#define XB_SPIN_CAP (1u << 18)

__device__ __forceinline__ unsigned xb_ld(unsigned* p)              { return __hip_atomic_load(p, __ATOMIC_RELAXED, __HIP_MEMORY_SCOPE_AGENT); }
__device__ __forceinline__ unsigned xb_add(unsigned* p, unsigned v) { return __hip_atomic_fetch_add(p, v, __ATOMIC_RELAXED, __HIP_MEMORY_SCOPE_AGENT); }
__device__ __forceinline__ unsigned xb_xcc_id() { return (unsigned)__builtin_amdgcn_s_getreg((3 << 11) | 20) & 0xFu; }
#define XB_SPIN(cond, bar) do { unsigned _sp = 0; while (cond) { __builtin_amdgcn_s_sleep(1); \
    if ((++_sp & 255u) == 0u) { if (xb_ld(&(bar)[XB_TMO])) break; if (_sp > XB_SPIN_CAP) { atomicAdd(&(bar)[XB_TMO], 1u); break; } } } } while (0)

struct XcdBarrier {
    unsigned* bar; unsigned x;
    volatile LAS unsigned* st;
};

__device__ __forceinline__ XcdBarrier xcd_barrier_post(unsigned* bar, volatile LAS unsigned* st) {
    XcdBarrier b; b.bar = bar; b.x = xb_xcc_id(); b.st = st;
    if (threadIdx.x == 0) (void)xb_add(&bar[XB_XCNT(b.x)], 1u);
    return b;
}
__device__ __forceinline__ void xcd_barrier_complete(unsigned* bar, unsigned x, unsigned& nloc, unsigned& nx) {
    const unsigned G = gridDim.x * gridDim.y * gridDim.z;
    unsigned sum, cnt, mine, sp = 0u;
    for (;;) {
        sum = 0u; cnt = 0u; mine = 0u;
#pragma unroll
        for (unsigned j = 0; j < 16; ++j) { const unsigned c = xb_ld(&bar[XB_XCNT(j)]); sum += c; cnt += (c > 0u) ? 1u : 0u; mine = (j == x) ? c : mine; }
        if (sum == G) break;
        __builtin_amdgcn_s_sleep(1);
        if ((++sp & 255u) == 0u) { if (xb_ld(&bar[XB_TMO])) break; if (sp > XB_SPIN_CAP) { atomicAdd(&bar[XB_TMO], 1u); break; } }
    }
    nloc = mine > 0u ? mine : 1u; nx = cnt > 0u ? cnt : 1u;
}

__device__ __forceinline__ void xcd_barrier(const XcdBarrier& b) {
    asm volatile("s_waitcnt vmcnt(0)" ::: "memory");
    __syncthreads();
    if (threadIdx.x == 0) {
        unsigned* bar = b.bar;
        __builtin_amdgcn_s_waitcnt(0);
        unsigned nloc = b.st[0], nx = b.st[1];
        if (nloc == 0u) { xcd_barrier_complete(bar, b.x, nloc, nx); b.st[0] = nloc; b.st[1] = nx; }
        const unsigned old = xb_add(&bar[XB_XSUB(b.x)], 1u);
        const unsigned gen = old / nloc;
        if (old + 1u == (gen + 1u) * nloc) {
            __builtin_amdgcn_fence(__ATOMIC_RELEASE, "agent");
            asm volatile("s_waitcnt vmcnt(0)" ::: "memory");
            const unsigned og = xb_add(&bar[XB_TOP], 1u);
            const unsigned tg = og / nx;
            if (og + 1u == (tg + 1u) * nx) xb_add(&bar[XB_TOPGEN], 1u);
            else XB_SPIN(xb_ld(&bar[XB_TOPGEN]) == tg, bar);
            __builtin_amdgcn_fence(__ATOMIC_ACQUIRE, "agent");
            xb_add(&bar[XB_XGEN(b.x)], 1u);
            asm volatile("s_waitcnt vmcnt(0)" ::: "memory");
        } else {
            XB_SPIN(xb_ld(&bar[XB_XGEN(b.x)]) == gen, bar);
            __builtin_amdgcn_fence(__ATOMIC_ACQUIRE, "agent");
            asm volatile("s_waitcnt vmcnt(0)" ::: "memory");
        }
    }
    __syncthreads();
}

constexpr float LOG2E = 1.4426950408889634f;
constexpr float OFF2 = 4.0f * LOG2E;
constexpr int AT_PITCH = 144;
constexpr int AT_TILE = 64 * AT_PITCH;
constexpr int AT_LDS = 4 * AT_TILE;
#define MFMA32H(a, b, c) __builtin_amdgcn_mfma_f32_32x32x16_f16((a), (b), (c), 0, 0, 0)
#define MFMA16H(a, b, c) __builtin_amdgcn_mfma_f32_16x16x32_f16((a), (b), (c), 0, 0, 0)
#define MFMA32B(a, b, c) __builtin_amdgcn_mfma_f32_32x32x16_bf16((a), (b), (c), 0, 0, 0)

#define AT_BAR() do { asm volatile("s_waitcnt lgkmcnt(0)" ::: "memory"); __builtin_amdgcn_s_barrier(); asm volatile("" ::: "memory"); } while (0)
template <int MODE>
__device__ __forceinline__ void attn_tiles(LAS unsigned char* lds, const u16* __restrict__ Kbg, const u16* __restrict__ VTbg, const h16x8 (&qf)[4], int qt, int j0, int qh, int wave, int lane,
                                           unsigned sw0, unsigned sw1, unsigned sw2, unsigned sw3, f32x16 (&o)[2], float& lsum) {
    const int tid = threadIdx.x, r32 = lane & 31, hi = lane >> 5;
    const int srow = tid >> 3, sch = tid & 7;
    const u16* ksrc = Kbg + (size_t)srow * 64 + 8 * sch;
    const u16* vsrc = VTbg + (size_t)srow * 64 + 8 * sch;
    const int sdst = srow * AT_PITCH + sch * 16;
    const int prow = (r32 & 0x13) | ((r32 & 8) >> 1) | ((r32 & 4) << 1);
    const int koff = prow * AT_PITCH + hi * 16;
    const int voff = r32 * AT_PITCH + hi * 16;
    const int qrel = 32 * qh + r32;
    u32x4 kA = *(const u32x4*)(ksrc + (size_t)j0 * 4096), vA = *(const u32x4*)(vsrc + (size_t)j0 * 4096);
    u32x4 kB = kA, vB = vA;
    if (j0 + 1 <= qt) { kB = *(const u32x4*)(ksrc + (size_t)(j0 + 1) * 4096); vB = *(const u32x4*)(vsrc + (size_t)(j0 + 1) * 4096); }
    *(LAS u32x4*)(lds + sdst) = kA; *(LAS u32x4*)(lds + 2 * AT_TILE + sdst) = vA;
    h16x8 qg0 = qf[0], qg1 = qf[1], qg2 = qf[2], qg3 = qf[3];
    asm volatile("" : "+v"(qg0), "+v"(qg1), "+v"(qg2), "+v"(qg3));
    const u32x4 onesw = {0x3c003c00u, 0x3c003c00u, 0x3c003c00u, 0x3c003c00u};
    f32x16 negoff;
#pragma unroll
    for (int i = 0; i < 16; ++i) negoff[i] = -OFF2;
    asm volatile("" : "+v"(negoff));
    f32x16 ol;
#pragma unroll
    for (int i = 0; i < 16; ++i) ol[i] = 0.f;
    AT_BAR();
    for (int j = j0; j <= qt; ++j) {
        const int buf = (j - j0) & 1;
        if (j + 2 <= qt) { kA = *(const u32x4*)(ksrc + (size_t)(j + 2) * 4096); vA = *(const u32x4*)(vsrc + (size_t)(j + 2) * 4096); }
        LAS unsigned char* kb = lds + buf * AT_TILE; LAS unsigned char* vb = lds + (2 + buf) * AT_TILE;
        bool sel = true;
        if (MODE == 1) { const unsigned w = j < 32 ? sw0 : (j < 64 ? sw1 : (j < 96 ? sw2 : sw3)); sel = (w >> (j & 31)) & 1u; }
        if (MODE == 0 || __any(sel)) {
            h16x8 kf[8];
#pragma unroll
            for (int kh = 0; kh < 2; ++kh)
#pragma unroll
                for (int d0 = 0; d0 < 4; ++d0) kf[kh * 4 + d0] = *(const LAS h16x8*)(kb + kh * 32 * AT_PITCH + koff + d0 * 32);
            __builtin_amdgcn_sched_barrier(0);
            f32x16 s[2];
#pragma unroll
            for (int kh = 0; kh < 2; ++kh) {
#pragma unroll
                for (int d0 = 0; d0 < 4; ++d0) s[kh] = MFMA32H(kf[kh * 4 + d0], (d0 == 0 ? qg0 : d0 == 1 ? qg1 : d0 == 2 ? qg2 : qg3), (d0 == 0 ? negoff : s[kh]));
            }
            h16x8 vfr[8];
#pragma unroll
            for (int dt = 0; dt < 2; ++dt)
#pragma unroll
                for (int kk = 0; kk < 4; ++kk) vfr[dt * 4 + kk] = *(const LAS h16x8*)(vb + dt * 32 * AT_PITCH + voff + kk * 32);
            __builtin_amdgcn_sched_barrier(0);
            const int dj = qt - j;
            const bool edge_hi = (dj == 0), edge_lo = (MODE == 0) && (dj == 8);
            u32x4 pw[2][2];
            if (edge_hi || edge_lo) {
#pragma unroll
                for (int kh = 0; kh < 2; ++kh)
#pragma unroll
                    for (int sp = 0; sp < 2; ++sp) {
                        float pv[8];
#pragma unroll
                        for (int e = 0; e < 8; ++e) {
                            const int kin = 32 * kh + 16 * sp + 8 * hi + e;
                            float pe = __builtin_amdgcn_exp2f(s[kh][8 * sp + e]);
                            if (edge_hi) pe = (kin <= qrel) ? pe : 0.f;
                            if (edge_lo) pe = (kin > qrel) ? pe : 0.f;
                            pv[e] = pe;
                        }
                        pw[kh][sp] = (u32x4){pkh(pv[0], pv[1]), pkh(pv[2], pv[3]), pkh(pv[4], pv[5]), pkh(pv[6], pv[7])};
                    }
            } else {
#pragma unroll
                for (int kh = 0; kh < 2; ++kh)
#pragma unroll
                    for (int sp = 0; sp < 2; ++sp) {
                        float pv[8];
#pragma unroll
                        for (int e = 0; e < 8; ++e) pv[e] = __builtin_amdgcn_exp2f(s[kh][8 * sp + e]);
                        pw[kh][sp] = (u32x4){pkh(pv[0], pv[1]), pkh(pv[2], pv[3]), pkh(pv[4], pv[5]), pkh(pv[6], pv[7])};
                    }
            }
            if (MODE == 1) {
                const unsigned mk = sel ? 0xffffffffu : 0u;
#pragma unroll
                for (int kh = 0; kh < 2; ++kh)
#pragma unroll
                    for (int sp = 0; sp < 2; ++sp) { pw[kh][sp].x &= mk; pw[kh][sp].y &= mk; pw[kh][sp].z &= mk; pw[kh][sp].w &= mk; }
            }
#pragma unroll
            for (int kh = 0; kh < 2; ++kh)
#pragma unroll
                for (int sp = 0; sp < 2; ++sp) {
                    const h16x8 pb = __builtin_bit_cast(h16x8, pw[kh][sp]);
#pragma unroll
                    for (int dt = 0; dt < 2; ++dt) o[dt] = MFMA32H(vfr[dt * 4 + 2 * kh + sp], pb, o[dt]);
                    ol = MFMA32H(__builtin_bit_cast(h16x8, onesw), pb, ol);
                }
        }
        if (j < qt) { *(LAS u32x4*)(lds + (buf ^ 1) * AT_TILE + sdst) = kB; *(LAS u32x4*)(lds + (2 + (buf ^ 1)) * AT_TILE + sdst) = vB; }
        kB = kA; vB = vA;
        AT_BAR();
    }
    lsum = 0.5f * ol[0];
}

__device__ __forceinline__ void win_unit(unsigned char* ws, LAS unsigned char* lds, int u, int wave, int lane) {
    const int qt = u & 127, bg = u >> 7, b = bg >> 1, g = bg & 1;
    const int h = wave >> 1, qh = wave & 1, r32 = lane & 31, hi = lane >> 5;
    const int t = 64 * qt + 32 * qh + r32;
    const size_t row = (size_t)b * SEQ + t;
    const u16* qp = (const u16*)(ws + WS_Q) + row * 512 + (4 * g + h) * 64 + 8 * hi;
    h16x8 qf[4];
#pragma unroll
    for (int d0 = 0; d0 < 4; ++d0) qf[d0] = *(const h16x8*)(qp + 16 * d0);
    f32x16 o[2]; float l = 0.f;
#pragma unroll
    for (int i = 0; i < 16; ++i) { o[0][i] = 0.f; o[1][i] = 0.f; }
    const int j0 = qt > 8 ? qt - 8 : 0;
    attn_tiles<0>(lds, (const u16*)(ws + WS_KW) + (size_t)bg * SEQ * 64, (const u16*)(ws + WS_VWT) + (size_t)bg * 64 * SEQ, qf, qt, j0, qh, wave, lane, 0u, 0u, 0u, 0u, o, l);
    l += __shfl_xor(l, 32);
    const float sc = ((const float*)(ws + WS_GATES))[row * 24 + (4 * g + h) * 3 + 2] / l;
    u16* dst = (u16*)(ws + WS_OWIN) + row * 512 + (4 * g + h) * 64 + 4 * hi;
#pragma unroll
    for (int dt = 0; dt < 2; ++dt)
#pragma unroll
        for (int r4 = 0; r4 < 4; ++r4) {
            u32x2 w; w.x = pkh(o[dt][4 * r4] * sc, o[dt][4 * r4 + 1] * sc); w.y = pkh(o[dt][4 * r4 + 2] * sc, o[dt][4 * r4 + 3] * sc);
            *(u32x2*)(dst + 32 * dt + 8 * r4) = w;
        }
}

constexpr int CM_SP = 132, CM_HP = 136;
__device__ __forceinline__ void cmp_mlp_unit(unsigned char* ws, LAS unsigned char* lds, int u, int wave, int lane) {
    const int mt = u & 31, bg = (u >> 5) & 3, kv = u >> 7;
    const int tid = threadIdx.x, r = lane & 15, quad = lane >> 4;
    LAS float* slab = (LAS float*)lds;
    LAS u16* hb = (LAS u16*)(lds + 8 * 16 * CM_SP * 4);
    const u16* src = (const u16*)(ws + (kv ? WS_VC : WS_KC)) + (size_t)bg * SEQ * 64;
    const u16* pe = (const u16*)(ws + (kv ? WS_PEV : WS_PEK));
    const u16* w1t = (const u16*)(ws + (kv ? WS_CW1V_T : WS_CW1K_T));
    const int n = 16 * mt + r;
    const int nc = n < NCMP ? n : NCMP - 1;
    const u16* arow = src + (size_t)nc * 1024 + 8 * quad;
    const u16* brow = w1t + (size_t)r * 2048 + 8 * quad;
    f32x4 acc[8];
#pragma unroll
    for (int c = 0; c < 8; ++c) acc[c] = (f32x4){0.f, 0.f, 0.f, 0.f};
    const int kbase = 256 * wave;
#pragma unroll 1
    for (int hf = 0; hf < 2; ++hf) {
#pragma unroll
        for (int st = 0; st < 4; ++st) {
            const int k0 = kbase + 32 * (4 * hf + st);
            const h16x8 av = *(const h16x8*)(arow + k0) + *(const h16x8*)(pe + k0 + 8 * quad);
#pragma unroll
            for (int c = 0; c < 8; ++c) { const h16x8 bf = *(const h16x8*)(brow + (size_t)(16 * c) * 2048 + k0); acc[c] = MFMA16H(av, bf, acc[c]); }
        }
    }
#pragma unroll
    for (int c = 0; c < 8; ++c)
#pragma unroll
        for (int i = 0; i < 4; ++i) slab[(wave * 16 + 4 * quad + i) * CM_SP + 16 * c + r] = acc[c][i];
    AT_BAR();
#pragma unroll
    for (int jj = 0; jj < 4; ++jj) {
        const int idx = tid + NTHREADS * jj, row = idx >> 7, col = idx & 127;
        float x = 0.f;
#pragma unroll
        for (int w8 = 0; w8 < 8; ++w8) x += slab[(w8 * 16 + row) * CM_SP + col];
        hb[row * CM_HP + col] = f2h(x * sigmoid_f(x));
    }
    AT_BAR();
    if (wave < 4) {
        const u16* w2t = (const u16*)(ws + (kv ? WS_CW2V_T : WS_CW2K_T)) + (size_t)(16 * wave + r) * 128 + 8 * quad;
        f32x4 oc = {0.f, 0.f, 0.f, 0.f};
#pragma unroll
        for (int ks = 0; ks < 4; ++ks) {
            const h16x8 af = *(const LAS h16x8*)(hb + r * CM_HP + 32 * ks + 8 * quad);
            const h16x8 bf = *(const h16x8*)(w2t + 32 * ks);
            oc = MFMA16H(af, bf, oc);
        }
        const int d = 16 * wave + r, n0 = 16 * mt + 4 * quad;
        if (kv == 0) {
            u16* dst = (u16*)(ws + WS_KCMP) + (size_t)bg * 512 * 64 + d;
#pragma unroll
            for (int i = 0; i < 4; ++i) dst[(size_t)(n0 + i) * 64] = (n0 + i) < NCMP ? f2h(oc[i]) : (u16)0;
        } else {
            u32x2 w; w.x = pkh(oc[0], oc[1]); w.y = pkh(oc[2], (n0 + 3) < NCMP ? oc[3] : 0.f);
            *(u32x2*)((u16*)(ws + WS_VCMPT) + ((size_t)bg * 64 + d) * 512 + n0) = w;
        }
    }
    AT_BAR();
}
constexpr int NS_IMP_P = 132, NS_MAXIT = 288, NS_SLOT = 32 * 144;
constexpr int NS_OFF_IMP = 0, NS_OFF_KC = 67584;
constexpr int NS_OFF_SLOT = 0, NS_OFF_SLOTL = 2 * 8 * NS_SLOT, NS_OFF_OA = NS_OFF_SLOTL + 2048;
constexpr int NS_OFF_BM = 141312, NS_OFF_ITEMS = 142336, NS_OFF_CNT = 145792;
static_assert(2 * 64 * NS_IMP_P * 4 <= NS_OFF_KC && NS_OFF_KC + 512 * 144 <= NS_OFF_BM && NS_OFF_OA + 4 * 512 * 16 <= NS_OFF_BM &&
              NS_OFF_ITEMS + NS_MAXIT * 12 <= NS_OFF_CNT && NS_OFF_CNT + 16 + 1024 <= LDS_BYTES - 256 && AT_LDS <= NS_OFF_BM, "nsa LDS map");
#define NS_BAR() do { asm volatile("s_waitcnt lgkmcnt(0)" ::: "memory"); __builtin_amdgcn_s_barrier(); asm volatile("" ::: "memory"); } while (0)

__device__ __forceinline__ void nsa_unit(unsigned char* ws, LAS unsigned char* lds, int bg, int qt, int wave, int lane) {
    const int tid = threadIdx.x; const int b = bg >> 1, g = bg & 1;
    LAS float* imp = (LAS float*)(lds + NS_OFF_IMP);
    LAS unsigned* bm = (LAS unsigned*)(lds + NS_OFF_BM);
    LAS unsigned char* kcl = lds + NS_OFF_KC;
    LAS unsigned* items = (LAS unsigned*)(lds + NS_OFF_ITEMS);
    LAS unsigned* cnt = (LAS unsigned*)(lds + NS_OFF_CNT);
    const float* gates = (const float*)(ws + WS_GATES);
    for (int i = tid; i < 2 * 64 * NS_IMP_P; i += NTHREADS) imp[i] = 0.f;
    if (tid == 0) cnt[0] = 0u;
    {
        const int amax = 4 * qt + 3;
        int nrows = 32 * ((amax + 31) >> 5); nrows = nrows > 512 ? 512 : nrows;
        const u16* kcg = (const u16*)(ws + WS_KCMP) + (size_t)bg * 512 * 64;
        u32x4 tmp[8];
#pragma unroll
        for (int ii = 0; ii < 8; ++ii) { const int i = tid + NTHREADS * ii; if (i < nrows * 8) tmp[ii] = *(const u32x4*)(kcg + (size_t)i * 8); }
#pragma unroll
        for (int ii = 0; ii < 8; ++ii) { const int i = tid + NTHREADS * ii; if (i < nrows * 8) *(LAS u32x4*)(kcl + (i >> 3) * 144 + (i & 7) * 16) = tmp[ii]; }
    }
    AT_BAR();
    {
        int ln1 = lane; asm volatile("" : "+v"(ln1));
        const int qg = wave & 3, hp = wave >> 2, qi = ln1 & 15, quad = ln1 >> 4;
        const int a = 4 * qt + qg;
        const int nlim = (qi == 15) ? a - 1 : a - 2;
        const int nT = (a + 15) >> 4, nP = (nT + 1) >> 1;
        const int q = 16 * qg + qi; const size_t row = (size_t)b * SEQ + 64 * qt + q;
        const u16* vtg = (const u16*)(ws + WS_VCMPT) + (size_t)bg * 64 * 512;
        const LAS unsigned char* kl = kcl + qi * 144 + quad * 16;
        LAS float* ir = imp + (hp * 64 + q) * NS_IMP_P + quad;
        h16x8 qf2[2][2];
#pragma unroll
        for (int hh = 0; hh < 2; ++hh)
#pragma unroll
            for (int ks = 0; ks < 2; ++ks) qf2[hh][ks] = *(const h16x8*)((const u16*)(ws + WS_Q) + row * 512 + (4 * g + 2 * hp + hh) * 64 + 32 * ks + 8 * quad);
        float m[2] = {-1e30f, -1e30f}, l[2] = {0.f, 0.f};
        for (int P = 0; P < nP; ++P) {
            h16x8 kp[2][2];
#pragma unroll
            for (int tt = 0; tt < 2; ++tt) { kp[tt][0] = *(const LAS h16x8*)(kl + (2 * P + tt) * 16 * 144); kp[tt][1] = *(const LAS h16x8*)(kl + (2 * P + tt) * 16 * 144 + 64); }
            f32x4 sv[2][2];
#pragma unroll
            for (int tt = 0; tt < 2; ++tt)
#pragma unroll
                for (int hh = 0; hh < 2; ++hh) { f32x4 z = {0.f, 0.f, 0.f, 0.f}; z = MFMA16H(kp[tt][0], qf2[hh][0], z); sv[tt][hh] = MFMA16H(kp[tt][1], qf2[hh][1], z); }
#pragma unroll
            for (int hh = 0; hh < 2; ++hh) {
                float mx = m[hh];
#pragma unroll
                for (int tt = 0; tt < 2; ++tt)
#pragma unroll
                    for (int i = 0; i < 4; ++i) mx = (16 * (2 * P + tt) + 4 * quad + i <= nlim) ? fmaxf(mx, sv[tt][hh][i]) : mx;
                float add = 0.f;
#pragma unroll
                for (int tt = 0; tt < 2; ++tt)
#pragma unroll
                    for (int i = 0; i < 4; ++i) add += (16 * (2 * P + tt) + 4 * quad + i <= nlim) ? __builtin_amdgcn_exp2f(sv[tt][hh][i] - mx) : 0.f;
                l[hh] = l[hh] * __builtin_amdgcn_exp2f(m[hh] - mx) + add; m[hh] = mx;
            }
        }
        float mall[2], inv[2];
#pragma unroll
        for (int hh = 0; hh < 2; ++hh) {
            float ma = fmaxf(m[hh], __shfl_xor(m[hh], 16)); ma = fmaxf(ma, __shfl_xor(ma, 32));
            float lw = l[hh] * __builtin_amdgcn_exp2f(m[hh] - ma); lw += __shfl_xor(lw, 16); lw += __shfl_xor(lw, 32);
            mall[hh] = ma; inv[hh] = lw > 0.f ? 1.0f / lw : 0.f;
        }
        f32x4 oc[2][4];
#pragma unroll
        for (int hh = 0; hh < 2; ++hh)
#pragma unroll
            for (int dt = 0; dt < 4; ++dt) oc[hh][dt] = (f32x4){0.f, 0.f, 0.f, 0.f};
        float cwrap = 0.f;
        u32x2 vn[4][2];
#pragma unroll
        for (int dt = 0; dt < 4; ++dt) { const u16* vp = vtg + (size_t)(16 * dt + qi) * 512 + 4 * quad; vn[dt][0] = *(const u32x2*)vp; vn[dt][1] = *(const u32x2*)(vp + 16); }
        for (int P = 0; P < nP; ++P) {
            u32x4 va4[4];
#pragma unroll
            for (int dt = 0; dt < 4; ++dt) va4[dt] = (u32x4){vn[dt][0].x, vn[dt][0].y, vn[dt][1].x, vn[dt][1].y};
            if (P + 1 < nP) {
#pragma unroll
                for (int dt = 0; dt < 4; ++dt) { const u16* vp = vtg + (size_t)(16 * dt + qi) * 512 + 32 * (P + 1) + 4 * quad; vn[dt][0] = *(const u32x2*)vp; vn[dt][1] = *(const u32x2*)(vp + 16); }
            }
            h16x8 kp[2][2];
#pragma unroll
            for (int tt = 0; tt < 2; ++tt) { kp[tt][0] = *(const LAS h16x8*)(kl + (2 * P + tt) * 16 * 144); kp[tt][1] = *(const LAS h16x8*)(kl + (2 * P + tt) * 16 * 144 + 64); }
            f32x4 sv[2][2];
#pragma unroll
            for (int tt = 0; tt < 2; ++tt)
#pragma unroll
                for (int hh = 0; hh < 2; ++hh) { f32x4 z = {0.f, 0.f, 0.f, 0.f}; z = MFMA16H(kp[tt][0], qf2[hh][0], z); sv[tt][hh] = MFMA16H(kp[tt][1], qf2[hh][1], z); }
            u32x4 pw[2];
            float A2[2], C2[2];
#pragma unroll
            for (int tt = 0; tt < 2; ++tt) {
                const int n0 = 16 * (2 * P + tt) + 4 * quad;
                float A = 0.f, C = 0.f;
#pragma unroll
                for (int hh = 0; hh < 2; ++hh) {
                    float pv[4];
#pragma unroll
                    for (int i = 0; i < 4; ++i) pv[i] = (n0 + i <= nlim) ? __builtin_amdgcn_exp2f(sv[tt][hh][i] - mall[hh]) * inv[hh] : 0.f;
                    A += (pv[0] + pv[1]) + (pv[2] + 0.5f * pv[3]); C += 0.5f * pv[3];
                    if (tt == 0) { pw[hh].x = pkh(pv[0], pv[1]); pw[hh].y = pkh(pv[2], pv[3]); } else { pw[hh].z = pkh(pv[0], pv[1]); pw[hh].w = pkh(pv[2], pv[3]); }
                }
                A2[tt] = A; C2[tt] = C;
            }
            const float cup0 = __shfl_up(C2[0], 16), cup1 = __shfl_up(C2[1], 16);
            const float cw0 = __shfl(C2[0], qi + 48), cw1 = __shfl(C2[1], qi + 48);
            ir[4 * (2 * P)] = A2[0] + (quad > 0 ? cup0 : cwrap);
            ir[4 * (2 * P + 1)] = A2[1] + (quad > 0 ? cup1 : cw0);
            cwrap = cw1;
#pragma unroll
            for (int dt = 0; dt < 4; ++dt) {
#pragma unroll
                for (int hh = 0; hh < 2; ++hh) oc[hh][dt] = MFMA16H(__builtin_bit_cast(h16x8, va4[dt]), __builtin_bit_cast(h16x8, pw[hh]), oc[hh][dt]);
            }
        }
        if (quad == 0 && 2 * nP < 32) ir[4 * (2 * nP)] = cwrap;
#pragma unroll
        for (int hh = 0; hh < 2; ++hh) {
            const int h = 2 * hp + hh;
            const float g0 = gates[row * 24 + (4 * g + h) * 3 + 0];
#pragma unroll
            for (int dt = 0; dt < 4; ++dt) {
                u32x2 w; w.x = pkh(oc[hh][dt][0] * g0, oc[hh][dt][1] * g0); w.y = pkh(oc[hh][dt][2] * g0, oc[hh][dt][3] * g0);
                *(u32x2*)((u16*)(ws + WS_Y) + row * DM + (4 * g + h) * 64 + 16 * dt + 4 * quad) = w;
            }
        }
    }
    __syncthreads();
    {
        const int cur = qt, nf = cur == 0 ? 1 : (cur == 1 ? 2 : 3), need = NTOP - nf, jhi = cur - 2;
        int ln2 = lane; asm volatile("" : "+v"(ln2));
        const int j1 = ln2, j2 = ln2 + 64;
        const bool c1 = (j1 >= 1 && j1 <= jhi), c2 = (j2 <= jhi);
        const bool f1 = (j1 == 0) || (j1 == cur) || (j1 == cur - 1), f2 = (j2 == cur) || (j2 == cur - 1);
#pragma unroll 1
        for (int q0 = 0; q0 < 8; q0 += 4) {
            unsigned u1[4], u2[4];
#pragma unroll
            for (int k = 0; k < 4; ++k) {
                const int q = 8 * wave + q0 + k;
                const LAS float* ir0 = imp + q * NS_IMP_P; const LAS float* ir1 = imp + (64 + q) * NS_IMP_P;
                u1[k] = __float_as_uint(ir0[j1] + ir1[j1]); u2[k] = __float_as_uint(ir0[j2] + ir1[j2]);
                u1[k] = c1 ? u1[k] : 0u; u2[k] = c2 ? u2[k] : 0u;
            }
            unsigned pre[4] = {0u, 0u, 0u, 0u};
            if (jhi > need) {
                for (int bit = 30; bit >= 0; --bit) {
#pragma unroll
                    for (int k = 0; k < 4; ++k) {
                        const unsigned tr = pre[k] | (1u << bit);
                        const int cge = __popcll(__ballot(u1[k] >= tr)) + __popcll(__ballot(u2[k] >= tr));
                        pre[k] = cge >= need ? tr : pre[k];
                    }
                }
            }
#pragma unroll
            for (int k = 0; k < 4; ++k) {
                const int q = 8 * wave + q0 + k;
                bool s1 = f1 || c1, s2 = f2 || c2;
                if (jhi > need) {
                    const unsigned long long g1 = __ballot(c1 && u1[k] > pre[k]), g2 = __ballot(c2 && u2[k] > pre[k]);
                    const unsigned long long e1 = __ballot(c1 && u1[k] == pre[k]), e2 = __ballot(c2 && u2[k] == pre[k]);
                    const int rem = need - (__popcll(g1) + __popcll(g2));
                    const int er1 = __builtin_amdgcn_mbcnt_hi((unsigned)(e1 >> 32), __builtin_amdgcn_mbcnt_lo((unsigned)e1, 0u));
                    const int er2 = __popcll(e1) + __builtin_amdgcn_mbcnt_hi((unsigned)(e2 >> 32), __builtin_amdgcn_mbcnt_lo((unsigned)e2, 0u));
                    s1 = f1 || (c1 && (u1[k] > pre[k] || (u1[k] == pre[k] && er1 < rem)));
                    s2 = f2 || (c2 && (u2[k] > pre[k] || (u2[k] == pre[k] && er2 < rem)));
                }
                const unsigned long long m1 = __ballot(s1), m2 = __ballot(s2);
                if (ln2 == 0) { bm[q * 4 + 0] = (unsigned)m1; bm[q * 4 + 1] = (unsigned)(m1 >> 32); bm[q * 4 + 2] = (unsigned)m2; bm[q * 4 + 3] = (unsigned)(m2 >> 32); }
            }
        }
    }
    AT_BAR();
    {
        constexpr int MB_QL = 0, MB_QP = 528, MB_KV = 33792, MB_SLOT = MB_KV + 8 * AT_TILE, MB_SP = 144, MB_SLOTL = MB_SLOT + 8 * 32 * MB_SP, MB_PERM = MB_SLOTL + 1024;
        static_assert(64 * MB_QP <= MB_KV && MB_PERM + 512 <= LDS_BYTES - 256, "mbr LDS map");
        int ln3 = lane, td3 = tid; asm volatile("" : "+v"(ln3), "+v"(td3));
        const int r32 = ln3 & 31, hi = ln3 >> 5, qi = r32 >> 2, h = r32 & 3;
        const int prow = (r32 & 0x13) | ((r32 & 8) >> 1) | ((r32 & 4) << 1);
        const int oq = td3 >> 3, oh = (td3 >> 1) & 3, ohf = td3 & 1;
        LAS unsigned char* ql = lds + MB_QL;
        LAS unsigned char* kvl = lds + MB_KV;
        LAS unsigned char* slots = lds + MB_SLOT;
        LAS float* slotl = (LAS float*)(lds + MB_SLOTL);
        LAS unsigned char* permw = lds + MB_PERM + wave * 64;
        {
            const u16* qsrc = (const u16*)(ws + WS_Q) + ((size_t)b * SEQ + 64 * qt) * 512 + 4 * g * 64;
#pragma unroll
            for (int i = 0; i < 4; ++i) { const int idx = td3 + NTHREADS * i, r = idx >> 5, pc = idx & 31; *(LAS u32x4*)(ql + r * MB_QP + pc * 16) = *(const u32x4*)(qsrc + (size_t)r * 512 + pc * 8); }
        }
        const int srow = td3 >> 3, sch = td3 & 7;
        const u16* ksrc = (const u16*)(ws + WS_KS) + (size_t)bg * SEQ * 64 + (size_t)srow * 64 + 8 * sch;
        const u16* vsrc = (const u16*)(ws + WS_VST) + (size_t)bg * 64 * SEQ + (size_t)srow * 64 + 8 * sch;
        const int sdst = srow * AT_PITCH + sch * 16;
        const int nrnd = (qt + 4) >> 2;
        u32x4 kr[4], vr[4];
#define MB_LOAD(R_) do { _Pragma("unroll") for (int bi = 0; bi < 4; ++bi) { const int jb_ = 4 * (R_) + bi; const int jc_ = jb_ <= qt ? jb_ : qt; \
            kr[bi] = *(const u32x4*)(ksrc + (size_t)jc_ * 4096); vr[bi] = *(const u32x4*)(vsrc + (size_t)jc_ * 4096); } } while (0)
#define MB_STORE() do { _Pragma("unroll") for (int bi = 0; bi < 4; ++bi) { *(LAS u32x4*)(kvl + bi * AT_TILE + sdst) = kr[bi]; *(LAS u32x4*)(kvl + (4 + bi) * AT_TILE + sdst) = vr[bi]; } } while (0)
        MB_LOAD(0);
        const unsigned mybm0 = bm[ln3 * 4 + 0], mybm1 = bm[ln3 * 4 + 1], mybm2 = bm[ln3 * 4 + 2], mybm3 = bm[ln3 * 4 + 3];
        MB_STORE();
        h16x2 oa[16]; float la = 0.f;
#pragma unroll
        for (int e = 0; e < 16; ++e) oa[e] = (h16x2){(h16)0.f, (h16)0.f};
        const u32x4 onesw = {0x3c003c00u, 0x3c003c00u, 0x3c003c00u, 0x3c003c00u};
        const int koff = prow * AT_PITCH + hi * 16, voff = 4 * AT_TILE + r32 * AT_PITCH + hi * 16;
        const unsigned blo = oq >= 32 ? 0xffffffffu : ((1u << oq) - 1u), bhi = oq >= 32 ? ((1u << (oq - 32)) - 1u) : 0u;
        const unsigned obit = 1u << (oq & 31); const bool ohigh = oq >= 32;
        AT_BAR();
        for (int R = 0; R < nrnd; ++R) {
            if (R + 1 < nrnd) MB_LOAD(R + 1);
            unsigned long long mk[4]; int cb[4], base[4]; int NI = 0;
#pragma unroll
            for (int bi = 0; bi < 4; ++bi) {
                const int j = 4 * R + bi;
                const unsigned mw = j < 32 ? mybm0 : (j < 64 ? mybm1 : (j < 96 ? mybm2 : mybm3));
                const bool bit = (j <= qt) && ((mw >> (j & 31)) & 1u);
                mk[bi] = __ballot(bit); cb[bi] = __popcll(mk[bi]); base[bi] = NI; NI += (cb[bi] + 7) >> 3;
            }
            const int nsub = (NI + 7) >> 3;
            for (int sr = 0; sr < nsub; ++sr) {
                const int it = 8 * sr + wave;
                if (it < NI) {
                    int bi = 0;
                    if (it >= base[1]) bi = 1;
                    if (it >= base[2]) bi = 2;
                    if (it >= base[3]) bi = 3;
                    const unsigned long long mkb = bi == 0 ? mk[0] : (bi == 1 ? mk[1] : (bi == 2 ? mk[2] : mk[3]));
                    const int cbb = bi == 0 ? cb[0] : (bi == 1 ? cb[1] : (bi == 2 ? cb[2] : cb[3]));
                    const int sub = it - (bi == 0 ? base[0] : (bi == 1 ? base[1] : (bi == 2 ? base[2] : base[3])));
                    const int j = 4 * R + bi;
                    const unsigned mwj = j < 32 ? mybm0 : (j < 64 ? mybm1 : (j < 96 ? mybm2 : mybm3));
                    const bool bit = (mwj >> (j & 31)) & 1u;
                    const int rank = __builtin_amdgcn_mbcnt_hi((unsigned)(mkb >> 32), __builtin_amdgcn_mbcnt_lo((unsigned)mkb, 0u));
                    if (bit) permw[rank] = (unsigned char)ln3;
                    h16x8 qf[4], kf[8];
#pragma unroll
                    for (int kh = 0; kh < 2; ++kh)
#pragma unroll
                        for (int d0 = 0; d0 < 4; ++d0) kf[kh * 4 + d0] = *(const LAS h16x8*)(kvl + bi * AT_TILE + kh * 32 * AT_PITCH + koff + d0 * 32);
                    const int slotq = 8 * sub + qi;
                    const bool valid = slotq < cbb;
                    const int q = valid ? (int)permw[slotq] : 0;
#pragma unroll
                    for (int d0 = 0; d0 < 4; ++d0) qf[d0] = *(const LAS h16x8*)(ql + q * MB_QP + h * 128 + d0 * 32 + hi * 16);
                    __builtin_amdgcn_sched_barrier(0);
                    f32x16 sx[2];
#pragma unroll
                    for (int kh = 0; kh < 2; ++kh) {
#pragma unroll
                        for (int e = 0; e < 16; ++e) sx[kh][e] = -OFF2;
#pragma unroll
                        for (int d0 = 0; d0 < 4; ++d0) sx[kh] = MFMA32H(kf[kh * 4 + d0], qf[d0], sx[kh]);
                    }
                    h16x8 vfr[8];
#pragma unroll
                    for (int dt = 0; dt < 2; ++dt)
#pragma unroll
                        for (int kk = 0; kk < 4; ++kk) vfr[dt * 4 + kk] = *(const LAS h16x8*)(kvl + bi * AT_TILE + voff + dt * 32 * AT_PITCH + kk * 32);
                    __builtin_amdgcn_sched_barrier(0);
                    const bool diag = (j == qt);
                    const unsigned vmk = valid ? 0xffffffffu : 0u;
                    u32x4 pw[4];
#pragma unroll
                    for (int kk = 0; kk < 4; ++kk) {
                        float pv[8];
#pragma unroll
                        for (int e = 0; e < 8; ++e) {
                            float pe = __builtin_amdgcn_exp2f(sx[kk >> 1][8 * (kk & 1) + e]);
                            if (diag) pe = (16 * kk + 8 * hi + e <= q) ? pe : 0.f;
                            pv[e] = pe;
                        }
                        pw[kk] = (u32x4){pkh(pv[0], pv[1]) & vmk, pkh(pv[2], pv[3]) & vmk, pkh(pv[4], pv[5]) & vmk, pkh(pv[6], pv[7]) & vmk};
                    }
                    f32x16 o[2], ol;
#pragma unroll
                    for (int e = 0; e < 16; ++e) { o[0][e] = 0.f; o[1][e] = 0.f; ol[e] = 0.f; }
#pragma unroll
                    for (int kk = 0; kk < 4; ++kk) {
                        const h16x8 pb2 = __builtin_bit_cast(h16x8, pw[kk]);
#pragma unroll
                        for (int dt = 0; dt < 2; ++dt) o[dt] = MFMA32H(vfr[dt * 4 + kk], pb2, o[dt]);
                        ol = MFMA32H(__builtin_bit_cast(h16x8, onesw), pb2, ol);
                    }
                    LAS unsigned char* sp = slots + (wave * 32 + r32) * MB_SP + hi * 8;
#pragma unroll
                    for (int dt = 0; dt < 2; ++dt)
#pragma unroll
                        for (int r4 = 0; r4 < 4; ++r4) { u32x2 w; w.x = pkh(o[dt][4 * r4], o[dt][4 * r4 + 1]); w.y = pkh(o[dt][4 * r4 + 2], o[dt][4 * r4 + 3]); *(LAS u32x2*)(sp + dt * 64 + r4 * 16) = w; }
                    if (hi == 0) slotl[wave * 32 + r32] = ol[0];
                }
                AT_BAR();
                if (sr == nsub - 1 && R + 1 < nrnd) MB_STORE();
#pragma unroll
                for (int bi = 0; bi < 4; ++bi) {
                    const unsigned mlo = (unsigned)mk[bi], mhi = (unsigned)(mk[bi] >> 32);
                    if ((ohigh ? mhi : mlo) & obit) {
                        const int rk = __builtin_popcount(mlo & blo) + __builtin_popcount(mhi & bhi);
                        const int itb = base[bi] + (rk >> 3);
                        if ((itb >> 3) == sr) {
                            const int sl = itb & 7, col = 4 * (rk & 7) + oh;
                            const LAS unsigned char* sp = slots + (sl * 32 + col) * MB_SP + ohf * 64;
#pragma unroll
                            for (int c8 = 0; c8 < 4; ++c8) {
                                const h16x8 v = *(const LAS h16x8*)(sp + c8 * 16);
#pragma unroll
                                for (int e = 0; e < 4; ++e) oa[4 * c8 + e] += (h16x2){v[2 * e], v[2 * e + 1]};
                            }
                            la += slotl[sl * 32 + col];
                        }
                    }
                }
                AT_BAR();
            }
            if (nsub == 0 && R + 1 < nrnd) { MB_STORE(); AT_BAR(); }
        }
#undef MB_LOAD
#undef MB_STORE
        {
            const size_t row = (size_t)b * SEQ + 64 * qt + oq;
            const float g1 = gates[row * 24 + (4 * g + oh) * 3 + 1];
            const float sc = g1 / la;
            const u16* owp = (const u16*)(ws + WS_OWIN) + row * 512 + (4 * g + oh) * 64 + 32 * ohf;
            u16* yp = (u16*)(ws + WS_Y) + row * DM + (4 * g + oh) * 64 + 32 * ohf;
            float ssq = 0.f;
#pragma unroll
            for (int c8 = 0; c8 < 4; ++c8) {
                const h16x8 cw = *(const h16x8*)(yp + 8 * c8), ww = *(const h16x8*)(owp + 8 * c8);
                float y[8];
#pragma unroll
                for (int e = 0; e < 8; ++e) { y[e] = (float)oa[4 * c8 + (e >> 1)][e & 1] * sc + (float)cw[e] + (float)ww[e]; ssq += y[e] * y[e]; }
                const u32x4 w = {pkh(y[0], y[1]), pkh(y[2], y[3]), pkh(y[4], y[5]), pkh(y[6], y[7])};
                *(u32x4*)(yp + 8 * c8) = w;
            }
            ssq += __shfl_xor(ssq, 1); ssq += __shfl_xor(ssq, 2); ssq += __shfl_xor(ssq, 4);
            if ((td3 & 7) == 0) ((float*)(ws + WS_SSQ))[row * 2 + g] = ssq;
        }
    }
    __syncthreads();
}

__device__ __forceinline__ void nsa_finalize_unit(unsigned char* ws, const float* gain, int u, int wave, int lane) {
    const f32x4 g0 = *(const f32x4*)(gain + 8 * lane), g1 = *(const f32x4*)(gain + 8 * lane + 4);
#pragma unroll 1
    for (int i0 = 0; i0 < 16; i0 += 8) {
        f32x2 sq[8]; h16x8 v[8];
#pragma unroll
        for (int i = 0; i < 8; ++i) {
            const size_t row = (size_t)u * 128 + wave * 16 + i0 + i;
            sq[i] = *(const f32x2*)((const float*)(ws + WS_SSQ) + row * 2);
            v[i] = *(const h16x8*)((const u16*)(ws + WS_Y) + row * DM + 8 * lane);
        }
#pragma unroll
        for (int i = 0; i < 8; ++i) {
            const size_t row = (size_t)u * 128 + wave * 16 + i0 + i;
            const float rs = 1.0f / sqrtf((sq[i][0] + sq[i][1]) * (1.0f / 512.f) + EPS);
            u32x4 w;
            w.x = pkh((float)v[i][0] * rs * g0[0], (float)v[i][1] * rs * g0[1]); w.y = pkh((float)v[i][2] * rs * g0[2], (float)v[i][3] * rs * g0[3]);
            w.z = pkh((float)v[i][4] * rs * g1[0], (float)v[i][5] * rs * g1[1]); w.w = pkh((float)v[i][6] * rs * g1[2], (float)v[i][7] * rs * g1[3]);
            *(u32x4*)((u16*)(ws + WS_Y) + row * DM + 8 * lane) = w;
        }
    }
}
constexpr int HG_LFP = 129;
constexpr int HG_OFF_LF = 0, HG_OFF_SEG = 33024, HG_OFF_KT = 35072, HG_OFF_VT = 35072 + 18432;
constexpr int H3_OFF_QT = 35072, H3_OFF_KH = H3_OFF_QT + 17408, H3_OFF_VT = H3_OFF_KH + 17408, H3_OFF_SSQ = H3_OFF_VT + 18432;
static_assert(H3_OFF_SSQ + 256 <= LDS_BYTES, "hgrn LDS map");

__device__ __forceinline__ void hg_load_logf(const unsigned char* ws, LAS float* lf, size_t row0, int h, int tid) {
#pragma unroll
    for (int i = 0; i < 2; ++i) {
        const int idx = tid + NTHREADS * i, s = idx >> 4, ch = idx & 15;
        const h16x8 v = *(const h16x8*)((const u16*)(ws + WS_HLOGF) + (row0 + s) * 512 + h * 128 + 8 * ch);
#pragma unroll
        for (int e = 0; e < 8; ++e) lf[s * HG_LFP + 8 * ch + e] = (float)v[e];
    }
}
__device__ __forceinline__ void hg_stage_vt(const unsigned char* ws, LAS u16* vt, size_t row0, int h, int tid) {
#pragma unroll
    for (int i = 0; i < 2; ++i) {
        const int idx = tid + NTHREADS * i, s = idx & 63, ch = idx >> 6;
        const s16x8 v = *(const s16x8*)((const u16*)(ws + WS_HV) + (row0 + s) * 512 + h * 128 + 8 * ch);
#pragma unroll
        for (int e = 0; e < 8; ++e) vt[(8 * ch + e) * 72 + s] = (u16)v[e];
    }
}

__device__ __forceinline__ void hgrn_h1_units(unsigned char* ws, LAS unsigned char* lds, int u0, int stride, int nu, int wave, int lane) {
    if (u0 >= nu) return;
    const int tid = threadIdx.x, r32 = lane & 31, hi = lane >> 5;
    LAS float* lf = (LAS float*)(lds + HG_OFF_LF);
    LAS float* seg = (LAS float*)(lds + HG_OFF_SEG);
    LAS u16* kt = (LAS u16*)(lds + HG_OFF_KT);
    LAS u16* vt = (LAS u16*)(lds + HG_OFF_VT);
    h16x8 lfr[2]; s16x8 vvr[2];
#define H1_LOAD(uu) do { const int c_ = (uu) & 127, bh_ = (uu) >> 7; const size_t r0_ = (size_t)(bh_ >> 2) * SEQ + 64 * c_; const int h_ = bh_ & 3; \
        _Pragma("unroll") for (int i = 0; i < 2; ++i) { const int idx = tid + NTHREADS * i; \
            lfr[i] = *(const h16x8*)((const u16*)(ws + WS_HLOGF) + (r0_ + (idx >> 4)) * 512 + h_ * 128 + 8 * (idx & 15)); \
            vvr[i] = *(const s16x8*)((const u16*)(ws + WS_HV) + (r0_ + (idx & 63)) * 512 + h_ * 128 + 8 * (idx >> 6)); } } while (0)
    H1_LOAD(u0);
    for (int u = u0; u < nu; u += stride) {
        const int c = u & 127, bh = u >> 7;
#pragma unroll
        for (int i = 0; i < 2; ++i) {
            const int idx = tid + NTHREADS * i;
            { const int s = idx >> 4, ch = idx & 15;
#pragma unroll
              for (int e = 0; e < 8; ++e) lf[s * HG_LFP + 8 * ch + e] = (float)lfr[i][e]; }
            { const int s = idx & 63, ch = idx >> 6;
#pragma unroll
              for (int e = 0; e < 8; ++e) vt[(8 * ch + e) * 72 + s] = (u16)vvr[i][e]; }
        }
        if (u + stride < nu) H1_LOAD(u + stride);
        AT_BAR();
        const int d = tid & 127, sg = tid >> 7;
        float lg[16]; float tot = 0.f;
#pragma unroll
        for (int i = 0; i < 16; ++i) { lg[i] = lf[(16 * sg + i) * HG_LFP + d]; tot += lg[i]; }
        seg[sg * 128 + d] = tot;
        AT_BAR();
        {
            float R = 0.f;
            for (int s2 = sg + 1; s2 < 4; ++s2) R += seg[s2 * 128 + d];
#pragma unroll
            for (int i = 15; i >= 0; --i) {
                const float ke = (1.0f - __expf(lg[i])) * __expf(R);
                kt[d * 72 + 16 * sg + i] = f2b(ke);
                R += lg[i];
            }
            if (sg == 0) ((float*)(ws + WS_HD))[((size_t)bh * 128 + c) * 128 + d] = __expf(R);
        }
        AT_BAR();
        {
            const int vtile = wave & 3;
            s16x8 bfr[4];
#pragma unroll
            for (int ks = 0; ks < 4; ++ks) bfr[ks] = *(const LAS s16x8*)(vt + (32 * vtile + r32) * 72 + 16 * ks + 8 * hi);
            u16* dst = (u16*)(ws + WS_HL) + (((size_t)bh * 128 + c) * 128 + 32 * vtile + r32) * 128;
#pragma unroll
            for (int dd = 0; dd < 2; ++dd) {
                const int dtile = 2 * (wave >> 2) + dd;
                f32x16 acc;
#pragma unroll
                for (int i = 0; i < 16; ++i) acc[i] = 0.f;
                s16x8 afr[4];
#pragma unroll
                for (int ks = 0; ks < 4; ++ks) afr[ks] = *(const LAS s16x8*)(kt + (32 * dtile + r32) * 72 + 16 * ks + 8 * hi);
#pragma unroll
                for (int ks = 0; ks < 4; ++ks) acc = MFMA32B(afr[ks], bfr[ks], acc);
#pragma unroll
                for (int r4 = 0; r4 < 4; ++r4) {
                    u32x2 w; w.x = pkb(acc[4 * r4], acc[4 * r4 + 1]); w.y = pkb(acc[4 * r4 + 2], acc[4 * r4 + 3]);
                    *(u32x2*)(dst + 32 * dtile + 8 * r4 + 4 * hi) = w;
                }
            }
        }
        AT_BAR();
    }
#undef H1_LOAD
}

__device__ __forceinline__ void hgrn_h2_unit(unsigned char* ws, int u, int wave, int lane) {
    if (wave >= 2) return;
    const int gt = u * 128 + wave * 64 + lane;
    const int bh = gt >> 12, v = (gt >> 5) & 127, d0 = 4 * (gt & 31);
    const u16* lp = (const u16*)(ws + WS_HL) + ((size_t)bh * 128 * 128 + v) * 128 + d0;
    u16* sp = (u16*)(ws + WS_HS) + ((size_t)bh * 128 * 128 + v) * 128 + d0;
    const float* dp = (const float*)(ws + WS_HD) + (size_t)bh * 128 * 128 + d0;
    float S0 = 0.f, S1 = 0.f, S2 = 0.f, S3 = 0.f;
#pragma unroll 1
    for (int c0 = 0; c0 < 128; c0 += 16) {
        u32x2 lw[16]; f32x4 dv[16];
#pragma unroll
        for (int i = 0; i < 16; ++i) { lw[i] = *(const u32x2*)(lp + (size_t)(c0 + i) * 16384); dv[i] = *(const f32x4*)(dp + (c0 + i) * 128); }
#pragma unroll
        for (int i = 0; i < 16; ++i) {
            u32x2 w; w.x = pkb(S0, S1); w.y = pkb(S2, S3);
            *(u32x2*)(sp + (size_t)(c0 + i) * 16384) = w;
            S0 = dv[i][0] * S0 + __builtin_bit_cast(float, lw[i].x << 16); S1 = dv[i][1] * S1 + __builtin_bit_cast(float, lw[i].x & 0xffff0000u);
            S2 = dv[i][2] * S2 + __builtin_bit_cast(float, lw[i].y << 16); S3 = dv[i][3] * S3 + __builtin_bit_cast(float, lw[i].y & 0xffff0000u);
        }
    }
}

constexpr int H3_OFF_QR = H3_OFF_SSQ + 256;
static_assert(H3_OFF_QR + 64 * 136 * 2 <= LDS_BYTES - 256, "hgrn h3 LDS map");
__device__ __forceinline__ void hgrn_h3_units(unsigned char* ws, LAS unsigned char* lds, const float* ogain, int u0, int stride, int nu, int wave, int lane) {
    if (u0 >= nu) return;
    const int tid = threadIdx.x, r32 = lane & 31, hi = lane >> 5;
    LAS float* lf = (LAS float*)(lds + HG_OFF_LF);
    LAS float* seg = (LAS float*)(lds + HG_OFF_SEG);
    LAS u16* qt = (LAS u16*)(lds + H3_OFF_QT);
    LAS u16* kh = (LAS u16*)(lds + H3_OFF_KH);
    LAS u16* vt = (LAS u16*)(lds + H3_OFF_VT);
    LAS float* ssq = (LAS float*)(lds + H3_OFF_SSQ);
    LAS u16* qr = (LAS u16*)(lds + H3_OFF_QR);
    h16x8 lfr[2]; s16x8 vvr[2], qqr[2];
#define H3_LOAD(uu) do { const int c_ = (uu) & 127, bh_ = (uu) >> 7; const size_t r0_ = (size_t)(bh_ >> 2) * SEQ + 64 * c_; const int h_ = bh_ & 3; \
        _Pragma("unroll") for (int i = 0; i < 2; ++i) { const int idx = tid + NTHREADS * i; \
            lfr[i] = *(const h16x8*)((const u16*)(ws + WS_HLOGF) + (r0_ + (idx >> 4)) * 512 + h_ * 128 + 8 * (idx & 15)); \
            qqr[i] = *(const s16x8*)((const u16*)(ws + WS_HQ) + (r0_ + (idx >> 4)) * 512 + h_ * 128 + 8 * (idx & 15)); \
            vvr[i] = *(const s16x8*)((const u16*)(ws + WS_HV) + (r0_ + (idx & 63)) * 512 + h_ * 128 + 8 * (idx >> 6)); } } while (0)
    H3_LOAD(u0);
    for (int u = u0; u < nu; u += stride) {
        const int c = u & 127, bh = u >> 7, b = bh >> 2, h = bh & 3;
        const size_t row0 = (size_t)b * SEQ + 64 * c;
#pragma unroll
        for (int i = 0; i < 2; ++i) {
            const int idx = tid + NTHREADS * i;
            { const int s = idx >> 4, ch = idx & 15;
#pragma unroll
              for (int e = 0; e < 8; ++e) lf[s * HG_LFP + 8 * ch + e] = (float)lfr[i][e];
              *(LAS s16x8*)(qr + s * 136 + 8 * ch) = qqr[i]; }
            { const int s = idx & 63, ch = idx >> 6;
#pragma unroll
              for (int e = 0; e < 8; ++e) vt[(8 * ch + e) * 72 + s] = (u16)vvr[i][e]; }
        }
        if (tid < 64) ssq[tid] = 0.f;
        if (u + stride < nu) H3_LOAD(u + stride);
        s16x8 sfr[8];
        {
            const u16* sp = (const u16*)(ws + WS_HS) + (((size_t)bh * 128 + c) * 128 + 32 * (wave >> 1) + r32) * 128 + 8 * hi;
#pragma unroll
            for (int ks = 0; ks < 8; ++ks) sfr[ks] = *(const s16x8*)(sp + 16 * ks);
        }
        AT_BAR();
        const int d = tid & 127, sg = tid >> 7;
        float lg[16]; float tot = 0.f;
#pragma unroll
        for (int i = 0; i < 16; ++i) { lg[i] = lf[(16 * sg + i) * HG_LFP + d]; tot += lg[i]; }
        seg[sg * 128 + d] = tot;
        AT_BAR();
        {
            float Bc = 0.f;
            for (int s2 = 0; s2 < sg; ++s2) Bc += seg[s2 * 128 + d];
#pragma unroll
            for (int i = 0; i < 16; ++i) {
                Bc += lg[i];
                const float qv = b2f(qr[(16 * sg + i) * 136 + d]);
                qt[(16 * sg + i) * 136 + d] = f2b(qv * __expf(Bc));
                kh[(16 * sg + i) * 136 + d] = f2b((1.0f - __expf(lg[i])) * __expf(fminf(-Bc, 80.f)));
            }
        }
        AT_BAR();
        {
            const int th = wave & 1, vtile = wave >> 1;
            s16x8 qf[8];
#pragma unroll
            for (int ks = 0; ks < 8; ++ks) qf[ks] = *(const LAS s16x8*)(qt + (32 * th + r32) * 136 + 16 * ks + 8 * hi);
            f32x16 acc;
#pragma unroll
            for (int i = 0; i < 16; ++i) acc[i] = 0.f;
            {
#pragma unroll
                for (int ks = 0; ks < 8; ++ks) acc = MFMA32B(sfr[ks], qf[ks], acc);
            }
            const int prow = (r32 & 0x13) | ((r32 & 8) >> 1) | ((r32 & 4) << 1);
            for (int sh = 0; sh <= th; ++sh) {
                f32x16 x;
#pragma unroll
                for (int i = 0; i < 16; ++i) x[i] = 0.f;
                s16x8 kfr[8], vfr2[2];
#pragma unroll
                for (int ks = 0; ks < 8; ++ks) kfr[ks] = *(const LAS s16x8*)(kh + (32 * sh + prow) * 136 + 16 * ks + 8 * hi);
#pragma unroll
                for (int sp2 = 0; sp2 < 2; ++sp2) vfr2[sp2] = *(const LAS s16x8*)(vt + (32 * vtile + r32) * 72 + 32 * sh + 16 * sp2 + 8 * hi);
#pragma unroll
                for (int ks = 0; ks < 8; ++ks) x = MFMA32B(kfr[ks], qf[ks], x);
                u32x4 pw[2];
#pragma unroll
                for (int sp2 = 0; sp2 < 2; ++sp2) {
                    float xv[8];
#pragma unroll
                    for (int e = 0; e < 8; ++e) { const int sin_ = 16 * sp2 + 8 * hi + e; const bool ok = (sh < th) || (sin_ <= r32); xv[e] = ok ? x[8 * sp2 + e] : 0.f; }
                    pw[sp2] = (u32x4){pkb(xv[0], xv[1]), pkb(xv[2], xv[3]), pkb(xv[4], xv[5]), pkb(xv[6], xv[7])};
                }
#pragma unroll
                for (int sp2 = 0; sp2 < 2; ++sp2) acc = MFMA32B(vfr2[sp2], __builtin_bit_cast(s16x8, pw[sp2]), acc);
            }
            const int t = 32 * th + r32;
            const u16* gp = (const u16*)(ws + WS_HG) + (row0 + t) * 512 + h * 128 + 32 * vtile + 4 * hi;
            u32x2 gw4[4];
#pragma unroll
            for (int r4 = 0; r4 < 4; ++r4) gw4[r4] = *(const u32x2*)(gp + 8 * r4);
            float sq = 0.f;
#pragma unroll
            for (int i = 0; i < 16; ++i) sq += acc[i] * acc[i];
            sq += __shfl_xor(sq, 32);
            if (hi == 0) (void)__hip_atomic_fetch_add(ssq + t, sq, __ATOMIC_RELAXED, __HIP_MEMORY_SCOPE_WORKGROUP);
            AT_BAR();
            const float rs = 1.0f / sqrtf(ssq[t] * (1.0f / 128.f) + EPS);
            u16* yp = (u16*)(ws + WS_Y) + (row0 + t) * DM + 512 + h * 128 + 32 * vtile + 4 * hi;
            const float* gn = ogain + 32 * vtile + 4 * hi;
#pragma unroll
            for (int r4 = 0; r4 < 4; ++r4) {
                const h16x4 gv = __builtin_bit_cast(h16x4, gw4[r4]);
                const f32x4 gg = *(const f32x4*)(gn + 8 * r4);
                u32x2 w;
                w.x = pkh(acc[4 * r4] * rs * gg[0] * (float)gv[0], acc[4 * r4 + 1] * rs * gg[1] * (float)gv[1]);
                w.y = pkh(acc[4 * r4 + 2] * rs * gg[2] * (float)gv[2], acc[4 * r4 + 3] * rs * gg[3] * (float)gv[3]);
                *(u32x2*)(yp + 8 * r4) = w;
            }
        }
        AT_BAR();
    }
#undef H3_LOAD
}
__global__ void __launch_bounds__(NTHREADS, 2) mk_fwd(Params p) {
    extern __shared__ __attribute__((aligned(16))) unsigned char lds_raw[];
    LAS unsigned char* lds = (LAS unsigned char*)lds_raw;
    const int tid = threadIdx.x, lane = tid & 63, wave = __builtin_amdgcn_readfirstlane(tid >> 6);
    const int G = gridDim.x, bx = blockIdx.x;
    const int vcu = (G % 8 == 0) ? (bx % 8) * (G / 8) + bx / 8 : bx;
    const int gw = vcu * NWAVES + wave, NGW = G * NWAVES;
    unsigned char* ws = p.ws;
#define IN(k) (p.ph_lo <= (k) && (k) < p.ph_hi)
    volatile LAS unsigned* xst = (volatile LAS unsigned*)(lds + LDS_BYTES - 256);
    unsigned* barw = (unsigned*)(ws + WS_CTL);
    XcdBarrier xbar; xbar.bar = barw; xbar.x = 0; xbar.st = xst;
    const bool fused = (p.ph_hi - p.ph_lo) > 1;
    if (fused) {
        if (tid < 2) xst[tid] = 0u;
        __syncthreads();
        xbar = xcd_barrier_post(barw, xst);
    }
#define SEAM(k) do { if (IN(k) && IN((k) + 1)) xcd_barrier(xbar); } while (0)

    if (IN(0)) { p0_prologue(p, lds, gw, NGW, wave, lane); }
    SEAM(0);
    if (IN(1)) {
        pg8::Gemm g{(const u16*)(ws + WS_XH), (const u16*)(ws + WS_WIN_T), MT, DINP, DM}; pg8::StaticOrder S; S.init(MT, DINP, G, bx);
        pg8::EpiInProj E{ws, p.in[3], p.in[4]};
        pg8::gemm_phase<pg8::EpiInProj, pg8::StaticOrder, true, true>(lds, g, S, E, wave);
        const int nfull = (MT / 256) * (DINP / 256) - 3 * G;
        if (nfull < 0 || nfull >= G) p0_late_transposes(p, lds, gw, NGW, wave, lane);
        else if (bx >= nfull) p0_late_transposes(p, lds, (bx - nfull) * NWAVES + wave, (G - nfull) * NWAVES, wave, lane);
    }
    SEAM(1);
    if (IN(2)) {
        constexpr int NU_WIN = 512, NU_CMP = 256, NU_H1 = 1024;
        for (int u = bx; u < NU_WIN + NU_CMP + NU_H1; u += G) {
            if (u < NU_WIN) win_unit(ws, lds, u, wave, lane);
            else if (u < NU_WIN + NU_CMP) cmp_mlp_unit(ws, lds, u - NU_WIN, wave, lane);
            else { hgrn_h1_units(ws, lds, u - NU_WIN - NU_CMP, G, NU_H1, wave, lane); break; }
        }
    }
    SEAM(2);
    if (IN(3)) {
        for (int v = bx; v < 512 + 256; v += G) {
            if (v < 512) {
                int bg, qt;
                if (G == 256) { const int c = v & 255, mem = (c & 1) * 32 + (c >> 3); bg = (c & 7) >> 1; qt = (v < 256) ? mem : 127 - mem; }
                else { const int vv = v & 255; bg = vv >> 6; qt = (v < 256) ? (vv & 63) : 127 - (vv & 63); }
                nsa_unit(ws, lds, bg, qt, wave, lane);
            }
            else hgrn_h2_unit(ws, v - 512, wave, lane);
        }
    }
    SEAM(3);
    if (IN(4)) {
        for (int u = bx; u < 128 + 1024; u += G) {
            if (u < 128) nsa_finalize_unit(ws, p.in[11], u, wave, lane);
            else { hgrn_h3_units(ws, lds, p.in[13], u - 128, G, 1024, wave, lane); break; }
        }
    }
    SEAM(4);
    if (IN(5)) {
        pg8::Gemm g{(const u16*)(ws + WS_Y), (const u16*)(ws + WS_WOUT_T), MT, DM, DM}; pg8::StaticOrder S; S.init(MT, DM, G, bx);
        pg8::EpiOutProj E{p.in[0], (u16*)(ws + WS_X1H), (float*)(ws + WS_SSQ1)};
        pg8::gemm_phase<pg8::EpiOutProj, pg8::StaticOrder, true, true>(lds, g, S, E, wave);
    }
    SEAM(5);
    if (IN(6)) {
        pg8::Gemm g{(const u16*)(ws + WS_X1H), (const u16*)(ws + WS_W1_T), MT, FF, DM}; pg8::StaticOrder S; S.init(MT, FF, G, bx);
        pg8::EpiUp E{(u16*)(ws + WS_HID), (const float*)(ws + WS_SSQ1)};
        pg8::gemm_phase<pg8::EpiUp, pg8::StaticOrder, true, true>(lds, g, S, E, wave);
    }
    SEAM(6);
    if (IN(7)) {
        pg8::Gemm g{(const u16*)(ws + WS_HID), (const u16*)(ws + WS_W2_T), MT, DM, FF}; pg8::StaticOrder S; S.init(MT, DM, G, bx);
        pg8::EpiDown E{p.out, (const u16*)(ws + WS_X1H)};
        pg8::gemm_phase<pg8::EpiDown, pg8::StaticOrder, true, true>(lds, g, S, E, wave);
    }
#undef IN
#undef SEAM
}
static int g_grid = 0;
extern "C" void kernel_launch(void* const* d_in, const int* in_sizes, int n_in, void* d_out, int out_size, void* d_ws, size_t ws_size, hipStream_t stream) {
    if (g_grid == 0) {
        int dev = 0, cus = 0, per_cu = 0;
        (void)hipGetDevice(&dev); (void)hipDeviceGetAttribute(&cus, hipDeviceAttributeMultiprocessorCount, dev);
        (void)hipFuncSetAttribute((const void*)mk_fwd, hipFuncAttributeMaxDynamicSharedMemorySize, LDS_BYTES);
        if (hipOccupancyMaxActiveBlocksPerMultiprocessor(&per_cu, (const void*)mk_fwd, NTHREADS, LDS_BYTES) != hipSuccess || per_cu < 1) { per_cu = 1; (void)hipGetLastError(); }
        if (cus <= 0) cus = 256;
        g_grid = cus;
    }
    Params P{};
    for (int i = 0; i < 18; ++i) P.in[i] = (const float*)d_in[i];
    P.out = (float*)d_out; P.ws = (unsigned char*)d_ws;
    for (int i = 0; i < 8; ++i) P.invf[i] = (float)pow(500000.0, -(double)(2 * i) / 16.0);
    P.ph_lo = 0; P.ph_hi = 8;
    (void)hipMemsetAsync((char*)d_ws + WS_CTL, 0, XCD_BAR_WORDS * sizeof(unsigned), stream);
    void* args[] = {&P};
    hipError_t e = hipLaunchCooperativeKernel((const void*)mk_fwd, dim3(g_grid), dim3(NTHREADS), args, LDS_BYTES, stream);
    if (e != hipSuccess) fprintf(stderr, "cooperative launch failed: %s (grid %d)\n", hipGetErrorString(e), g_grid);
}
```

```cpp
#include <hip/hip_runtime.h>
#include <hip/hip_cooperative_groups.h>
#include <cstdio>
#include <cstdint>
#include <cmath>
namespace cg = cooperative_groups;

#define LAS __attribute__((address_space(3)))
typedef _Float16 h16;
typedef _Float16 h16x2 __attribute__((ext_vector_type(2)));
typedef _Float16 h16x4 __attribute__((ext_vector_type(4)));
typedef _Float16 h16x8 __attribute__((ext_vector_type(8)));
typedef __bf16 b16x2 __attribute__((ext_vector_type(2)));
typedef __bf16 b16x8 __attribute__((ext_vector_type(8)));
typedef short s16x8 __attribute__((ext_vector_type(8)));
typedef short s16x4 __attribute__((ext_vector_type(4)));
typedef float f32x2 __attribute__((ext_vector_type(2)));
typedef float f32x4 __attribute__((ext_vector_type(4)));
typedef float f32x16 __attribute__((ext_vector_type(16)));
typedef unsigned u32x2 __attribute__((ext_vector_type(2)));
typedef unsigned u32x4 __attribute__((ext_vector_type(4)));
typedef unsigned short u16;

__device__ __forceinline__ unsigned pkh(float lo, float hi) { f32x2 v = {lo, hi}; h16x2 h = __builtin_convertvector(v, h16x2); return __builtin_bit_cast(unsigned, h); }
__device__ __forceinline__ unsigned pkb(float lo, float hi) { f32x2 v = {lo, hi}; b16x2 h = __builtin_convertvector(v, b16x2); return __builtin_bit_cast(unsigned, h); }
__device__ __forceinline__ float h2f(u16 v) { return (float)__builtin_bit_cast(h16, v); }
__device__ __forceinline__ float b2f(u16 v) { return __builtin_bit_cast(float, (unsigned)v << 16); }
__device__ __forceinline__ u16 f2h(float f) { return __builtin_bit_cast(u16, (h16)f); }
__device__ __forceinline__ u16 f2b(float f) { return (u16)(pkb(f, 0.f) & 0xffffu); }
__device__ __forceinline__ float wave_sum(float v) {
#pragma unroll
    for (int o = 1; o < 64; o <<= 1) v += __shfl_xor(v, o);
    return v;
}
__device__ __forceinline__ float sigmoid_f(float x) { return __builtin_amdgcn_rcpf(1.f + __expf(-x)); }

constexpr int BATCH = 2, SEQ = 8192, DM = 1024, MT = BATCH * SEQ, DIN = 3352, DINP = 3584, FF = 4096;
constexpr int NG = 2, HPG = 4, HD = 64, NQH = 8;
constexpr int NCMP = 511, NSLC = 128, NTOP = 16, WINDOW = 512;
constexpr int HGH = 4, HGD = 128;
constexpr float EPS = 1e-6f;
constexpr int C_Q = 0, C_KC = 512, C_VC = 640, C_KS = 768, C_VS = 896, C_KW = 1024, C_VW = 1152, C_GATE = 1280,
              C_HQ = 1304, C_HF = 1816, C_HI = 2328, C_HG = 2840;

constexpr size_t MiB = 1u << 20;
constexpr size_t WS_CTL = 0;
constexpr size_t WS_WIN_T = 1 * MiB;
constexpr size_t WS_WOUT_T = 8 * MiB;
constexpr size_t WS_W1_T = 10 * MiB;
constexpr size_t WS_W2_T = 18 * MiB;
constexpr size_t WS_CW1K_T = 26 * MiB;
constexpr size_t WS_CW1V_T = 26 * MiB + 512 * 1024;
constexpr size_t WS_CW2K_T = 27 * MiB;
constexpr size_t WS_CW2V_T = 27 * MiB + 16 * 1024;
constexpr size_t WS_PEK = 27 * MiB + 32 * 1024;
constexpr size_t WS_PEV = 27 * MiB + 40 * 1024;
constexpr size_t WS_LB = 27 * MiB + 48 * 1024;
constexpr size_t WS_ROPE = 27 * MiB + 256 * 1024;
constexpr size_t WS_XH = 28 * MiB;
constexpr size_t WS_HL = 28 * MiB;
constexpr size_t WS_X1H = 28 * MiB;
constexpr size_t WS_Q = 60 * MiB;
constexpr size_t WS_KC = 76 * MiB;
constexpr size_t WS_KS = 80 * MiB;
constexpr size_t WS_KW = 84 * MiB;
constexpr size_t WS_VC = 88 * MiB;
constexpr size_t WS_VST = 92 * MiB;
constexpr size_t WS_VWT = 96 * MiB;
constexpr size_t WS_GATES = 100 * MiB;
constexpr size_t WS_KCMP = 101 * MiB + 512 * 1024;
constexpr size_t WS_VCMPT = 101 * MiB + 768 * 1024;
constexpr size_t WS_HD = 102 * MiB;
constexpr size_t WS_SSQ = 102 * MiB + 512 * 1024;
constexpr size_t WS_SSQ1 = 103 * MiB;
constexpr size_t WS_HQ = 104 * MiB;
constexpr size_t WS_HLOGF = 120 * MiB;
constexpr size_t WS_HV = 136 * MiB;
constexpr size_t WS_HG = 152 * MiB;
constexpr size_t WS_OWIN = 168 * MiB;
constexpr size_t WS_HS = 184 * MiB;
constexpr size_t WS_Y = 216 * MiB;
constexpr size_t WS_HID = 104 * MiB;
constexpr size_t WS_END = 256 * MiB;

constexpr int NWAVES = 8, NTHREADS = 512;
constexpr int LDS_BYTES = 147456;

#define MK_LANE() ((int)__builtin_amdgcn_mbcnt_hi(~0u, __builtin_amdgcn_mbcnt_lo(~0u, 0u)))
namespace pg8 {
#define PG8_LAS __attribute__((address_space(3)))
typedef unsigned short bf16_t;
typedef short bf16x8 __attribute__((ext_vector_type(8)));
typedef float f32x4 __attribute__((ext_vector_type(4)));
typedef unsigned u32x4 __attribute__((ext_vector_type(4)));
constexpr int BM = 256, BK = 64, HALF = 128, HTB = HALF * BK * 2  , STAGE_BYTES = 8 * HTB, NXCD = 8, WGM = 8;

__host__ __device__ __forceinline__ int lds_byte(int r, int c) { const int st = (r >> 4) * 2 + (c >> 5), rr = r & 15, cc = c & 31, ob = rr * 64 + cc * 2; return st * 1024 + (ob ^ (((ob >> 9) & 1) << 5)); }
__host__ __device__ __forceinline__ void stage_rc(int b, int& R, int& C) { const int st = b / 1024, sb = b % 1024, swz = sb ^ (((sb >> 9) & 1) << 5); R = (st >> 1) * 16 + swz / 64; C = (st & 1) * 32 + (swz % 64) / 2; }
__host__ __device__ __forceinline__ int perm32(int rho) { const int n = rho >> 4, i = rho & 15; return 8 * (i >> 2) + 4 * n + (i & 3); }

struct Unit { int pm, pn; };
struct Gemm { const bf16_t* A; const bf16_t* Bt; int M, N, K; };

struct StaticOrder {
    int nM, nN, nwg, G, c;
    __host__ __device__ void init(int M, int N, int G_, int c_) { nM = M / BM; nN = N / BM; nwg = nM * nN; G = G_; c = c_; }
    __host__ __device__ bool next(int i, Unit& u) const {
        const long L = (long)i * G + c; if (L >= nwg) return false;
        int wgid = (int)L; { const int q = nwg / NXCD, r = nwg % NXCD, xcd = wgid % NXCD, off = wgid / NXCD; wgid = (xcd < r ? xcd * (q + 1) : r * (q + 1) + (xcd - r) * q) + off; }
        const int nig = WGM * nN, gid = wgid / nig, fm = gid * WGM, gsz = (nM - fm) < WGM ? (nM - fm) : WGM;
        u.pm = fm + ((wgid % nig) % gsz); u.pn = (wgid % nig) / gsz; return true;
    }
    __device__ __forceinline__ void a_ready(const Unit&) const {}
    __device__ __forceinline__ void done(const Unit&) const {}
};

#define PG8_MFMA(a, b, c) __builtin_amdgcn_mfma_f32_16x16x32_f16(__builtin_bit_cast(h16x8, (a)), __builtin_bit_cast(h16x8, (b)), (c), 0, 0, 0)
struct EpiOutProj {
    static constexpr bool PERM = false, AFTER_DRAIN = false;
    const float* x; u16* x1h; float* ssq1;
    __device__ __forceinline__ void operator()(const f32x4 (&acc)[2][2][4][2], const Unit& u, int wr, int wc, int fr, int fq) const {
        const int col0 = u.pn * BM + wc * 32 + 4 * fq;
#pragma unroll
        for (int ai = 0; ai < 2; ++ai) {
            f32x4 xr[4][2][2];
#pragma unroll
            for (int m = 0; m < 4; ++m) {
                const size_t off = (size_t)(u.pm * BM + ai * HALF + wr * 64 + m * 16 + fr) * DM + col0;
#pragma unroll
                for (int bj = 0; bj < 2; ++bj)
#pragma unroll
                    for (int n = 0; n < 2; ++n) xr[m][bj][n] = *(const f32x4*)(x + off + bj * HALF + n * 16);
            }
#pragma unroll
            for (int m = 0; m < 4; ++m) {
                const int row = u.pm * BM + ai * HALF + wr * 64 + m * 16 + fr;
                const size_t off = (size_t)row * DM + col0;
                float ss = 0.f;
#pragma unroll
                for (int bj = 0; bj < 2; ++bj)
#pragma unroll
                    for (int n = 0; n < 2; ++n) {
                        const f32x4 v = acc[ai][bj][m][n] + xr[m][bj][n];
                        u32x2 w; w.x = pkh(v[0], v[1]); w.y = pkh(v[2], v[3]);
                        *(u32x2*)(x1h + off + bj * HALF + n * 16) = w;
                        ss += (v[0] * v[0] + v[1] * v[1]) + (v[2] * v[2] + v[3] * v[3]);
                    }
                ss += __shfl_xor(ss, 16); ss += __shfl_xor(ss, 32);
                if (fq == 0) ssq1[(size_t)row * 16 + u.pn * 4 + wc] = ss;
            }
        }
    }
};
struct EpiUp {
    static constexpr bool PERM = true, AFTER_DRAIN = false;
    u16* hid; const float* ssq1;
    __device__ __forceinline__ void operator()(const f32x4 (&acc)[2][2][4][2], const Unit& u, int wr, int wc, int fr, int fq) const {
        const int col0 = u.pn * BM + wc * 32 + 8 * fq;
#pragma unroll
        for (int ai = 0; ai < 2; ++ai)
#pragma unroll
            for (int mp = 0; mp < 4; mp += 2) {
                f32x4 sv[2][4];
#pragma unroll
                for (int mm = 0; mm < 2; ++mm) { const f32x4* sp = (const f32x4*)(ssq1 + (size_t)(u.pm * BM + ai * HALF + wr * 64 + (mp + mm) * 16 + fr) * 16);
#pragma unroll
                    for (int q4 = 0; q4 < 4; ++q4) sv[mm][q4] = sp[q4]; }
#pragma unroll
                for (int mm = 0; mm < 2; ++mm) {
                    const int m = mp + mm;
                    const int row = u.pm * BM + ai * HALF + wr * 64 + m * 16 + fr;
                    float tot = 0.f;
#pragma unroll
                    for (int q4 = 0; q4 < 4; ++q4) tot += (sv[mm][q4][0] + sv[mm][q4][1]) + (sv[mm][q4][2] + sv[mm][q4][3]);
                    const float rs = __builtin_amdgcn_rsqf(tot * (1.0f / DM) + EPS);
                    u16* rowp = hid + (size_t)row * FF + col0;
#pragma unroll
                    for (int bj = 0; bj < 2; ++bj) {
                        f32x4 v0 = acc[ai][bj][m][0] * rs, v1 = acc[ai][bj][m][1] * rs;
#pragma unroll
                        for (int e = 0; e < 4; ++e) { const float a = fmaxf(v0[e], 0.f), b = fmaxf(v1[e], 0.f); v0[e] = a * a; v1[e] = b * b; }
                        u32x4 w; w.x = pkh(v0[0], v0[1]); w.y = pkh(v0[2], v0[3]); w.z = pkh(v1[0], v1[1]); w.w = pkh(v1[2], v1[3]);
                        *(u32x4*)(rowp + bj * HALF) = w;
                    }
                }
            }
    }
};
struct EpiDown {
    static constexpr bool PERM = false, AFTER_DRAIN = false;
    float* out; const u16* x1h;
    __device__ __forceinline__ void operator()(const f32x4 (&acc)[2][2][4][2], const Unit& u, int wr, int wc, int fr, int fq) const {
        const int col0 = u.pn * BM + wc * 32 + 4 * fq;
#pragma unroll
        for (int ai = 0; ai < 2; ++ai) {
            u32x2 xr[4][2][2];
#pragma unroll
            for (int m = 0; m < 4; ++m) {
                const size_t off = (size_t)(u.pm * BM + ai * HALF + wr * 64 + m * 16 + fr) * DM + col0;
#pragma unroll
                for (int bj = 0; bj < 2; ++bj)
#pragma unroll
                    for (int n = 0; n < 2; ++n) xr[m][bj][n] = *(const u32x2*)(x1h + off + bj * HALF + n * 16);
            }
#pragma unroll
            for (int m = 0; m < 4; ++m) {
                const size_t off = (size_t)(u.pm * BM + ai * HALF + wr * 64 + m * 16 + fr) * DM + col0;
#pragma unroll
                for (int bj = 0; bj < 2; ++bj)
#pragma unroll
                    for (int n = 0; n < 2; ++n) {
                        const h16x4 r = __builtin_bit_cast(h16x4, xr[m][bj][n]);
                        f32x4 o = acc[ai][bj][m][n]; o[0] += (float)r[0]; o[1] += (float)r[1]; o[2] += (float)r[2]; o[3] += (float)r[3];
                        *(f32x4*)(out + off + bj * HALF + n * 16) = o;
                    }
            }
        }
    }
};
struct EpiInProj {
    static constexpr bool PERM = true, AFTER_DRAIN = false;
    unsigned char* ws; const float* qg; const float* kg;
    __device__ __forceinline__ void operator()(const f32x4 (&acc)[2][2][4][2], const Unit& u, int wr, int wc, int fr, int fq) const {
        const int pn = u.pn;
        const bool normed = (pn < 2) || (pn < 5 && wc < 2);
        float gn[2][8];
        if (normed) {
            const float* gp = pn < 2 ? qg : kg;
#pragma unroll
            for (int bj = 0; bj < 2; ++bj) { const f32x4 a = *(const f32x4*)(gp + 32 * bj + 8 * fq), b = *(const f32x4*)(gp + 32 * bj + 8 * fq + 4);
#pragma unroll
                for (int e = 0; e < 4; ++e) { gn[bj][e] = a[e]; gn[bj][4 + e] = b[e]; } }
        }
        float lbv[2][8];
        if (pn == 7 || pn == 8) {
            const float* lp = (const float*)(ws + WS_LB) + 256 * (pn - 7) + 64 * wc + 8 * fq;
#pragma unroll
            for (int bj = 0; bj < 2; ++bj) { const f32x4 a = *(const f32x4*)(lp + 32 * bj), b = *(const f32x4*)(lp + 32 * bj + 4);
#pragma unroll
                for (int e = 0; e < 4; ++e) { lbv[bj][e] = a[e]; lbv[bj][4 + e] = b[e]; } }
        }
#pragma unroll
        for (int ai = 0; ai < 2; ++ai) {
            f32x4 rpv[4][4];
#pragma unroll
            for (int m = 0; m < 4; ++m) {
                if (normed && (m & 1) == 0) {
#pragma unroll
                    for (int mm = m; mm < m + 2; ++mm) { const int t_ = (u.pm * BM + ai * HALF + wr * 64 + mm * 16 + fr) & (SEQ - 1); const f32x4* rp_ = (const f32x4*)((const float*)(ws + WS_ROPE) + (size_t)t_ * 16);
#pragma unroll
                        for (int q4 = 0; q4 < 4; ++q4) rpv[mm][q4] = rp_[q4]; }
                }
                const int row = u.pm * BM + ai * HALF + wr * 64 + m * 16 + fr;
                const int b = row >> 13, t = row & (SEQ - 1);
                float v[2][8];
#pragma unroll
                for (int bj = 0; bj < 2; ++bj)
#pragma unroll
                    for (int e = 0; e < 4; ++e) { v[bj][e] = acc[ai][bj][m][0][e]; v[bj][4 + e] = acc[ai][bj][m][1][e]; }
                if (normed) {
                    float ss = 0.f;
#pragma unroll
                    for (int bj = 0; bj < 2; ++bj)
#pragma unroll
                        for (int e = 0; e < 8; ++e) ss += v[bj][e] * v[bj][e];
                    ss += __shfl_xor(ss, 16); ss += __shfl_xor(ss, 32);
                    const float rstd = 1.0f / sqrtf(ss * (1.0f / 64.f) + EPS);
#pragma unroll
                    for (int bj = 0; bj < 2; ++bj)
#pragma unroll
                        for (int e = 0; e < 8; ++e) v[bj][e] = v[bj][e] * rstd * gn[bj][e];
                    const f32x4 r0 = rpv[m][0], r1 = rpv[m][1], r2 = rpv[m][2], r3 = rpv[m][3];
                    const float cs[8] = {r0[0], r0[2], r1[0], r1[2], r2[0], r2[2], r3[0], r3[2]};
                    const float sn[8] = {r0[1], r0[3], r1[1], r1[3], r2[1], r2[3], r3[1], r3[3]};
#pragma unroll
                    for (int e = 0; e < 8; ++e) {
                        const float other = __shfl_xor(v[0][e], 16);
                        const float r1v = v[0][e] * cs[e] - other * sn[e];
                        const float r2v = v[0][e] * cs[e] + other * sn[e];
                        v[0][e] = fq == 0 ? r1v : (fq == 1 ? r2v : v[0][e]);
                    }
                    const float sc = pn < 2 ? 0.125f * 1.4426950408889634f : 1.0f;
                    u16* dst;
                    if (pn < 2) dst = (u16*)(ws + WS_Q) + (size_t)row * 512 + (4 * pn + wc) * 64 + 8 * fq;
                    else dst = (u16*)(ws + (pn == 2 ? WS_KC : pn == 3 ? WS_KS : WS_KW)) + ((size_t)(b * NG + wc) * SEQ + t) * 64 + 8 * fq;
#pragma unroll
                    for (int bj = 0; bj < 2; ++bj) {
                        u32x4 w; w.x = pkh(v[bj][0] * sc, v[bj][1] * sc); w.y = pkh(v[bj][2] * sc, v[bj][3] * sc); w.z = pkh(v[bj][4] * sc, v[bj][5] * sc); w.w = pkh(v[bj][6] * sc, v[bj][7] * sc);
                        *(u32x4*)(dst + 32 * bj) = w;
                    }
                } else if (pn < 5) {
                    const int g = wc - 2;
                    if (pn == 2) {
                        u16* dst = (u16*)(ws + WS_VC) + ((size_t)(b * NG + g) * SEQ + t) * 64 + 8 * fq;
#pragma unroll
                        for (int bj = 0; bj < 2; ++bj) {
                            u32x4 w; w.x = pkh(v[bj][0], v[bj][1]); w.y = pkh(v[bj][2], v[bj][3]); w.z = pkh(v[bj][4], v[bj][5]); w.w = pkh(v[bj][6], v[bj][7]);
                            *(u32x4*)(dst + 32 * bj) = w;
                        }
                    } else {
                        u16* dst = (u16*)(ws + (pn == 3 ? WS_VST : WS_VWT)) + (((size_t)(b * NG + g) * 128 + (t >> 6)) * 64 + 8 * fq) * 64 + (t & 63);
#pragma unroll
                        for (int bj = 0; bj < 2; ++bj)
#pragma unroll
                            for (int e = 0; e < 8; ++e) dst[(32 * bj + e) * 64] = f2h(v[bj][e]);
                    }
                } else if (pn < 13) {
                    const int kind = (pn - 5) >> 1;
                    const int col = 256 * ((pn - 5) & 1) + 64 * wc + 8 * fq;
                    u16* dst = (u16*)(ws + (kind == 0 ? WS_HQ : kind == 1 ? WS_HLOGF : kind == 2 ? WS_HV : WS_HG)) + (size_t)row * 512 + col;
#pragma unroll
                    for (int bj = 0; bj < 2; ++bj) {
                        float o[8];
#pragma unroll
                        for (int e = 0; e < 8; ++e) {
                            const float x = v[bj][e];
                            if (kind == 0 || kind == 3) o[e] = x * sigmoid_f(x);
                            else if (kind == 1) { const float l = lbv[bj][e]; o[e] = __logf(l + (1.f - l) * sigmoid_f(x)); }
                            else o[e] = x;
                        }
                        u32x4 w;
                        if (kind == 0 || kind == 2) { w.x = pkb(o[0], o[1]); w.y = pkb(o[2], o[3]); w.z = pkb(o[4], o[5]); w.w = pkb(o[6], o[7]); }
                        else { w.x = pkh(o[0], o[1]); w.y = pkh(o[2], o[3]); w.z = pkh(o[4], o[5]); w.w = pkh(o[6], o[7]); }
                        *(u32x4*)(dst + 32 * bj) = w;
                    }
                } else {
                    if (wc == 0 && fq < 3) {
                        float* dst = (float*)(ws + WS_GATES) + (size_t)row * 24 + 8 * fq;
                        f32x4 a, c;
#pragma unroll
                        for (int e = 0; e < 4; ++e) { a[e] = sigmoid_f(v[0][e]); c[e] = sigmoid_f(v[0][4 + e]); }
                        *(f32x4*)dst = a; *(f32x4*)(dst + 4) = c;
                    }
                }
            }
        }
    }
};
template <class Epi, class Sched, bool ALIGN_EPI = false, bool SP2 = false>
__device__ __forceinline__ void gemm_phase(PG8_LAS unsigned char* lds, const Gemm g, const Sched& S, const Epi& E, int wave_in) {
    const int tid = threadIdx.x, wid = __builtin_amdgcn_readfirstlane(tid >> 6), lane = tid & 63, wr = wid >> 2, wc = wid & 3, fr = lane & 15, fq = lane >> 4;
    const int K = g.K, nt = K / BK;
    unsigned voffA[2], voffB[2];
#pragma unroll
    for (int i = 0; i < 2; ++i) { int R, C; stage_rc(tid * 16 + i * 8192, R, C); const int Rb = Epi::PERM ? ((R & ~31) + perm32(R & 31)) : R;
        voffA[i] = (unsigned)(R * K + C) * 2u; voffB[i] = (unsigned)(Rb * K + C) * 2u; }
    const size_t kstep = (size_t)(BK * 2);
    const size_t hstep = (size_t)HALF * K * 2;
    const size_t tstep = 2 * hstep;
    const unsigned ldsw = (unsigned)wid * 1024u;
    const int aoff = lds_byte(wr * 64 + fr, fq * 8), boff = lds_byte(wc * 32 + fr, fq * 8);
#define PG8_SA(b, h) (((b) * 2 + (h)) * HTB)
#define PG8_SB(b, h) ((4 + (b) * 2 + (h)) * HTB)
#define PG8_STAGE(bufoff, gbase, voff) do { _Pragma("unroll") for (int _i = 0; _i < 2; ++_i) \
        __builtin_amdgcn_global_load_lds((const unsigned*)((const char*)(gbase) + (voff)[_i]), (PG8_LAS unsigned*)(lds + (bufoff) + ldsw + _i * 8192), 16, 0, 0); } while (0)
#define PG8_LDA(dst, b, h) do { _Pragma("unroll") for (int m = 0; m < 4; ++m) _Pragma("unroll") for (int k = 0; k < 2; ++k) dst[m][k] = *(const PG8_LAS bf16x8*)(lds + PG8_SA(b, h) + aoff + m * 2048 + k * 1024); } while (0)
#define PG8_LDB(dst, b, h) do { _Pragma("unroll") for (int n = 0; n < 2; ++n) _Pragma("unroll") for (int k = 0; k < 2; ++k) dst[n][k] = *(const PG8_LAS bf16x8*)(lds + PG8_SB(b, h) + boff + n * 2048 + k * 1024); } while (0)
#define PG8_MMA(ai, bj, At, Bt) do { __builtin_amdgcn_s_setprio(1); _Pragma("unroll") for (int m = 0; m < 4; ++m) _Pragma("unroll") for (int n = 0; n < 2; ++n) _Pragma("unroll") for (int k = 0; k < 2; ++k) \
        acc[ai][bj][m][n] = PG8_MFMA(Bt[n][k], At[m][k], acc[ai][bj][m][n]); __builtin_amdgcn_s_setprio(0); } while (0)
#define PG8_WAIT_V(n) asm volatile("s_waitcnt vmcnt(" #n ")" ::: "memory")
#define PG8_WAIT_L(n) asm volatile("s_waitcnt lgkmcnt(" #n ")" ::: "memory")
#define PG8_BAR __builtin_amdgcn_s_barrier()
#define PG8_SCHED __builtin_amdgcn_sched_barrier(0)
    Unit cur, nxt; int ui = 0;
    if (!S.next(0, cur)) return;
    f32x4 acc[2][2][4][2];
#pragma unroll
    for (int a = 0; a < 2; ++a)
#pragma unroll
        for (int b = 0; b < 2; ++b)
#pragma unroll
            for (int m = 0; m < 4; ++m)
#pragma unroll
                for (int n = 0; n < 2; ++n) acc[a][b][m][n] = (f32x4){0.f, 0.f, 0.f, 0.f};
    bf16x8 At[4][2], B0[2][2], B1[2][2];
    const char* cA = (const char*)g.A + (size_t)cur.pm * tstep; const char* cB = (const char*)g.Bt + (size_t)cur.pn * tstep;
    S.a_ready(cur);
    if constexpr (SP2) {
        PG8_STAGE(PG8_SB(0, 0), cB, voffB); PG8_STAGE(PG8_SB(0, 1), cB + hstep, voffB); PG8_STAGE(PG8_SA(0, 0), cA, voffA); PG8_STAGE(PG8_SA(0, 1), cA + hstep, voffA);
        if (wr == 1) PG8_BAR;
        PG8_WAIT_V(2); PG8_BAR;
        PG8_STAGE(PG8_SB(1, 0), cB + kstep, voffB); PG8_STAGE(PG8_SA(1, 0), cA + kstep, voffA); PG8_STAGE(PG8_SB(1, 1), cB + hstep + kstep, voffB);
        PG8_WAIT_V(6); PG8_BAR;
    } else {
        PG8_STAGE(PG8_SB(0, 0), cB, voffB); PG8_STAGE(PG8_SA(0, 0), cA, voffA); PG8_STAGE(PG8_SB(0, 1), cB + hstep, voffB); PG8_STAGE(PG8_SA(0, 1), cA + hstep, voffA);
        if (wr == 1) PG8_BAR;
        PG8_WAIT_V(4); PG8_BAR;
        PG8_STAGE(PG8_SB(1, 0), cB + kstep, voffB); PG8_STAGE(PG8_SA(1, 0), cA + kstep, voffA); PG8_STAGE(PG8_SB(1, 1), cB + hstep + kstep, voffB);
        PG8_WAIT_V(6); PG8_BAR;
    }
    for (;;) {
        const bool has_next = S.next(ui + 1, nxt);
        const char* nA = has_next ? (const char*)g.A + (size_t)nxt.pm * tstep : cA; const char* nB = has_next ? (const char*)g.Bt + (size_t)nxt.pn * tstep : cB;
        for (int t = 0; t < nt; t += 2) {
            const bool last = (t == nt - 2);
            const char* a1 = cA + (size_t)(t + 1) * kstep;
            const char* a2 = last ? nA : cA + (size_t)(t + 2) * kstep; const char* b2 = last ? nB : cB + (size_t)(t + 2) * kstep;
            const char* a3 = a2 + kstep; const char* b3 = b2 + kstep;
            if (last && has_next) S.a_ready(nxt);
            if constexpr (SP2) {
            PG8_LDB(B0, 0, 0); PG8_LDB(B1, 0, 1); PG8_SCHED; PG8_LDA(At, 0, 0); PG8_STAGE(PG8_SA(1, 1), a1 + hstep, voffA);
            PG8_WAIT_V(8); PG8_WAIT_L(0); PG8_BAR; PG8_MMA(0, 0, At, B0); PG8_MMA(0, 1, At, B1); PG8_BAR; PG8_SCHED;
            PG8_LDA(At, 0, 1); PG8_STAGE(PG8_SB(0, 0), b2, voffB); PG8_STAGE(PG8_SB(0, 1), b2 + hstep, voffB); PG8_STAGE(PG8_SA(0, 0), a2, voffA);
            PG8_WAIT_V(8); PG8_WAIT_L(0); PG8_BAR; PG8_MMA(1, 0, At, B0); PG8_MMA(1, 1, At, B1); PG8_BAR; PG8_SCHED;
            PG8_LDB(B0, 1, 0); PG8_LDB(B1, 1, 1); PG8_SCHED; PG8_LDA(At, 1, 0); PG8_STAGE(PG8_SA(0, 1), a2 + hstep, voffA);
            PG8_WAIT_V(8); PG8_WAIT_L(0); PG8_BAR; PG8_MMA(0, 0, At, B0); PG8_MMA(0, 1, At, B1); PG8_BAR; PG8_SCHED;
            PG8_LDA(At, 1, 1); PG8_STAGE(PG8_SB(1, 0), b3, voffB); PG8_STAGE(PG8_SB(1, 1), b3 + hstep, voffB); PG8_STAGE(PG8_SA(1, 0), a3, voffA);
            PG8_WAIT_V(8); PG8_WAIT_L(0); PG8_BAR; PG8_MMA(1, 0, At, B0); PG8_MMA(1, 1, At, B1); PG8_BAR; PG8_SCHED;
            } else {
            PG8_LDB(B0, 0, 0); PG8_SCHED; PG8_LDA(At, 0, 0); PG8_STAGE(PG8_SA(1, 1), a1 + hstep, voffA);
            PG8_WAIT_L(8); PG8_BAR; PG8_WAIT_L(0); PG8_MMA(0, 0, At, B0); PG8_BAR; PG8_SCHED;
            PG8_LDB(B1, 0, 1); PG8_STAGE(PG8_SB(0, 0), b2, voffB);
            PG8_BAR; PG8_WAIT_L(0); PG8_MMA(0, 1, At, B1); PG8_BAR;
            PG8_LDA(At, 0, 1); PG8_STAGE(PG8_SA(0, 0), a2, voffA);
            PG8_BAR; PG8_WAIT_L(0); PG8_MMA(1, 0, At, B0); PG8_BAR; PG8_SCHED;
            PG8_STAGE(PG8_SB(0, 1), b2 + hstep, voffB);
            PG8_WAIT_V(6); PG8_BAR; PG8_MMA(1, 1, At, B1); PG8_BAR;
            PG8_LDB(B0, 1, 0); PG8_SCHED; PG8_LDA(At, 1, 0); PG8_STAGE(PG8_SA(0, 1), a2 + hstep, voffA);
            PG8_WAIT_L(8); PG8_BAR; PG8_WAIT_L(0); PG8_MMA(0, 0, At, B0); PG8_BAR; PG8_SCHED;
            PG8_LDB(B1, 1, 1); PG8_STAGE(PG8_SB(1, 0), b3, voffB);
            PG8_BAR; PG8_WAIT_L(0); PG8_MMA(0, 1, At, B1); PG8_BAR;
            PG8_LDA(At, 1, 1); PG8_STAGE(PG8_SA(1, 0), a3, voffA);
            PG8_BAR; PG8_WAIT_L(0); PG8_MMA(1, 0, At, B0); PG8_BAR; PG8_SCHED;
            PG8_STAGE(PG8_SB(1, 1), b3 + hstep, voffB);
            PG8_WAIT_V(6); PG8_BAR; PG8_MMA(1, 1, At, B1); PG8_BAR;
            }
        }
        if constexpr (ALIGN_EPI) { if (wr == 0) PG8_BAR; }
        if constexpr (!Epi::AFTER_DRAIN) { E(acc, cur, wr, wc, fr, fq); S.done(cur); }
        if (!has_next) break;
#pragma unroll
        for (int a = 0; a < 2; ++a)
#pragma unroll
            for (int b = 0; b < 2; ++b)
#pragma unroll
                for (int m = 0; m < 4; ++m)
#pragma unroll
                    for (int n = 0; n < 2; ++n) acc[a][b][m][n] = (f32x4){0.f, 0.f, 0.f, 0.f};
        cur = nxt; cA = nA; cB = nB; ++ui;
        if constexpr (ALIGN_EPI) { if (wr == 1) PG8_BAR; }
    }
    PG8_WAIT_V(0);
    if constexpr (!ALIGN_EPI) { if (wr == 0) PG8_BAR; }
    PG8_BAR;
    if constexpr (Epi::AFTER_DRAIN) { E.fused(acc, cur, wr, wc, fr, fq, lds, wid, lane); S.done(cur); }
#undef PG8_SA
#undef PG8_SB
#undef PG8_STAGE
#undef PG8_LDA
#undef PG8_LDB
#undef PG8_MMA
#undef PG8_WAIT_V
#undef PG8_WAIT_L
#undef PG8_BAR
#undef PG8_SCHED
}
}
#define LDS_WAIT() asm volatile("s_waitcnt lgkmcnt(0)" ::: "memory")
#define VM_WAIT() asm volatile("s_waitcnt vmcnt(0)" ::: "memory")

struct Params {
    const float* in[18];
    float* out;
    unsigned char* ws;
    float invf[8];
    int ph_lo, ph_hi;
};

__device__ __forceinline__ void sincos_acc(float ang, float& s, float& c) {
    const double x = (double)ang;
    const double k = rint(x * 0.6366197723675814);
    double r = fma(-k, 1.5707963267948966, x); r = fma(-k, 6.123233995736766e-17, r);
    const int q = ((int)k) & 3;
    const double r2 = r * r;
    const double sp = r * (1.0 + r2 * (-1.0 / 6 + r2 * (1.0 / 120 + r2 * (-1.0 / 5040 + r2 * (1.0 / 362880 + r2 * (-1.0 / 39916800 + r2 * (1.0 / 6227020800.0)))))));
    const double cp = 1.0 + r2 * (-0.5 + r2 * (1.0 / 24 + r2 * (-1.0 / 720 + r2 * (1.0 / 40320 + r2 * (-1.0 / 3628800 + r2 * (1.0 / 479001600.0 + r2 * (-1.0 / 87178291200.0)))))));
    double ss, cc;
    if (q == 0) { ss = sp; cc = cp; } else if (q == 1) { ss = cp; cc = -sp; } else if (q == 2) { ss = -sp; cc = -cp; } else { ss = -cp; cc = sp; }
    s = (float)ss; c = (float)cc;
}

struct ColId { __device__ __forceinline__ int operator()(int n) const { return n; } };
struct ColWin {
    __device__ __forceinline__ int operator()(int P) const {
        const int pn = P >> 8, p = P & 255, bj = p >> 7, wc = (p >> 5) & 3, j = p & 31;
        const int Lp = 256 * pn + 64 * wc + 32 * bj + j;
        return Lp < 1280 ? Lp : (Lp < 3328 ? Lp + 24 : (Lp < 3352 ? Lp - 3328 + 1280 : -1));
    }
};
template <class SrcCol>
__device__ __forceinline__ void p0_transpose_item(const float* __restrict__ W, int K, int Nsrc, u16* WT, const float* rowscale, SrcCol sc, LAS float* scr, int kb, int nb, int lane) {
    const int k0 = 64 * kb, n0 = 32 * nb;
    const int scol = sc(n0 + (lane & 31));
#pragma unroll
    for (int i = 0; i < 32; ++i) {
        const int kk = 2 * i + (lane >> 5);
        float v = scol >= 0 ? W[(size_t)(k0 + kk) * Nsrc + scol] : 0.f;
        if (rowscale) v *= rowscale[k0 + kk];
        scr[kk * 33 + (lane & 31)] = v;
    }
    LDS_WAIT(); asm volatile("" ::: "memory");
    const int c = lane & 7;
#pragma unroll
    for (int j = 0; j < 4; ++j) {
        const int n = (lane >> 3) + 8 * j; const LAS float* s = scr + (8 * c) * 33 + n;
        u32x4 o; o.x = pkh(s[0 * 33], s[1 * 33]); o.y = pkh(s[2 * 33], s[3 * 33]); o.z = pkh(s[4 * 33], s[5 * 33]); o.w = pkh(s[6 * 33], s[7 * 33]);
        *(u32x4*)(WT + (size_t)(n0 + n) * K + k0 + 8 * c) = o;
    }
    LDS_WAIT(); asm volatile("" ::: "memory");
}

__device__ __forceinline__ void p0_late_transposes(const Params& p, LAS unsigned char* lds, int gw, int NGW, int wave, int lane) {
    unsigned char* ws = p.ws;
    LAS float* scr = (LAS float*)(lds + wave * 16384);
    constexpr int I_WOUT = 16 * 32, I_W1 = 16 * (FF / 32), I_W2 = (FF / 64) * 32, I_C1 = 32 * 4, I_C2 = 2 * 2;
    constexpr int NITEMS = I_WOUT + I_W1 + I_W2 + 2 * I_C1 + 2 * I_C2;
    for (int it = gw; it < NITEMS; it += NGW) {
        int r = it;
        if (r < I_C1) { p0_transpose_item(p.in[6], 2048, 128, (u16*)(ws + WS_CW1K_T), nullptr, ColId(), scr, r / 4, r % 4, lane); continue; } r -= I_C1;
        if (r < I_C1) { p0_transpose_item(p.in[9], 2048, 128, (u16*)(ws + WS_CW1V_T), nullptr, ColId(), scr, r / 4, r % 4, lane); continue; } r -= I_C1;
        if (r < I_C2) { p0_transpose_item(p.in[7], 128, 64, (u16*)(ws + WS_CW2K_T), nullptr, ColId(), scr, r / 2, r % 2, lane); continue; } r -= I_C2;
        if (r < I_C2) { p0_transpose_item(p.in[10], 128, 64, (u16*)(ws + WS_CW2V_T), nullptr, ColId(), scr, r / 2, r % 2, lane); continue; } r -= I_C2;
        if (r < I_WOUT) { p0_transpose_item(p.in[14], DM, DM, (u16*)(ws + WS_WOUT_T), nullptr, ColId(), scr, r / 32, r % 32, lane); continue; } r -= I_WOUT;
        if (r < I_W1) { p0_transpose_item(p.in[16], DM, FF, (u16*)(ws + WS_W1_T), p.in[15], ColId(), scr, r / (FF / 32), r % (FF / 32), lane); continue; } r -= I_W1;
        p0_transpose_item(p.in[17], FF, DM, (u16*)(ws + WS_W2_T), nullptr, ColId(), scr, r / 32, r % 32, lane);
    }
}
__device__ __forceinline__ void p0_prologue(const Params& p, LAS unsigned char* lds, int gw, int NGW, int wave, int lane) {
    unsigned char* ws = p.ws;
    LAS float* scr = (LAS float*)(lds + wave * 16384);
    constexpr int I_WIN = 16 * (DINP / 32);
    for (int it = gw; it < I_WIN; it += NGW) p0_transpose_item(p.in[2], DM, DIN, (u16*)(ws + WS_WIN_T), nullptr, ColWin(), scr, it / (DINP / 32), it % (DINP / 32), lane);
    {
        const float* gn = p.in[1];
        f32x4 gv[4];
#pragma unroll
        for (int j = 0; j < 4; ++j) gv[j] = ((const f32x4*)gn)[lane + 64 * j];
        for (int m = gw; m < MT; m += 4 * NGW) {
            f32x4 v[4][4]; float s[4];
#pragma unroll
            for (int r = 0; r < 4; ++r) {
                const int mr = m + r * NGW; const f32x4* xr = (const f32x4*)(p.in[0] + (size_t)(mr < MT ? mr : m) * DM) + lane;
#pragma unroll
                for (int j = 0; j < 4; ++j) v[r][j] = __builtin_nontemporal_load(xr + 64 * j);
            }
#pragma unroll
            for (int r = 0; r < 4; ++r) {
                float a = 0.f;
#pragma unroll
                for (int j = 0; j < 4; ++j) a += (v[r][j][0] * v[r][j][0] + v[r][j][1] * v[r][j][1]) + (v[r][j][2] * v[r][j][2] + v[r][j][3] * v[r][j][3]);
                s[r] = a;
            }
#pragma unroll
            for (int o = 1; o < 64; o <<= 1) {
#pragma unroll
                for (int r = 0; r < 4; ++r) s[r] += __shfl_xor(s[r], o);
            }
#pragma unroll
            for (int r = 0; r < 4; ++r) {
                const int mr = m + r * NGW;
                if (mr < MT) {
                    const float rstd = 1.0f / sqrtf(s[r] * (1.f / DM) + EPS);
                    u32x2* o8 = (u32x2*)((u16*)(ws + WS_XH) + (size_t)mr * DM) + lane;
#pragma unroll
                    for (int j = 0; j < 4; ++j) { u32x2 ww; ww.x = pkh(v[r][j][0] * rstd * gv[j][0], v[r][j][1] * rstd * gv[j][1]); ww.y = pkh(v[r][j][2] * rstd * gv[j][2], v[r][j][3] * rstd * gv[j][3]); o8[64 * j] = ww; }
                }
            }
        }
    }
    const int gt = gw * 64 + lane, NGT = NGW * 64;
    for (int i = gt; i < SEQ * 8; i += NGT) {
        const int pos = i >> 3, f = i & 7; float s, c; sincos_acc((float)pos * p.invf[f], s, c);
        ((f32x2*)(ws + WS_ROPE))[i] = (f32x2){c, s};
    }
    for (int i = gt; i < 512; i += NGT) {
        const float a = p.in[12][i], c = p.in[12][512 + i]; const float m = fmaxf(a, c); const float ea = expf(a - m), ec = expf(c - m);
        ((float*)(ws + WS_LB))[i] = ea / (ea + ec);
    }
    for (int i = gt; i < 2048; i += NGT) { ((u16*)(ws + WS_PEK))[i] = f2h(p.in[5][i]); ((u16*)(ws + WS_PEV))[i] = f2h(p.in[8][i]); }
}

#define XB_TMO      128
#define XB_XCNT(j)  (256  + 64 * (j))
#define XB_XSUB(j)  (1280 + 64 * (j))
#define XB_XGEN(j)  (2304 + 64 * (j))
#define XB_TOP      3328
#define XB_TOPGEN   3392
#define XCD_BAR_WORDS 3456
#define XB_SPIN_CAP (1u << 18)

__device__ __forceinline__ unsigned xb_ld(unsigned* p)              { return __hip_atomic_load(p, __ATOMIC_RELAXED, __HIP_MEMORY_SCOPE_AGENT); }
__device__ __forceinline__ unsigned xb_add(unsigned* p, unsigned v) { return __hip_atomic_fetch_add(p, v, __ATOMIC_RELAXED, __HIP_MEMORY_SCOPE_AGENT); }
__device__ __forceinline__ unsigned xb_xcc_id() { return (unsigned)__builtin_amdgcn_s_getreg((3 << 11) | 20) & 0xFu; }
#define XB_SPIN(cond, bar) do { unsigned _sp = 0; while (cond) { __builtin_amdgcn_s_sleep(1); \
    if ((++_sp & 255u) == 0u) { if (xb_ld(&(bar)[XB_TMO])) break; if (_sp > XB_SPIN_CAP) { atomicAdd(&(bar)[XB_TMO], 1u); break; } } } } while (0)

struct XcdBarrier {
    unsigned* bar; unsigned x;
    volatile LAS unsigned* st;
};

__device__ __forceinline__ XcdBarrier xcd_barrier_post(unsigned* bar, volatile LAS unsigned* st) {
    XcdBarrier b; b.bar = bar; b.x = xb_xcc_id(); b.st = st;
    if (threadIdx.x == 0) (void)xb_add(&bar[XB_XCNT(b.x)], 1u);
    return b;
}
__device__ __forceinline__ void xcd_barrier_complete(unsigned* bar, unsigned x, unsigned& nloc, unsigned& nx) {
    const unsigned G = gridDim.x * gridDim.y * gridDim.z;
    unsigned sum, cnt, mine, sp = 0u;
    for (;;) {
        sum = 0u; cnt = 0u; mine = 0u;
#pragma unroll
        for (unsigned j = 0; j < 16; ++j) { const unsigned c = xb_ld(&bar[XB_XCNT(j)]); sum += c; cnt += (c > 0u) ? 1u : 0u; mine = (j == x) ? c : mine; }
        if (sum == G) break;
        __builtin_amdgcn_s_sleep(1);
        if ((++sp & 255u) == 0u) { if (xb_ld(&bar[XB_TMO])) break; if (sp > XB_SPIN_CAP) { atomicAdd(&bar[XB_TMO], 1u); break; } }
    }
    nloc = mine > 0u ? mine : 1u; nx = cnt > 0u ? cnt : 1u;
}

__device__ __forceinline__ void xcd_barrier(const XcdBarrier& b) {
    asm volatile("s_waitcnt vmcnt(0)" ::: "memory");
    __syncthreads();
    if (threadIdx.x == 0) {
        unsigned* bar = b.bar;
        __builtin_amdgcn_s_waitcnt(0);
        unsigned nloc = b.st[0], nx = b.st[1];
        if (nloc == 0u) { xcd_barrier_complete(bar, b.x, nloc, nx); b.st[0] = nloc; b.st[1] = nx; }
        const unsigned old = xb_add(&bar[XB_XSUB(b.x)], 1u);
        const unsigned gen = old / nloc;
        if (old + 1u == (gen + 1u) * nloc) {
            __builtin_amdgcn_fence(__ATOMIC_RELEASE, "agent");
            asm volatile("s_waitcnt vmcnt(0)" ::: "memory");
            const unsigned og = xb_add(&bar[XB_TOP], 1u);
            const unsigned tg = og / nx;
            if (og + 1u == (tg + 1u) * nx) xb_add(&bar[XB_TOPGEN], 1u);
            else XB_SPIN(xb_ld(&bar[XB_TOPGEN]) == tg, bar);
            __builtin_amdgcn_fence(__ATOMIC_ACQUIRE, "agent");
            xb_add(&bar[XB_XGEN(b.x)], 1u);
            asm volatile("s_waitcnt vmcnt(0)" ::: "memory");
        } else {
            XB_SPIN(xb_ld(&bar[XB_XGEN(b.x)]) == gen, bar);
            __builtin_amdgcn_fence(__ATOMIC_ACQUIRE, "agent");
            asm volatile("s_waitcnt vmcnt(0)" ::: "memory");
        }
    }
    __syncthreads();
}

constexpr float LOG2E = 1.4426950408889634f;
constexpr float OFF2 = 4.0f * LOG2E;
constexpr int AT_PITCH = 144;
constexpr int AT_TILE = 64 * AT_PITCH;
constexpr int AT_LDS = 4 * AT_TILE;
#define MFMA32H(a, b, c) __builtin_amdgcn_mfma_f32_32x32x16_f16((a), (b), (c), 0, 0, 0)
#define MFMA16H(a, b, c) __builtin_amdgcn_mfma_f32_16x16x32_f16((a), (b), (c), 0, 0, 0)
#define MFMA32B(a, b, c) __builtin_amdgcn_mfma_f32_32x32x16_bf16((a), (b), (c), 0, 0, 0)

#define AT_BAR() do { asm volatile("s_waitcnt lgkmcnt(0)" ::: "memory"); __builtin_amdgcn_s_barrier(); asm volatile("" ::: "memory"); } while (0)
template <int MODE>
__device__ __forceinline__ void attn_tiles(LAS unsigned char* lds, const u16* __restrict__ Kbg, const u16* __restrict__ VTbg, const h16x8 (&qf)[4], int qt, int j0, int qh, int wave, int lane,
                                           unsigned sw0, unsigned sw1, unsigned sw2, unsigned sw3, f32x16 (&o)[2], float& lsum) {
    const int tid = threadIdx.x, r32 = lane & 31, hi = lane >> 5;
    const int srow = tid >> 3, sch = tid & 7;
    const u16* ksrc = Kbg + (size_t)srow * 64 + 8 * sch;
    const u16* vsrc = VTbg + (size_t)srow * 64 + 8 * sch;
    const int sdst = srow * AT_PITCH + sch * 16;
    const int prow = (r32 & 0x13) | ((r32 & 8) >> 1) | ((r32 & 4) << 1);
    const int koff = prow * AT_PITCH + hi * 16;
    const int voff = r32 * AT_PITCH + hi * 16;
    const int qrel = 32 * qh + r32;
    u32x4 kA = *(const u32x4*)(ksrc + (size_t)j0 * 4096), vA = *(const u32x4*)(vsrc + (size_t)j0 * 4096);
    u32x4 kB = kA, vB = vA;
    if (j0 + 1 <= qt) { kB = *(const u32x4*)(ksrc + (size_t)(j0 + 1) * 4096); vB = *(const u32x4*)(vsrc + (size_t)(j0 + 1) * 4096); }
    *(LAS u32x4*)(lds + sdst) = kA; *(LAS u32x4*)(lds + 2 * AT_TILE + sdst) = vA;
    h16x8 qg0 = qf[0], qg1 = qf[1], qg2 = qf[2], qg3 = qf[3];
    asm volatile("" : "+v"(qg0), "+v"(qg1), "+v"(qg2), "+v"(qg3));
    const u32x4 onesw = {0x3c003c00u, 0x3c003c00u, 0x3c003c00u, 0x3c003c00u};
    f32x16 negoff;
#pragma unroll
    for (int i = 0; i < 16; ++i) negoff[i] = -OFF2;
    asm volatile("" : "+v"(negoff));
    f32x16 ol;
#pragma unroll
    for (int i = 0; i < 16; ++i) ol[i] = 0.f;
    AT_BAR();
    for (int j = j0; j <= qt; ++j) {
        const int buf = (j - j0) & 1;
        if (j + 2 <= qt) { kA = *(const u32x4*)(ksrc + (size_t)(j + 2) * 4096); vA = *(const u32x4*)(vsrc + (size_t)(j + 2) * 4096); }
        LAS unsigned char* kb = lds + buf * AT_TILE; LAS unsigned char* vb = lds + (2 + buf) * AT_TILE;
        bool sel = true;
        if (MODE == 1) { const unsigned w = j < 32 ? sw0 : (j < 64 ? sw1 : (j < 96 ? sw2 : sw3)); sel = (w >> (j & 31)) & 1u; }
        if (MODE == 0 || __any(sel)) {
            h16x8 kf[8];
#pragma unroll
            for (int kh = 0; kh < 2; ++kh)
#pragma unroll
                for (int d0 = 0; d0 < 4; ++d0) kf[kh * 4 + d0] = *(const LAS h16x8*)(kb + kh * 32 * AT_PITCH + koff + d0 * 32);
            __builtin_amdgcn_sched_barrier(0);
            f32x16 s[2];
#pragma unroll
            for (int kh = 0; kh < 2; ++kh) {
#pragma unroll
                for (int d0 = 0; d0 < 4; ++d0) s[kh] = MFMA32H(kf[kh * 4 + d0], (d0 == 0 ? qg0 : d0 == 1 ? qg1 : d0 == 2 ? qg2 : qg3), (d0 == 0 ? negoff : s[kh]));
            }
            h16x8 vfr[8];
#pragma unroll
            for (int dt = 0; dt < 2; ++dt)
#pragma unroll
                for (int kk = 0; kk < 4; ++kk) vfr[dt * 4 + kk] = *(const LAS h16x8*)(vb + dt * 32 * AT_PITCH + voff + kk * 32);
            __builtin_amdgcn_sched_barrier(0);
            const int dj = qt - j;
            const bool edge_hi = (dj == 0), edge_lo = (MODE == 0) && (dj == 8);
            u32x4 pw[2][2];
            if (edge_hi || edge_lo) {
#pragma unroll
                for (int kh = 0; kh < 2; ++kh)
#pragma unroll
                    for (int sp = 0; sp < 2; ++sp) {
                        float pv[8];
#pragma unroll
                        for (int e = 0; e < 8; ++e) {
                            const int kin = 32 * kh + 16 * sp + 8 * hi + e;
                            float pe = __builtin_amdgcn_exp2f(s[kh][8 * sp + e]);
                            if (edge_hi) pe = (kin <= qrel) ? pe : 0.f;
                            if (edge_lo) pe = (kin > qrel) ? pe : 0.f;
                            pv[e] = pe;
                        }
                        pw[kh][sp] = (u32x4){pkh(pv[0], pv[1]), pkh(pv[2], pv[3]), pkh(pv[4], pv[5]), pkh(pv[6], pv[7])};
                    }
            } else {
#pragma unroll
                for (int kh = 0; kh < 2; ++kh)
#pragma unroll
                    for (int sp = 0; sp < 2; ++sp) {
                        float pv[8];
#pragma unroll
                        for (int e = 0; e < 8; ++e) pv[e] = __builtin_amdgcn_exp2f(s[kh][8 * sp + e]);
                        pw[kh][sp] = (u32x4){pkh(pv[0], pv[1]), pkh(pv[2], pv[3]), pkh(pv[4], pv[5]), pkh(pv[6], pv[7])};
                    }
            }
            if (MODE == 1) {
                const unsigned mk = sel ? 0xffffffffu : 0u;
#pragma unroll
                for (int kh = 0; kh < 2; ++kh)
#pragma unroll
                    for (int sp = 0; sp < 2; ++sp) { pw[kh][sp].x &= mk; pw[kh][sp].y &= mk; pw[kh][sp].z &= mk; pw[kh][sp].w &= mk; }
            }
#pragma unroll
            for (int kh = 0; kh < 2; ++kh)
#pragma unroll
                for (int sp = 0; sp < 2; ++sp) {
                    const h16x8 pb = __builtin_bit_cast(h16x8, pw[kh][sp]);
#pragma unroll
                    for (int dt = 0; dt < 2; ++dt) o[dt] = MFMA32H(vfr[dt * 4 + 2 * kh + sp], pb, o[dt]);
                    ol = MFMA32H(__builtin_bit_cast(h16x8, onesw), pb, ol);
                }
        }
        if (j < qt) { *(LAS u32x4*)(lds + (buf ^ 1) * AT_TILE + sdst) = kB; *(LAS u32x4*)(lds + (2 + (buf ^ 1)) * AT_TILE + sdst) = vB; }
        kB = kA; vB = vA;
        AT_BAR();
    }
    lsum = 0.5f * ol[0];
}

__device__ __forceinline__ void win_unit(unsigned char* ws, LAS unsigned char* lds, int u, int wave, int lane) {
    const int qt = u & 127, bg = u >> 7, b = bg >> 1, g = bg & 1;
    const int h = wave >> 1, qh = wave & 1, r32 = lane & 31, hi = lane >> 5;
    const int t = 64 * qt + 32 * qh + r32;
    const size_t row = (size_t)b * SEQ + t;
    const u16* qp = (const u16*)(ws + WS_Q) + row * 512 + (4 * g + h) * 64 + 8 * hi;
    h16x8 qf[4];
#pragma unroll
    for (int d0 = 0; d0 < 4; ++d0) qf[d0] = *(const h16x8*)(qp + 16 * d0);
    f32x16 o[2]; float l = 0.f;
#pragma unroll
    for (int i = 0; i < 16; ++i) { o[0][i] = 0.f; o[1][i] = 0.f; }
    const int j0 = qt > 8 ? qt - 8 : 0;
    attn_tiles<0>(lds, (const u16*)(ws + WS_KW) + (size_t)bg * SEQ * 64, (const u16*)(ws + WS_VWT) + (size_t)bg * 64 * SEQ, qf, qt, j0, qh, wave, lane, 0u, 0u, 0u, 0u, o, l);
    l += __shfl_xor(l, 32);
    const float sc = ((const float*)(ws + WS_GATES))[row * 24 + (4 * g + h) * 3 + 2] / l;
    u16* dst = (u16*)(ws + WS_OWIN) + row * 512 + (4 * g + h) * 64 + 4 * hi;
#pragma unroll
    for (int dt = 0; dt < 2; ++dt)
#pragma unroll
        for (int r4 = 0; r4 < 4; ++r4) {
            u32x2 w; w.x = pkh(o[dt][4 * r4] * sc, o[dt][4 * r4 + 1] * sc); w.y = pkh(o[dt][4 * r4 + 2] * sc, o[dt][4 * r4 + 3] * sc);
            *(u32x2*)(dst + 32 * dt + 8 * r4) = w;
        }
}

constexpr int CM_SP = 132, CM_HP = 136;
__device__ __forceinline__ void cmp_mlp_unit(unsigned char* ws, LAS unsigned char* lds, int u, int wave, int lane) {
    const int mt = u & 31, bg = (u >> 5) & 3, kv = u >> 7;
    const int tid = threadIdx.x, r = lane & 15, quad = lane >> 4;
    LAS float* slab = (LAS float*)lds;
    LAS u16* hb = (LAS u16*)(lds + 8 * 16 * CM_SP * 4);
    const u16* src = (const u16*)(ws + (kv ? WS_VC : WS_KC)) + (size_t)bg * SEQ * 64;
    const u16* pe = (const u16*)(ws + (kv ? WS_PEV : WS_PEK));
    const u16* w1t = (const u16*)(ws + (kv ? WS_CW1V_T : WS_CW1K_T));
    const int n = 16 * mt + r;
    const int nc = n < NCMP ? n : NCMP - 1;
    const u16* arow = src + (size_t)nc * 1024 + 8 * quad;
    const u16* brow = w1t + (size_t)r * 2048 + 8 * quad;
    f32x4 acc[8];
#pragma unroll
    for (int c = 0; c < 8; ++c) acc[c] = (f32x4){0.f, 0.f, 0.f, 0.f};
    const int kbase = 256 * wave;
#pragma unroll 1
    for (int hf = 0; hf < 2; ++hf) {
#pragma unroll
        for (int st = 0; st < 4; ++st) {
            const int k0 = kbase + 32 * (4 * hf + st);
            const h16x8 av = *(const h16x8*)(arow + k0) + *(const h16x8*)(pe + k0 + 8 * quad);
#pragma unroll
            for (int c = 0; c < 8; ++c) { const h16x8 bf = *(const h16x8*)(brow + (size_t)(16 * c) * 2048 + k0); acc[c] = MFMA16H(av, bf, acc[c]); }
        }
    }
#pragma unroll
    for (int c = 0; c < 8; ++c)
#pragma unroll
        for (int i = 0; i < 4; ++i) slab[(wave * 16 + 4 * quad + i) * CM_SP + 16 * c + r] = acc[c][i];
    AT_BAR();
#pragma unroll
    for (int jj = 0; jj < 4; ++jj) {
        const int idx = tid + NTHREADS * jj, row = idx >> 7, col = idx & 127;
        float x = 0.f;
#pragma unroll
        for (int w8 = 0; w8 < 8; ++w8) x += slab[(w8 * 16 + row) * CM_SP + col];
        hb[row * CM_HP + col] = f2h(x * sigmoid_f(x));
    }
    AT_BAR();
    if (wave < 4) {
        const u16* w2t = (const u16*)(ws + (kv ? WS_CW2V_T : WS_CW2K_T)) + (size_t)(16 * wave + r) * 128 + 8 * quad;
        f32x4 oc = {0.f, 0.f, 0.f, 0.f};
#pragma unroll
        for (int ks = 0; ks < 4; ++ks) {
            const h16x8 af = *(const LAS h16x8*)(hb + r * CM_HP + 32 * ks + 8 * quad);
            const h16x8 bf = *(const h16x8*)(w2t + 32 * ks);
            oc = MFMA16H(af, bf, oc);
        }
        const int d = 16 * wave + r, n0 = 16 * mt + 4 * quad;
        if (kv == 0) {
            u16* dst = (u16*)(ws + WS_KCMP) + (size_t)bg * 512 * 64 + d;
#pragma unroll
            for (int i = 0; i < 4; ++i) dst[(size_t)(n0 + i) * 64] = (n0 + i) < NCMP ? f2h(oc[i]) : (u16)0;
        } else {
            u32x2 w; w.x = pkh(oc[0], oc[1]); w.y = pkh(oc[2], (n0 + 3) < NCMP ? oc[3] : 0.f);
            *(u32x2*)((u16*)(ws + WS_VCMPT) + ((size_t)bg * 64 + d) * 512 + n0) = w;
        }
    }
    AT_BAR();
}
constexpr int NS_IMP_P = 132, NS_MAXIT = 288, NS_SLOT = 32 * 144;
constexpr int NS_OFF_IMP = 0, NS_OFF_KC = 67584;
constexpr int NS_OFF_SLOT = 0, NS_OFF_SLOTL = 2 * 8 * NS_SLOT, NS_OFF_OA = NS_OFF_SLOTL + 2048;
constexpr int NS_OFF_BM = 141312, NS_OFF_ITEMS = 142336, NS_OFF_CNT = 145792;
static_assert(2 * 64 * NS_IMP_P * 4 <= NS_OFF_KC && NS_OFF_KC + 512 * 144 <= NS_OFF_BM && NS_OFF_OA + 4 * 512 * 16 <= NS_OFF_BM &&
              NS_OFF_ITEMS + NS_MAXIT * 12 <= NS_OFF_CNT && NS_OFF_CNT + 16 + 1024 <= LDS_BYTES - 256 && AT_LDS <= NS_OFF_BM, "nsa LDS map");
#define NS_BAR() do { asm volatile("s_waitcnt lgkmcnt(0)" ::: "memory"); __builtin_amdgcn_s_barrier(); asm volatile("" ::: "memory"); } while (0)

__device__ __forceinline__ void nsa_unit(unsigned char* ws, LAS unsigned char* lds, int bg, int qt, int wave, int lane) {
    const int tid = threadIdx.x; const int b = bg >> 1, g = bg & 1;
    LAS float* imp = (LAS float*)(lds + NS_OFF_IMP);
    LAS unsigned* bm = (LAS unsigned*)(lds + NS_OFF_BM);
    LAS unsigned char* kcl = lds + NS_OFF_KC;
    LAS unsigned* items = (LAS unsigned*)(lds + NS_OFF_ITEMS);
    LAS unsigned* cnt = (LAS unsigned*)(lds + NS_OFF_CNT);
    const float* gates = (const float*)(ws + WS_GATES);
    for (int i = tid; i < 2 * 64 * NS_IMP_P; i += NTHREADS) imp[i] = 0.f;
    if (tid == 0) cnt[0] = 0u;
    {
        const int amax = 4 * qt + 3;
        int nrows = 32 * ((amax + 31) >> 5); nrows = nrows > 512 ? 512 : nrows;
        const u16* kcg = (const u16*)(ws + WS_KCMP) + (size_t)bg * 512 * 64;
        u32x4 tmp[8];
#pragma unroll
        for (int ii = 0; ii < 8; ++ii) { const int i = tid + NTHREADS * ii; if (i < nrows * 8) tmp[ii] = *(const u32x4*)(kcg + (size_t)i * 8); }
#pragma unroll
        for (int ii = 0; ii < 8; ++ii) { const int i = tid + NTHREADS * ii; if (i < nrows * 8) *(LAS u32x4*)(kcl + (i >> 3) * 144 + (i & 7) * 16) = tmp[ii]; }
    }
    AT_BAR();
    {
        int ln1 = lane; asm volatile("" : "+v"(ln1));
        const int qg = wave & 3, hp = wave >> 2, qi = ln1 & 15, quad = ln1 >> 4;
        const int a = 4 * qt + qg;
        const int nlim = (qi == 15) ? a - 1 : a - 2;
        const int nT = (a + 15) >> 4, nP = (nT + 1) >> 1;
        const int q = 16 * qg + qi; const size_t row = (size_t)b * SEQ + 64 * qt + q;
        const u16* vtg = (const u16*)(ws + WS_VCMPT) + (size_t)bg * 64 * 512;
        const LAS unsigned char* kl = kcl + qi * 144 + quad * 16;
        LAS float* ir = imp + (hp * 64 + q) * NS_IMP_P + quad;
        h16x8 qf2[2][2];
#pragma unroll
        for (int hh = 0; hh < 2; ++hh)
#pragma unroll
            for (int ks = 0; ks < 2; ++ks) qf2[hh][ks] = *(const h16x8*)((const u16*)(ws + WS_Q) + row * 512 + (4 * g + 2 * hp + hh) * 64 + 32 * ks + 8 * quad);
        float m[2] = {-1e30f, -1e30f}, l[2] = {0.f, 0.f};
        for (int P = 0; P < nP; ++P) {
            h16x8 kp[2][2];
#pragma unroll
            for (int tt = 0; tt < 2; ++tt) { kp[tt][0] = *(const LAS h16x8*)(kl + (2 * P + tt) * 16 * 144); kp[tt][1] = *(const LAS h16x8*)(kl + (2 * P + tt) * 16 * 144 + 64); }
            f32x4 sv[2][2];
#pragma unroll
            for (int tt = 0; tt < 2; ++tt)
#pragma unroll
                for (int hh = 0; hh < 2; ++hh) { f32x4 z = {0.f, 0.f, 0.f, 0.f}; z = MFMA16H(kp[tt][0], qf2[hh][0], z); sv[tt][hh] = MFMA16H(kp[tt][1], qf2[hh][1], z); }
#pragma unroll
            for (int hh = 0; hh < 2; ++hh) {
                float mx = m[hh];
#pragma unroll
                for (int tt = 0; tt < 2; ++tt)
#pragma unroll
                    for (int i = 0; i < 4; ++i) mx = (16 * (2 * P + tt) + 4 * quad + i <= nlim) ? fmaxf(mx, sv[tt][hh][i]) : mx;
                float add = 0.f;
#pragma unroll
                for (int tt = 0; tt < 2; ++tt)
#pragma unroll
                    for (int i = 0; i < 4; ++i) add += (16 * (2 * P + tt) + 4 * quad + i <= nlim) ? __builtin_amdgcn_exp2f(sv[tt][hh][i] - mx) : 0.f;
                l[hh] = l[hh] * __builtin_amdgcn_exp2f(m[hh] - mx) + add; m[hh] = mx;
            }
        }
        float mall[2], inv[2];
#pragma unroll
        for (int hh = 0; hh < 2; ++hh) {
            float ma = fmaxf(m[hh], __shfl_xor(m[hh], 16)); ma = fmaxf(ma, __shfl_xor(ma, 32));
            float lw = l[hh] * __builtin_amdgcn_exp2f(m[hh] - ma); lw += __shfl_xor(lw, 16); lw += __shfl_xor(lw, 32);
            mall[hh] = ma; inv[hh] = lw > 0.f ? 1.0f / lw : 0.f;
        }
        f32x4 oc[2][4];
#pragma unroll
        for (int hh = 0; hh < 2; ++hh)
#pragma unroll
            for (int dt = 0; dt < 4; ++dt) oc[hh][dt] = (f32x4){0.f, 0.f, 0.f, 0.f};
        float cwrap = 0.f;
        u32x2 vn[4][2];
#pragma unroll
        for (int dt = 0; dt < 4; ++dt) { const u16* vp = vtg + (size_t)(16 * dt + qi) * 512 + 4 * quad; vn[dt][0] = *(const u32x2*)vp; vn[dt][1] = *(const u32x2*)(vp + 16); }
        for (int P = 0; P < nP; ++P) {
            u32x4 va4[4];
#pragma unroll
            for (int dt = 0; dt < 4; ++dt) va4[dt] = (u32x4){vn[dt][0].x, vn[dt][0].y, vn[dt][1].x, vn[dt][1].y};
            if (P + 1 < nP) {
#pragma unroll
                for (int dt = 0; dt < 4; ++dt) { const u16* vp = vtg + (size_t)(16 * dt + qi) * 512 + 32 * (P + 1) + 4 * quad; vn[dt][0] = *(const u32x2*)vp; vn[dt][1] = *(const u32x2*)(vp + 16); }
            }
            h16x8 kp[2][2];
#pragma unroll
            for (int tt = 0; tt < 2; ++tt) { kp[tt][0] = *(const LAS h16x8*)(kl + (2 * P + tt) * 16 * 144); kp[tt][1] = *(const LAS h16x8*)(kl + (2 * P + tt) * 16 * 144 + 64); }
            f32x4 sv[2][2];
#pragma unroll
            for (int tt = 0; tt < 2; ++tt)
#pragma unroll
                for (int hh = 0; hh < 2; ++hh) { f32x4 z = {0.f, 0.f, 0.f, 0.f}; z = MFMA16H(kp[tt][0], qf2[hh][0], z); sv[tt][hh] = MFMA16H(kp[tt][1], qf2[hh][1], z); }
            u32x4 pw[2];
            float A2[2], C2[2];
#pragma unroll
            for (int tt = 0; tt < 2; ++tt) {
                const int n0 = 16 * (2 * P + tt) + 4 * quad;
                float A = 0.f, C = 0.f;
#pragma unroll
                for (int hh = 0; hh < 2; ++hh) {
                    float pv[4];
#pragma unroll
                    for (int i = 0; i < 4; ++i) pv[i] = (n0 + i <= nlim) ? __builtin_amdgcn_exp2f(sv[tt][hh][i] - mall[hh]) * inv[hh] : 0.f;
                    A += (pv[0] + pv[1]) + (pv[2] + 0.5f * pv[3]); C += 0.5f * pv[3];
                    if (tt == 0) { pw[hh].x = pkh(pv[0], pv[1]); pw[hh].y = pkh(pv[2], pv[3]); } else { pw[hh].z = pkh(pv[0], pv[1]); pw[hh].w = pkh(pv[2], pv[3]); }
                }
                A2[tt] = A; C2[tt] = C;
            }
            const float cup0 = __shfl_up(C2[0], 16), cup1 = __shfl_up(C2[1], 16);
            const float cw0 = __shfl(C2[0], qi + 48), cw1 = __shfl(C2[1], qi + 48);
            ir[4 * (2 * P)] = A2[0] + (quad > 0 ? cup0 : cwrap);
            ir[4 * (2 * P + 1)] = A2[1] + (quad > 0 ? cup1 : cw0);
            cwrap = cw1;
#pragma unroll
            for (int dt = 0; dt < 4; ++dt) {
#pragma unroll
                for (int hh = 0; hh < 2; ++hh) oc[hh][dt] = MFMA16H(__builtin_bit_cast(h16x8, va4[dt]), __builtin_bit_cast(h16x8, pw[hh]), oc[hh][dt]);
            }
        }
        if (quad == 0 && 2 * nP < 32) ir[4 * (2 * nP)] = cwrap;
#pragma unroll
        for (int hh = 0; hh < 2; ++hh) {
            const int h = 2 * hp + hh;
            const float g0 = gates[row * 24 + (4 * g + h) * 3 + 0];
#pragma unroll
            for (int dt = 0; dt < 4; ++dt) {
                u32x2 w; w.x = pkh(oc[hh][dt][0] * g0, oc[hh][dt][1] * g0); w.y = pkh(oc[hh][dt][2] * g0, oc[hh][dt][3] * g0);
                *(u32x2*)((u16*)(ws + WS_Y) + row * DM + (4 * g + h) * 64 + 16 * dt + 4 * quad) = w;
            }
        }
    }
    __syncthreads();
    {
        const int cur = qt, nf = cur == 0 ? 1 : (cur == 1 ? 2 : 3), need = NTOP - nf, jhi = cur - 2;
        int ln2 = lane; asm volatile("" : "+v"(ln2));
        const int j1 = ln2, j2 = ln2 + 64;
        const bool c1 = (j1 >= 1 && j1 <= jhi), c2 = (j2 <= jhi);
        const bool f1 = (j1 == 0) || (j1 == cur) || (j1 == cur - 1), f2 = (j2 == cur) || (j2 == cur - 1);
#pragma unroll 1
        for (int q0 = 0; q0 < 8; q0 += 4) {
            unsigned u1[4], u2[4];
#pragma unroll
            for (int k = 0; k < 4; ++k) {
                const int q = 8 * wave + q0 + k;
                const LAS float* ir0 = imp + q * NS_IMP_P; const LAS float* ir1 = imp + (64 + q) * NS_IMP_P;
                u1[k] = __float_as_uint(ir0[j1] + ir1[j1]); u2[k] = __float_as_uint(ir0[j2] + ir1[j2]);
                u1[k] = c1 ? u1[k] : 0u; u2[k] = c2 ? u2[k] : 0u;
            }
            unsigned pre[4] = {0u, 0u, 0u, 0u};
            if (jhi > need) {
                for (int bit = 30; bit >= 0; --bit) {
#pragma unroll
                    for (int k = 0; k < 4; ++k) {
                        const unsigned tr = pre[k] | (1u << bit);
                        const int cge = __popcll(__ballot(u1[k] >= tr)) + __popcll(__ballot(u2[k] >= tr));
                        pre[k] = cge >= need ? tr : pre[k];
                    }
                }
            }
#pragma unroll
            for (int k = 0; k < 4; ++k) {
                const int q = 8 * wave + q0 + k;
                bool s1 = f1 || c1, s2 = f2 || c2;
                if (jhi > need) {
                    const unsigned long long g1 = __ballot(c1 && u1[k] > pre[k]), g2 = __ballot(c2 && u2[k] > pre[k]);
                    const unsigned long long e1 = __ballot(c1 && u1[k] == pre[k]), e2 = __ballot(c2 && u2[k] == pre[k]);
                    const int rem = need - (__popcll(g1) + __popcll(g2));
                    const int er1 = __builtin_amdgcn_mbcnt_hi((unsigned)(e1 >> 32), __builtin_amdgcn_mbcnt_lo((unsigned)e1, 0u));
                    const int er2 = __popcll(e1) + __builtin_amdgcn_mbcnt_hi((unsigned)(e2 >> 32), __builtin_amdgcn_mbcnt_lo((unsigned)e2, 0u));
                    s1 = f1 || (c1 && (u1[k] > pre[k] || (u1[k] == pre[k] && er1 < rem)));
                    s2 = f2 || (c2 && (u2[k] > pre[k] || (u2[k] == pre[k] && er2 < rem)));
                }
                const unsigned long long m1 = __ballot(s1), m2 = __ballot(s2);
                if (ln2 == 0) { bm[q * 4 + 0] = (unsigned)m1; bm[q * 4 + 1] = (unsigned)(m1 >> 32); bm[q * 4 + 2] = (unsigned)m2; bm[q * 4 + 3] = (unsigned)(m2 >> 32); }
            }
        }
    }
    AT_BAR();
    {
        constexpr int MB_QL = 0, MB_QP = 528, MB_KV = 33792, MB_SLOT = MB_KV + 8 * AT_TILE, MB_SP = 144, MB_SLOTL = MB_SLOT + 8 * 32 * MB_SP, MB_PERM = MB_SLOTL + 1024;
        static_assert(64 * MB_QP <= MB_KV && MB_PERM + 512 <= LDS_BYTES - 256, "mbr LDS map");
        int ln3 = lane, td3 = tid; asm volatile("" : "+v"(ln3), "+v"(td3));
        const int r32 = ln3 & 31, hi = ln3 >> 5, qi = r32 >> 2, h = r32 & 3;
        const int prow = (r32 & 0x13) | ((r32 & 8) >> 1) | ((r32 & 4) << 1);
        const int oq = td3 >> 3, oh = (td3 >> 1) & 3, ohf = td3 & 1;
        LAS unsigned char* ql = lds + MB_QL;
        LAS unsigned char* kvl = lds + MB_KV;
        LAS unsigned char* slots = lds + MB_SLOT;
        LAS float* slotl = (LAS float*)(lds + MB_SLOTL);
        LAS unsigned char* permw = lds + MB_PERM + wave * 64;
        {
            const u16* qsrc = (const u16*)(ws + WS_Q) + ((size_t)b * SEQ + 64 * qt) * 512 + 4 * g * 64;
#pragma unroll
            for (int i = 0; i < 4; ++i) { const int idx = td3 + NTHREADS * i, r = idx >> 5, pc = idx & 31; *(LAS u32x4*)(ql + r * MB_QP + pc * 16) = *(const u32x4*)(qsrc + (size_t)r * 512 + pc * 8); }
        }
        const int srow = td3 >> 3, sch = td3 & 7;
        const u16* ksrc = (const u16*)(ws + WS_KS) + (size_t)bg * SEQ * 64 + (size_t)srow * 64 + 8 * sch;
        const u16* vsrc = (const u16*)(ws + WS_VST) + (size_t)bg * 64 * SEQ + (size_t)srow * 64 + 8 * sch;
        const int sdst = srow * AT_PITCH + sch * 16;
        const int nrnd = (qt + 4) >> 2;
        u32x4 kr[4], vr[4];
#define MB_LOAD(R_) do { _Pragma("unroll") for (int bi = 0; bi < 4; ++bi) { const int jb_ = 4 * (R_) + bi; const int jc_ = jb_ <= qt ? jb_ : qt; \
            kr[bi] = *(const u32x4*)(ksrc + (size_t)jc_ * 4096); vr[bi] = *(const u32x4*)(vsrc + (size_t)jc_ * 4096); } } while (0)
#define MB_STORE() do { _Pragma("unroll") for (int bi = 0; bi < 4; ++bi) { *(LAS u32x4*)(kvl + bi * AT_TILE + sdst) = kr[bi]; *(LAS u32x4*)(kvl + (4 + bi) * AT_TILE + sdst) = vr[bi]; } } while (0)
        MB_LOAD(0);
        const unsigned mybm0 = bm[ln3 * 4 + 0], mybm1 = bm[ln3 * 4 + 1], mybm2 = bm[ln3 * 4 + 2], mybm3 = bm[ln3 * 4 + 3];
        MB_STORE();
        h16x2 oa[16]; float la = 0.f;
#pragma unroll
        for (int e = 0; e < 16; ++e) oa[e] = (h16x2){(h16)0.f, (h16)0.f};
        const u32x4 onesw = {0x3c003c00u, 0x3c003c00u, 0x3c003c00u, 0x3c003c00u};
        const int koff = prow * AT_PITCH + hi * 16, voff = 4 * AT_TILE + r32 * AT_PITCH + hi * 16;
        const unsigned blo = oq >= 32 ? 0xffffffffu : ((1u << oq) - 1u), bhi = oq >= 32 ? ((1u << (oq - 32)) - 1u) : 0u;
        const unsigned obit = 1u << (oq & 31); const bool ohigh = oq >= 32;
        AT_BAR();
        for (int R = 0; R < nrnd; ++R) {
            if (R + 1 < nrnd) MB_LOAD(R + 1);
            unsigned long long mk[4]; int cb[4], base[4]; int NI = 0;
#pragma unroll
            for (int bi = 0; bi < 4; ++bi) {
                const int j = 4 * R + bi;
                const unsigned mw = j < 32 ? mybm0 : (j < 64 ? mybm1 : (j < 96 ? mybm2 : mybm3));
                const bool bit = (j <= qt) && ((mw >> (j & 31)) & 1u);
                mk[bi] = __ballot(bit); cb[bi] = __popcll(mk[bi]); base[bi] = NI; NI += (cb[bi] + 7) >> 3;
            }
            const int nsub = (NI + 7) >> 3;
            for (int sr = 0; sr < nsub; ++sr) {
                const int it = 8 * sr + wave;
                if (it < NI) {
                    int bi = 0;
                    if (it >= base[1]) bi = 1;
                    if (it >= base[2]) bi = 2;
                    if (it >= base[3]) bi = 3;
                    const unsigned long long mkb = bi == 0 ? mk[0] : (bi == 1 ? mk[1] : (bi == 2 ? mk[2] : mk[3]));
                    const int cbb = bi == 0 ? cb[0] : (bi == 1 ? cb[1] : (bi == 2 ? cb[2] : cb[3]));
                    const int sub = it - (bi == 0 ? base[0] : (bi == 1 ? base[1] : (bi == 2 ? base[2] : base[3])));
                    const int j = 4 * R + bi;
                    const unsigned mwj = j < 32 ? mybm0 : (j < 64 ? mybm1 : (j < 96 ? mybm2 : mybm3));
                    const bool bit = (mwj >> (j & 31)) & 1u;
                    const int rank = __builtin_amdgcn_mbcnt_hi((unsigned)(mkb >> 32), __builtin_amdgcn_mbcnt_lo((unsigned)mkb, 0u));
                    if (bit) permw[rank] = (unsigned char)ln3;
                    h16x8 qf[4], kf[8];
#pragma unroll
                    for (int kh = 0; kh < 2; ++kh)
#pragma unroll
                        for (int d0 = 0; d0 < 4; ++d0) kf[kh * 4 + d0] = *(const LAS h16x8*)(kvl + bi * AT_TILE + kh * 32 * AT_PITCH + koff + d0 * 32);
                    const int slotq = 8 * sub + qi;
                    const bool valid = slotq < cbb;
                    const int q = valid ? (int)permw[slotq] : 0;
#pragma unroll
                    for (int d0 = 0; d0 < 4; ++d0) qf[d0] = *(const LAS h16x8*)(ql + q * MB_QP + h * 128 + d0 * 32 + hi * 16);
                    __builtin_amdgcn_sched_barrier(0);
                    f32x16 sx[2];
#pragma unroll
                    for (int kh = 0; kh < 2; ++kh) {
#pragma unroll
                        for (int e = 0; e < 16; ++e) sx[kh][e] = -(OFF2 + 4.0f);
#pragma unroll
                        for (int d0 = 0; d0 < 4; ++d0) sx[kh] = MFMA32H(kf[kh * 4 + d0], qf[d0], sx[kh]);
                    }
                    h16x8 vfr[8];
#pragma unroll
                    for (int dt = 0; dt < 2; ++dt)
#pragma unroll
                        for (int kk = 0; kk < 4; ++kk) vfr[dt * 4 + kk] = *(const LAS h16x8*)(kvl + bi * AT_TILE + voff + dt * 32 * AT_PITCH + kk * 32);
                    __builtin_amdgcn_sched_barrier(0);
                    const bool diag = (j == qt);
                    const unsigned vmk = valid ? 0xffffffffu : 0u;
                    u32x4 pw[4];
#pragma unroll
                    for (int kk = 0; kk < 4; ++kk) {
                        float pv[8];
#pragma unroll
                        for (int e = 0; e < 8; ++e) {
                            float pe = __builtin_amdgcn_exp2f(sx[kk >> 1][8 * (kk & 1) + e]);
                            if (diag) pe = (16 * kk + 8 * hi + e <= q) ? pe : 0.f;
                            pv[e] = pe;
                        }
                        pw[kk] = (u32x4){pkh(pv[0], pv[1]) & vmk, pkh(pv[2], pv[3]) & vmk, pkh(pv[4], pv[5]) & vmk, pkh(pv[6], pv[7]) & vmk};
                    }
                    f32x16 o[2], ol;
#pragma unroll
                    for (int e = 0; e < 16; ++e) { o[0][e] = 0.f; o[1][e] = 0.f; ol[e] = 0.f; }
#pragma unroll
                    for (int kk = 0; kk < 4; ++kk) {
                        const h16x8 pb2 = __builtin_bit_cast(h16x8, pw[kk]);
#pragma unroll
                        for (int dt = 0; dt < 2; ++dt) o[dt] = MFMA32H(vfr[dt * 4 + kk], pb2, o[dt]);
                        ol = MFMA32H(__builtin_bit_cast(h16x8, onesw), pb2, ol);
                    }
                    LAS unsigned char* sp = slots + (wave * 32 + r32) * MB_SP + hi * 8;
#pragma unroll
                    for (int dt = 0; dt < 2; ++dt)
#pragma unroll
                        for (int r4 = 0; r4 < 4; ++r4) { u32x2 w; w.x = pkh(o[dt][4 * r4], o[dt][4 * r4 + 1]); w.y = pkh(o[dt][4 * r4 + 2], o[dt][4 * r4 + 3]); *(LAS u32x2*)(sp + dt * 64 + r4 * 16) = w; }
                    if (hi == 0) slotl[wave * 32 + r32] = ol[0];
                }
                AT_BAR();
                if (sr == nsub - 1 && R + 1 < nrnd) MB_STORE();
#pragma unroll
                for (int bi = 0; bi < 4; ++bi) {
                    const unsigned mlo = (unsigned)mk[bi], mhi = (unsigned)(mk[bi] >> 32);
                    if ((ohigh ? mhi : mlo) & obit) {
                        const int rk = __builtin_popcount(mlo & blo) + __builtin_popcount(mhi & bhi);
                        const int itb = base[bi] + (rk >> 3);
                        if ((itb >> 3) == sr) {
                            const int sl = itb & 7, col = 4 * (rk & 7) + oh;
                            const LAS unsigned char* sp = slots + (sl * 32 + col) * MB_SP + ohf * 64;
#pragma unroll
                            for (int c8 = 0; c8 < 4; ++c8) {
                                const h16x8 v = *(const LAS h16x8*)(sp + c8 * 16);
#pragma unroll
                                for (int e = 0; e < 4; ++e) oa[4 * c8 + e] += (h16x2){v[2 * e], v[2 * e + 1]};
                            }
                            la += slotl[sl * 32 + col];
                        }
                    }
                }
                AT_BAR();
            }
            if (nsub == 0 && R + 1 < nrnd) { MB_STORE(); AT_BAR(); }
        }
#undef MB_LOAD
#undef MB_STORE
        {
            const size_t row = (size_t)b * SEQ + 64 * qt + oq;
            const float g1 = gates[row * 24 + (4 * g + oh) * 3 + 1];
            const float sc = g1 / la;
            const u16* owp = (const u16*)(ws + WS_OWIN) + row * 512 + (4 * g + oh) * 64 + 32 * ohf;
            u16* yp = (u16*)(ws + WS_Y) + row * DM + (4 * g + oh) * 64 + 32 * ohf;
            float ssq = 0.f;
#pragma unroll
            for (int c8 = 0; c8 < 4; ++c8) {
                const h16x8 cw = *(const h16x8*)(yp + 8 * c8), ww = *(const h16x8*)(owp + 8 * c8);
                float y[8];
#pragma unroll
                for (int e = 0; e < 8; ++e) { y[e] = (float)oa[4 * c8 + (e >> 1)][e & 1] * sc + (float)cw[e] + (float)ww[e]; ssq += y[e] * y[e]; }
                const u32x4 w = {pkh(y[0], y[1]), pkh(y[2], y[3]), pkh(y[4], y[5]), pkh(y[6], y[7])};
                *(u32x4*)(yp + 8 * c8) = w;
            }
            ssq += __shfl_xor(ssq, 1); ssq += __shfl_xor(ssq, 2); ssq += __shfl_xor(ssq, 4);
            if ((td3 & 7) == 0) ((float*)(ws + WS_SSQ))[row * 2 + g] = ssq;
        }
    }
    __syncthreads();
}

__device__ __forceinline__ void nsa_finalize_unit(unsigned char* ws, const float* gain, int u, int wave, int lane) {
    const f32x4 g0 = *(const f32x4*)(gain + 8 * lane), g1 = *(const f32x4*)(gain + 8 * lane + 4);
#pragma unroll 1
    for (int i0 = 0; i0 < 16; i0 += 8) {
        f32x2 sq[8]; h16x8 v[8];
#pragma unroll
        for (int i = 0; i < 8; ++i) {
            const size_t row = (size_t)u * 128 + wave * 16 + i0 + i;
            sq[i] = *(const f32x2*)((const float*)(ws + WS_SSQ) + row * 2);
            v[i] = *(const h16x8*)((const u16*)(ws + WS_Y) + row * DM + 8 * lane);
        }
#pragma unroll
        for (int i = 0; i < 8; ++i) {
            const size_t row = (size_t)u * 128 + wave * 16 + i0 + i;
            const float rs = 1.0f / sqrtf((sq[i][0] + sq[i][1]) * (1.0f / 512.f) + EPS);
            u32x4 w;
            w.x = pkh((float)v[i][0] * rs * g0[0], (float)v[i][1] * rs * g0[1]); w.y = pkh((float)v[i][2] * rs * g0[2], (float)v[i][3] * rs * g0[3]);
            w.z = pkh((float)v[i][4] * rs * g1[0], (float)v[i][5] * rs * g1[1]); w.w = pkh((float)v[i][6] * rs * g1[2], (float)v[i][7] * rs * g1[3]);
            *(u32x4*)((u16*)(ws + WS_Y) + row * DM + 8 * lane) = w;
        }
    }
}
constexpr int HG_LFP = 129;
constexpr int HG_OFF_LF = 0, HG_OFF_SEG = 33024, HG_OFF_KT = 35072, HG_OFF_VT = 35072 + 18432;
constexpr int H3_OFF_QT = 35072, H3_OFF_KH = H3_OFF_QT + 17408, H3_OFF_VT = H3_OFF_KH + 17408, H3_OFF_SSQ = H3_OFF_VT + 18432;
static_assert(H3_OFF_SSQ + 256 <= LDS_BYTES, "hgrn LDS map");

__device__ __forceinline__ void hg_load_logf(const unsigned char* ws, LAS float* lf, size_t row0, int h, int tid) {
#pragma unroll
    for (int i = 0; i < 2; ++i) {
        const int idx = tid + NTHREADS * i, s = idx >> 4, ch = idx & 15;
        const h16x8 v = *(const h16x8*)((const u16*)(ws + WS_HLOGF) + (row0 + s) * 512 + h * 128 + 8 * ch);
#pragma unroll
        for (int e = 0; e < 8; ++e) lf[s * HG_LFP + 8 * ch + e] = (float)v[e];
    }
}
__device__ __forceinline__ void hg_stage_vt(const unsigned char* ws, LAS u16* vt, size_t row0, int h, int tid) {
#pragma unroll
    for (int i = 0; i < 2; ++i) {
        const int idx = tid + NTHREADS * i, s = idx & 63, ch = idx >> 6;
        const s16x8 v = *(const s16x8*)((const u16*)(ws + WS_HV) + (row0 + s) * 512 + h * 128 + 8 * ch);
#pragma unroll
        for (int e = 0; e < 8; ++e) vt[(8 * ch + e) * 72 + s] = (u16)v[e];
    }
}

__device__ __forceinline__ void hgrn_h1_units(unsigned char* ws, LAS unsigned char* lds, int u0, int stride, int nu, int wave, int lane) {
    if (u0 >= nu) return;
    const int tid = threadIdx.x, r32 = lane & 31, hi = lane >> 5;
    LAS float* lf = (LAS float*)(lds + HG_OFF_LF);
    LAS float* seg = (LAS float*)(lds + HG_OFF_SEG);
    LAS u16* kt = (LAS u16*)(lds + HG_OFF_KT);
    LAS u16* vt = (LAS u16*)(lds + HG_OFF_VT);
    h16x8 lfr[2]; s16x8 vvr[2];
#define H1_LOAD(uu) do { const int c_ = (uu) & 127, bh_ = (uu) >> 7; const size_t r0_ = (size_t)(bh_ >> 2) * SEQ + 64 * c_; const int h_ = bh_ & 3; \
        _Pragma("unroll") for (int i = 0; i < 2; ++i) { const int idx = tid + NTHREADS * i; \
            lfr[i] = *(const h16x8*)((const u16*)(ws + WS_HLOGF) + (r0_ + (idx >> 4)) * 512 + h_ * 128 + 8 * (idx & 15)); \
            vvr[i] = *(const s16x8*)((const u16*)(ws + WS_HV) + (r0_ + (idx & 63)) * 512 + h_ * 128 + 8 * (idx >> 6)); } } while (0)
    H1_LOAD(u0);
    for (int u = u0; u < nu; u += stride) {
        const int c = u & 127, bh = u >> 7;
#pragma unroll
        for (int i = 0; i < 2; ++i) {
            const int idx = tid + NTHREADS * i;
            { const int s = idx >> 4, ch = idx & 15;
#pragma unroll
              for (int e = 0; e < 8; ++e) lf[s * HG_LFP + 8 * ch + e] = (float)lfr[i][e]; }
            { const int s = idx & 63, ch = idx >> 6;
#pragma unroll
              for (int e = 0; e < 8; ++e) vt[(8 * ch + e) * 72 + s] = (u16)vvr[i][e]; }
        }
        if (u + stride < nu) H1_LOAD(u + stride);
        AT_BAR();
        const int d = tid & 127, sg = tid >> 7;
        float lg[16]; float tot = 0.f;
#pragma unroll
        for (int i = 0; i < 16; ++i) { lg[i] = lf[(16 * sg + i) * HG_LFP + d]; tot += lg[i]; }
        seg[sg * 128 + d] = tot;
        AT_BAR();
        {
            float R = 0.f;
            for (int s2 = sg + 1; s2 < 4; ++s2) R += seg[s2 * 128 + d];
#pragma unroll
            for (int i = 15; i >= 0; --i) {
                const float ke = (1.0f - __expf(lg[i])) * __expf(R);
                kt[d * 72 + 16 * sg + i] = f2b(ke);
                R += lg[i];
            }
            if (sg == 0) ((float*)(ws + WS_HD))[((size_t)bh * 128 + c) * 128 + d] = __expf(R);
        }
        AT_BAR();
        {
            const int vtile = wave & 3;
            s16x8 bfr[4];
#pragma unroll
            for (int ks = 0; ks < 4; ++ks) bfr[ks] = *(const LAS s16x8*)(vt + (32 * vtile + r32) * 72 + 16 * ks + 8 * hi);
            u16* dst = (u16*)(ws + WS_HL) + (((size_t)bh * 128 + c) * 128 + 32 * vtile + r32) * 128;
#pragma unroll
            for (int dd = 0; dd < 2; ++dd) {
                const int dtile = 2 * (wave >> 2) + dd;
                f32x16 acc;
#pragma unroll
                for (int i = 0; i < 16; ++i) acc[i] = 0.f;
                s16x8 afr[4];
#pragma unroll
                for (int ks = 0; ks < 4; ++ks) afr[ks] = *(const LAS s16x8*)(kt + (32 * dtile + r32) * 72 + 16 * ks + 8 * hi);
#pragma unroll
                for (int ks = 0; ks < 4; ++ks) acc = MFMA32B(afr[ks], bfr[ks], acc);
#pragma unroll
                for (int r4 = 0; r4 < 4; ++r4) {
                    u32x2 w; w.x = pkb(acc[4 * r4], acc[4 * r4 + 1]); w.y = pkb(acc[4 * r4 + 2], acc[4 * r4 + 3]);
                    *(u32x2*)(dst + 32 * dtile + 8 * r4 + 4 * hi) = w;
                }
            }
        }
        AT_BAR();
    }
#undef H1_LOAD
}

__device__ __forceinline__ void hgrn_h2_unit(unsigned char* ws, int u, int wave, int lane) {
    if (wave >= 2) return;
    const int gt = u * 128 + wave * 64 + lane;
    const int bh = gt >> 12, v = (gt >> 5) & 127, d0 = 4 * (gt & 31);
    const u16* lp = (const u16*)(ws + WS_HL) + ((size_t)bh * 128 * 128 + v) * 128 + d0;
    u16* sp = (u16*)(ws + WS_HS) + ((size_t)bh * 128 * 128 + v) * 128 + d0;
    const float* dp = (const float*)(ws + WS_HD) + (size_t)bh * 128 * 128 + d0;
    float S0 = 0.f, S1 = 0.f, S2 = 0.f, S3 = 0.f;
#pragma unroll 1
    for (int c0 = 0; c0 < 128; c0 += 16) {
        u32x2 lw[16]; f32x4 dv[16];
#pragma unroll
        for (int i = 0; i < 16; ++i) { lw[i] = *(const u32x2*)(lp + (size_t)(c0 + i) * 16384); dv[i] = *(const f32x4*)(dp + (c0 + i) * 128); }
#pragma unroll
        for (int i = 0; i < 16; ++i) {
            u32x2 w; w.x = pkb(S0, S1); w.y = pkb(S2, S3);
            *(u32x2*)(sp + (size_t)(c0 + i) * 16384) = w;
            S0 = dv[i][0] * S0 + __builtin_bit_cast(float, lw[i].x << 16); S1 = dv[i][1] * S1 + __builtin_bit_cast(float, lw[i].x & 0xffff0000u);
            S2 = dv[i][2] * S2 + __builtin_bit_cast(float, lw[i].y << 16); S3 = dv[i][3] * S3 + __builtin_bit_cast(float, lw[i].y & 0xffff0000u);
        }
    }
}

constexpr int H3_OFF_QR = H3_OFF_SSQ + 256;
static_assert(H3_OFF_QR + 64 * 136 * 2 <= LDS_BYTES - 256, "hgrn h3 LDS map");
__device__ __forceinline__ void hgrn_h3_units(unsigned char* ws, LAS unsigned char* lds, const float* ogain, int u0, int stride, int nu, int wave, int lane) {
    if (u0 >= nu) return;
    const int tid = threadIdx.x, r32 = lane & 31, hi = lane >> 5;
    LAS float* lf = (LAS float*)(lds + HG_OFF_LF);
    LAS float* seg = (LAS float*)(lds + HG_OFF_SEG);
    LAS u16* qt = (LAS u16*)(lds + H3_OFF_QT);
    LAS u16* kh = (LAS u16*)(lds + H3_OFF_KH);
    LAS u16* vt = (LAS u16*)(lds + H3_OFF_VT);
    LAS float* ssq = (LAS float*)(lds + H3_OFF_SSQ);
    LAS u16* qr = (LAS u16*)(lds + H3_OFF_QR);
    h16x8 lfr[2]; s16x8 vvr[2], qqr[2];
#define H3_LOAD(uu) do { const int c_ = (uu) & 127, bh_ = (uu) >> 7; const size_t r0_ = (size_t)(bh_ >> 2) * SEQ + 64 * c_; const int h_ = bh_ & 3; \
        _Pragma("unroll") for (int i = 0; i < 2; ++i) { const int idx = tid + NTHREADS * i; \
            lfr[i] = *(const h16x8*)((const u16*)(ws + WS_HLOGF) + (r0_ + (idx >> 4)) * 512 + h_ * 128 + 8 * (idx & 15)); \
            qqr[i] = *(const s16x8*)((const u16*)(ws + WS_HQ) + (r0_ + (idx >> 4)) * 512 + h_ * 128 + 8 * (idx & 15)); \
            vvr[i] = *(const s16x8*)((const u16*)(ws + WS_HV) + (r0_ + (idx & 63)) * 512 + h_ * 128 + 8 * (idx >> 6)); } } while (0)
    H3_LOAD(u0);
    for (int u = u0; u < nu; u += stride) {
        const int c = u & 127, bh = u >> 7, b = bh >> 2, h = bh & 3;
        const size_t row0 = (size_t)b * SEQ + 64 * c;
#pragma unroll
        for (int i = 0; i < 2; ++i) {
            const int idx = tid + NTHREADS * i;
            { const int s = idx >> 4, ch = idx & 15;
#pragma unroll
              for (int e = 0; e < 8; ++e) lf[s * HG_LFP + 8 * ch + e] = (float)lfr[i][e];
              *(LAS s16x8*)(qr + s * 136 + 8 * ch) = qqr[i]; }
            { const int s = idx & 63, ch = idx >> 6;
#pragma unroll
              for (int e = 0; e < 8; ++e) vt[(8 * ch + e) * 72 + s] = (u16)vvr[i][e]; }
        }
        if (tid < 64) ssq[tid] = 0.f;
        if (u + stride < nu) H3_LOAD(u + stride);
        s16x8 sfr[8];
        {
            const u16* sp = (const u16*)(ws + WS_HS) + (((size_t)bh * 128 + c) * 128 + 32 * (wave >> 1) + r32) * 128 + 8 * hi;
#pragma unroll
            for (int ks = 0; ks < 8; ++ks) sfr[ks] = *(const s16x8*)(sp + 16 * ks);
        }
        AT_BAR();
        const int d = tid & 127, sg = tid >> 7;
        float lg[16]; float tot = 0.f;
#pragma unroll
        for (int i = 0; i < 16; ++i) { lg[i] = lf[(16 * sg + i) * HG_LFP + d]; tot += lg[i]; }
        seg[sg * 128 + d] = tot;
        AT_BAR();
        {
            float Bc = 0.f;
            for (int s2 = 0; s2 < sg; ++s2) Bc += seg[s2 * 128 + d];
#pragma unroll
            for (int i = 0; i < 16; ++i) {
                Bc += lg[i];
                const float qv = b2f(qr[(16 * sg + i) * 136 + d]);
                qt[(16 * sg + i) * 136 + d] = f2b(qv * __expf(Bc));
                kh[(16 * sg + i) * 136 + d] = f2b((1.0f - __expf(lg[i])) * __expf(fminf(-Bc, 80.f)));
            }
        }
        AT_BAR();
        {
            const int th = wave & 1, vtile = wave >> 1;
            s16x8 qf[8];
#pragma unroll
            for (int ks = 0; ks < 8; ++ks) qf[ks] = *(const LAS s16x8*)(qt + (32 * th + r32) * 136 + 16 * ks + 8 * hi);
            f32x16 acc;
#pragma unroll
            for (int i = 0; i < 16; ++i) acc[i] = 0.f;
            {
#pragma unroll
                for (int ks = 0; ks < 8; ++ks) acc = MFMA32B(sfr[ks], qf[ks], acc);
            }
            const int prow = (r32 & 0x13) | ((r32 & 8) >> 1) | ((r32 & 4) << 1);
            for (int sh = 0; sh <= th; ++sh) {
                f32x16 x;
#pragma unroll
                for (int i = 0; i < 16; ++i) x[i] = 0.f;
                s16x8 kfr[8], vfr2[2];
#pragma unroll
                for (int ks = 0; ks < 8; ++ks) kfr[ks] = *(const LAS s16x8*)(kh + (32 * sh + prow) * 136 + 16 * ks + 8 * hi);
#pragma unroll
                for (int sp2 = 0; sp2 < 2; ++sp2) vfr2[sp2] = *(const LAS s16x8*)(vt + (32 * vtile + r32) * 72 + 32 * sh + 16 * sp2 + 8 * hi);
#pragma unroll
                for (int ks = 0; ks < 8; ++ks) x = MFMA32B(kfr[ks], qf[ks], x);
                u32x4 pw[2];
#pragma unroll
                for (int sp2 = 0; sp2 < 2; ++sp2) {
                    float xv[8];
#pragma unroll
                    for (int e = 0; e < 8; ++e) { const int sin_ = 16 * sp2 + 8 * hi + e; const bool ok = (sh < th) || (sin_ <= r32); xv[e] = ok ? x[8 * sp2 + e] : 0.f; }
                    pw[sp2] = (u32x4){pkb(xv[0], xv[1]), pkb(xv[2], xv[3]), pkb(xv[4], xv[5]), pkb(xv[6], xv[7])};
                }
#pragma unroll
                for (int sp2 = 0; sp2 < 2; ++sp2) acc = MFMA32B(vfr2[sp2], __builtin_bit_cast(s16x8, pw[sp2]), acc);
            }
            const int t = 32 * th + r32;
            const u16* gp = (const u16*)(ws + WS_HG) + (row0 + t) * 512 + h * 128 + 32 * vtile + 4 * hi;
            u32x2 gw4[4];
#pragma unroll
            for (int r4 = 0; r4 < 4; ++r4) gw4[r4] = *(const u32x2*)(gp + 8 * r4);
            float sq = 0.f;
#pragma unroll
            for (int i = 0; i < 16; ++i) sq += acc[i] * acc[i];
            sq += __shfl_xor(sq, 32);
            if (hi == 0) (void)__hip_atomic_fetch_add(ssq + t, sq, __ATOMIC_RELAXED, __HIP_MEMORY_SCOPE_WORKGROUP);
            AT_BAR();
            const float rs = 1.0f / sqrtf(ssq[t] * (1.0f / 128.f) + EPS);
            u16* yp = (u16*)(ws + WS_Y) + (row0 + t) * DM + 512 + h * 128 + 32 * vtile + 4 * hi;
            const float* gn = ogain + 32 * vtile + 4 * hi;
#pragma unroll
            for (int r4 = 0; r4 < 4; ++r4) {
                const h16x4 gv = __builtin_bit_cast(h16x4, gw4[r4]);
                const f32x4 gg = *(const f32x4*)(gn + 8 * r4);
                u32x2 w;
                w.x = pkh(acc[4 * r4] * rs * gg[0] * (float)gv[0], acc[4 * r4 + 1] * rs * gg[1] * (float)gv[1]);
                w.y = pkh(acc[4 * r4 + 2] * rs * gg[2] * (float)gv[2], acc[4 * r4 + 3] * rs * gg[3] * (float)gv[3]);
                *(u32x2*)(yp + 8 * r4) = w;
            }
        }
        AT_BAR();
    }
#undef H3_LOAD
}
__global__ void __launch_bounds__(NTHREADS, 2) mk_fwd(Params p) {
    extern __shared__ __attribute__((aligned(16))) unsigned char lds_raw[];
    LAS unsigned char* lds = (LAS unsigned char*)lds_raw;
    const int tid = threadIdx.x, lane = tid & 63, wave = __builtin_amdgcn_readfirstlane(tid >> 6);
    const int G = gridDim.x, bx = blockIdx.x;
    const int vcu = (G % 8 == 0) ? (bx % 8) * (G / 8) + bx / 8 : bx;
    const int gw = vcu * NWAVES + wave, NGW = G * NWAVES;
    unsigned char* ws = p.ws;
#define IN(k) (p.ph_lo <= (k) && (k) < p.ph_hi)
    volatile LAS unsigned* xst = (volatile LAS unsigned*)(lds + LDS_BYTES - 256);
    unsigned* barw = (unsigned*)(ws + WS_CTL);
    XcdBarrier xbar; xbar.bar = barw; xbar.x = 0; xbar.st = xst;
    const bool fused = (p.ph_hi - p.ph_lo) > 1;
    if (fused) {
        if (tid < 2) xst[tid] = 0u;
        __syncthreads();
        xbar = xcd_barrier_post(barw, xst);
    }
#define SEAM(k) do { if (IN(k) && IN((k) + 1)) xcd_barrier(xbar); } while (0)

    if (IN(0)) { p0_prologue(p, lds, gw, NGW, wave, lane); }
    SEAM(0);
    if (IN(1)) {
        pg8::Gemm g{(const u16*)(ws + WS_XH), (const u16*)(ws + WS_WIN_T), MT, DINP, DM}; pg8::StaticOrder S; S.init(MT, DINP, G, bx);
        pg8::EpiInProj E{ws, p.in[3], p.in[4]};
        pg8::gemm_phase<pg8::EpiInProj, pg8::StaticOrder, true, true>(lds, g, S, E, wave);
        const int nfull = (MT / 256) * (DINP / 256) - 3 * G;
        if (nfull < 0 || nfull >= G) p0_late_transposes(p, lds, gw, NGW, wave, lane);
        else if (bx >= nfull) p0_late_transposes(p, lds, (bx - nfull) * NWAVES + wave, (G - nfull) * NWAVES, wave, lane);
    }
    SEAM(1);
    if (IN(2)) {
        constexpr int NU_WIN = 512, NU_CMP = 256, NU_H1 = 1024;
        for (int u = bx; u < NU_WIN + NU_CMP + NU_H1; u += G) {
            if (u < NU_WIN) win_unit(ws, lds, u, wave, lane);
            else if (u < NU_WIN + NU_CMP) cmp_mlp_unit(ws, lds, u - NU_WIN, wave, lane);
            else { hgrn_h1_units(ws, lds, u - NU_WIN - NU_CMP, G, NU_H1, wave, lane); break; }
        }
    }
    SEAM(2);
    if (IN(3)) {
        for (int v = bx; v < 512 + 256; v += G) {
            if (v < 512) {
                int bg, qt;
                if (G == 256) { const int c = v & 255, mem = (c & 1) * 32 + (c >> 3); bg = (c & 7) >> 1; qt = (v < 256) ? mem : 127 - mem; }
                else { const int vv = v & 255; bg = vv >> 6; qt = (v < 256) ? (vv & 63) : 127 - (vv & 63); }
                nsa_unit(ws, lds, bg, qt, wave, lane);
            }
            else hgrn_h2_unit(ws, v - 512, wave, lane);
        }
    }
    SEAM(3);
    if (IN(4)) {
        for (int u = bx; u < 128 + 1024; u += G) {
            if (u < 128) nsa_finalize_unit(ws, p.in[11], u, wave, lane);
            else { hgrn_h3_units(ws, lds, p.in[13], u - 128, G, 1024, wave, lane); break; }
        }
    }
    SEAM(4);
    if (IN(5)) {
        pg8::Gemm g{(const u16*)(ws + WS_Y), (const u16*)(ws + WS_WOUT_T), MT, DM, DM}; pg8::StaticOrder S; S.init(MT, DM, G, bx);
        pg8::EpiOutProj E{p.in[0], (u16*)(ws + WS_X1H), (float*)(ws + WS_SSQ1)};
        pg8::gemm_phase<pg8::EpiOutProj, pg8::StaticOrder, true, true>(lds, g, S, E, wave);
    }
    SEAM(5);
    if (IN(6)) {
        pg8::Gemm g{(const u16*)(ws + WS_X1H), (const u16*)(ws + WS_W1_T), MT, FF, DM}; pg8::StaticOrder S; S.init(MT, FF, G, bx);
        pg8::EpiUp E{(u16*)(ws + WS_HID), (const float*)(ws + WS_SSQ1)};
        pg8::gemm_phase<pg8::EpiUp, pg8::StaticOrder, true, true>(lds, g, S, E, wave);
    }
    SEAM(6);
    if (IN(7)) {
        pg8::Gemm g{(const u16*)(ws + WS_HID), (const u16*)(ws + WS_W2_T), MT, DM, FF}; pg8::StaticOrder S; S.init(MT, DM, G, bx);
        pg8::EpiDown E{p.out, (const u16*)(ws + WS_X1H)};
        pg8::gemm_phase<pg8::EpiDown, pg8::StaticOrder, true, true>(lds, g, S, E, wave);
    }
#undef IN
#undef SEAM
}
static int g_grid = 0;
extern "C" void kernel_launch(void* const* d_in, const int* in_sizes, int n_in, void* d_out, int out_size, void* d_ws, size_t ws_size, hipStream_t stream) {
    if (g_grid == 0) {
        int dev = 0, cus = 0, per_cu = 0;
        (void)hipGetDevice(&dev); (void)hipDeviceGetAttribute(&cus, hipDeviceAttributeMultiprocessorCount, dev);
        (void)hipFuncSetAttribute((const void*)mk_fwd, hipFuncAttributeMaxDynamicSharedMemorySize, LDS_BYTES);
        if (hipOccupancyMaxActiveBlocksPerMultiprocessor(&per_cu, (const void*)mk_fwd, NTHREADS, LDS_BYTES) != hipSuccess || per_cu < 1) { per_cu = 1; (void)hipGetLastError(); }
        if (cus <= 0) cus = 256;
        g_grid = cus;
    }
    Params P{};
    for (int i = 0; i < 18; ++i) P.in[i] = (const float*)d_in[i];
    P.out = (float*)d_out; P.ws = (unsigned char*)d_ws;
    for (int i = 0; i < 8; ++i) P.invf[i] = (float)pow(500000.0, -(double)(2 * i) / 16.0);
    P.ph_lo = 0; P.ph_hi = 8;
    (void)hipMemsetAsync((char*)d_ws + WS_CTL, 0, XCD_BAR_WORDS * sizeof(unsigned), stream);
    void* args[] = {&P};
    hipError_t e = hipLaunchCooperativeKernel((const void*)mk_fwd, dim3(g_grid), dim3(NTHREADS), args, LDS_BYTES, stream);
    if (e != hipSuccess) fprintf(stderr, "cooperative launch failed: %s (grid %d)\n", hipGetErrorString(e), g_grid);
}
```

```cpp
#include <hip/hip_runtime.h>
#include <hip/hip_cooperative_groups.h>
#include <cstdio>
#include <cstdint>
#include <cmath>
namespace cg = cooperative_groups;

#define LAS __attribute__((address_space(3)))
typedef _Float16 h16;
typedef _Float16 h16x2 __attribute__((ext_vector_type(2)));
typedef _Float16 h16x4 __attribute__((ext_vector_type(4)));
typedef _Float16 h16x8 __attribute__((ext_vector_type(8)));
typedef __bf16 b16x2 __attribute__((ext_vector_type(2)));
typedef __bf16 b16x8 __attribute__((ext_vector_type(8)));
typedef short s16x8 __attribute__((ext_vector_type(8)));
typedef short s16x4 __attribute__((ext_vector_type(4)));
typedef float f32x2 __attribute__((ext_vector_type(2)));
typedef float f32x4 __attribute__((ext_vector_type(4)));
typedef float f32x16 __attribute__((ext_vector_type(16)));
typedef unsigned u32x2 __attribute__((ext_vector_type(2)));
typedef unsigned u32x4 __attribute__((ext_vector_type(4)));
typedef unsigned short u16;

__device__ __forceinline__ unsigned pkh(float lo, float hi) { f32x2 v = {lo, hi}; h16x2 h = __builtin_convertvector(v, h16x2); return __builtin_bit_cast(unsigned, h); }
__device__ __forceinline__ unsigned pkb(float lo, float hi) { f32x2 v = {lo, hi}; b16x2 h = __builtin_convertvector(v, b16x2); return __builtin_bit_cast(unsigned, h); }
__device__ __forceinline__ float h2f(u16 v) { return (float)__builtin_bit_cast(h16, v); }
__device__ __forceinline__ float b2f(u16 v) { return __builtin_bit_cast(float, (unsigned)v << 16); }
__device__ __forceinline__ u16 f2h(float f) { return __builtin_bit_cast(u16, (h16)f); }
__device__ __forceinline__ u16 f2b(float f) { return (u16)(pkb(f, 0.f) & 0xffffu); }
__device__ __forceinline__ float wave_sum(float v) {
#pragma unroll
    for (int o = 1; o < 64; o <<= 1) v += __shfl_xor(v, o);
    return v;
}
__device__ __forceinline__ float sigmoid_f(float x) { return __builtin_amdgcn_rcpf(1.f + __expf(-x)); }

constexpr int BATCH = 2, SEQ = 8192, DM = 1024, MT = BATCH * SEQ, DIN = 3352, DINP = 3584, FF = 4096;
constexpr int NG = 2, HPG = 4, HD = 64, NQH = 8;
constexpr int NCMP = 511, NSLC = 128, NTOP = 16, WINDOW = 512;
constexpr int HGH = 4, HGD = 128;
constexpr float EPS = 1e-6f;
constexpr int C_Q = 0, C_KC = 512, C_VC = 640, C_KS = 768, C_VS = 896, C_KW = 1024, C_VW = 1152, C_GATE = 1280,
              C_HQ = 1304, C_HF = 1816, C_HI = 2328, C_HG = 2840;

constexpr size_t MiB = 1u << 20;
constexpr size_t WS_CTL = 0;
constexpr size_t WS_WIN_T = 1 * MiB;
constexpr size_t WS_WOUT_T = 8 * MiB;
constexpr size_t WS_W1_T = 10 * MiB;
constexpr size_t WS_W2_T = 18 * MiB;
constexpr size_t WS_CW1K_T = 26 * MiB;
constexpr size_t WS_CW1V_T = 26 * MiB + 512 * 1024;
constexpr size_t WS_CW2K_T = 27 * MiB;
constexpr size_t WS_CW2V_T = 27 * MiB + 16 * 1024;
constexpr size_t WS_PEK = 27 * MiB + 32 * 1024;
constexpr size_t WS_PEV = 27 * MiB + 40 * 1024;
constexpr size_t WS_LB = 27 * MiB + 48 * 1024;
constexpr size_t WS_ROPE = 27 * MiB + 256 * 1024;
constexpr size_t WS_XH = 28 * MiB;
constexpr size_t WS_HL = 28 * MiB;
constexpr size_t WS_X1H = 28 * MiB;
constexpr size_t WS_Q = 60 * MiB;
constexpr size_t WS_KC = 76 * MiB;
constexpr size_t WS_KS = 80 * MiB;
constexpr size_t WS_KW = 84 * MiB;
constexpr size_t WS_VC = 88 * MiB;
constexpr size_t WS_VST = 92 * MiB;
constexpr size_t WS_VWT = 96 * MiB;
constexpr size_t WS_GATES = 100 * MiB;
constexpr size_t WS_KCMP = 101 * MiB + 512 * 1024;
constexpr size_t WS_VCMPT = 101 * MiB + 768 * 1024;
constexpr size_t WS_HD = 102 * MiB;
constexpr size_t WS_SSQ = 102 * MiB + 512 * 1024;
constexpr size_t WS_SSQ1 = 103 * MiB;
constexpr size_t WS_HQ = 104 * MiB;
constexpr size_t WS_HLOGF = 120 * MiB;
constexpr size_t WS_HV = 136 * MiB;
constexpr size_t WS_HG = 152 * MiB;
constexpr size_t WS_OWIN = 168 * MiB;
constexpr size_t WS_HS = 184 * MiB;
constexpr size_t WS_Y = 216 * MiB;
constexpr size_t WS_HID = 104 * MiB;
constexpr size_t WS_END = 256 * MiB;

constexpr int NWAVES = 8, NTHREADS = 512;
constexpr int LDS_BYTES = 147456;

#define MK_LANE() ((int)__builtin_amdgcn_mbcnt_hi(~0u, __builtin_amdgcn_mbcnt_lo(~0u, 0u)))
namespace pg8 {
#define PG8_LAS __attribute__((address_space(3)))
typedef unsigned short bf16_t;
typedef short bf16x8 __attribute__((ext_vector_type(8)));
typedef float f32x4 __attribute__((ext_vector_type(4)));
typedef unsigned u32x4 __attribute__((ext_vector_type(4)));
constexpr int BM = 256, BK = 64, HALF = 128, HTB = HALF * BK * 2  , STAGE_BYTES = 8 * HTB, NXCD = 8, WGM = 8;

__host__ __device__ __forceinline__ int lds_byte(int r, int c) { const int st = (r >> 4) * 2 + (c >> 5), rr = r & 15, cc = c & 31, ob = rr * 64 + cc * 2; return st * 1024 + (ob ^ (((ob >> 9) & 1) << 5)); }
__host__ __device__ __forceinline__ void stage_rc(int b, int& R, int& C) { const int st = b / 1024, sb = b % 1024, swz = sb ^ (((sb >> 9) & 1) << 5); R = (st >> 1) * 16 + swz / 64; C = (st & 1) * 32 + (swz % 64) / 2; }
__host__ __device__ __forceinline__ int perm32(int rho) { const int n = rho >> 4, i = rho & 15; return 8 * (i >> 2) + 4 * n + (i & 3); }

struct Unit { int pm, pn; };
struct Gemm { const bf16_t* A; const bf16_t* Bt; int M, N, K; };

struct StaticOrder {
    int nM, nN, nwg, G, c;
    __host__ __device__ void init(int M, int N, int G_, int c_) { nM = M / BM; nN = N / BM; nwg = nM * nN; G = G_; c = c_; }
    __host__ __device__ bool next(int i, Unit& u) const {
        const long L = (long)i * G + c; if (L >= nwg) return false;
        int wgid = (int)L; { const int q = nwg / NXCD, r = nwg % NXCD, xcd = wgid % NXCD, off = wgid / NXCD; wgid = (xcd < r ? xcd * (q + 1) : r * (q + 1) + (xcd - r) * q) + off; }
        const int nig = WGM * nN, gid = wgid / nig, fm = gid * WGM, gsz = (nM - fm) < WGM ? (nM - fm) : WGM;
        u.pm = fm + ((wgid % nig) % gsz); u.pn = (wgid % nig) / gsz; return true;
    }
    __device__ __forceinline__ void a_ready(const Unit&) const {}
    __device__ __forceinline__ void done(const Unit&) const {}
};

#define PG8_MFMA(a, b, c) __builtin_amdgcn_mfma_f32_16x16x32_f16(__builtin_bit_cast(h16x8, (a)), __builtin_bit_cast(h16x8, (b)), (c), 0, 0, 0)
struct EpiOutProj {
    static constexpr bool PERM = false, AFTER_DRAIN = false;
    const float* x; u16* x1h; float* ssq1;
    __device__ __forceinline__ void operator()(const f32x4 (&acc)[2][2][4][2], const Unit& u, int wr, int wc, int fr, int fq) const {
        const int col0 = u.pn * BM + wc * 32 + 4 * fq;
#pragma unroll
        for (int ai = 0; ai < 2; ++ai) {
            f32x4 xr[4][2][2];
#pragma unroll
            for (int m = 0; m < 4; ++m) {
                const size_t off = (size_t)(u.pm * BM + ai * HALF + wr * 64 + m * 16 + fr) * DM + col0;
#pragma unroll
                for (int bj = 0; bj < 2; ++bj)
#pragma unroll
                    for (int n = 0; n < 2; ++n) xr[m][bj][n] = *(const f32x4*)(x + off + bj * HALF + n * 16);
            }
#pragma unroll
            for (int m = 0; m < 4; ++m) {
                const int row = u.pm * BM + ai * HALF + wr * 64 + m * 16 + fr;
                const size_t off = (size_t)row * DM + col0;
                float ss = 0.f;
#pragma unroll
                for (int bj = 0; bj < 2; ++bj)
#pragma unroll
                    for (int n = 0; n < 2; ++n) {
                        const f32x4 v = acc[ai][bj][m][n] + xr[m][bj][n];
                        u32x2 w; w.x = pkh(v[0], v[1]); w.y = pkh(v[2], v[3]);
                        *(u32x2*)(x1h + off + bj * HALF + n * 16) = w;
                        ss += (v[0] * v[0] + v[1] * v[1]) + (v[2] * v[2] + v[3] * v[3]);
                    }
                ss += __shfl_xor(ss, 16); ss += __shfl_xor(ss, 32);
                if (fq == 0) ssq1[(size_t)row * 16 + u.pn * 4 + wc] = ss;
            }
        }
    }
};
struct EpiUp {
    static constexpr bool PERM = true, AFTER_DRAIN = false;
    u16* hid; const float* ssq1;
    __device__ __forceinline__ void operator()(const f32x4 (&acc)[2][2][4][2], const Unit& u, int wr, int wc, int fr, int fq) const {
        const int col0 = u.pn * BM + wc * 32 + 8 * fq;
        f32x4 sv[2][4];
#pragma unroll
        for (int ai = 0; ai < 2; ++ai)
#pragma unroll
            for (int m = 0; m < 4; ++m) sv[ai][m] = *(const f32x4*)(ssq1 + (size_t)(u.pm * BM + ai * HALF + wr * 64 + m * 16 + fr) * 16 + 4 * fq);
#pragma unroll
        for (int ai = 0; ai < 2; ++ai)
#pragma unroll
            for (int m = 0; m < 4; ++m) {
                const int row = u.pm * BM + ai * HALF + wr * 64 + m * 16 + fr;
                float tot = (sv[ai][m][0] + sv[ai][m][1]) + (sv[ai][m][2] + sv[ai][m][3]);
                tot += __shfl_xor(tot, 16); tot += __shfl_xor(tot, 32);
                const float rs = __builtin_amdgcn_rsqf(tot * (1.0f / DM) + EPS);
                u16* rowp = hid + (size_t)row * FF + col0;
#pragma unroll
                for (int bj = 0; bj < 2; ++bj) {
                    f32x4 v0 = acc[ai][bj][m][0] * rs, v1 = acc[ai][bj][m][1] * rs;
#pragma unroll
                    for (int e = 0; e < 4; ++e) { const float a = fmaxf(v0[e], 0.f), b = fmaxf(v1[e], 0.f); v0[e] = a * a; v1[e] = b * b; }
                    u32x4 w; w.x = pkh(v0[0], v0[1]); w.y = pkh(v0[2], v0[3]); w.z = pkh(v1[0], v1[1]); w.w = pkh(v1[2], v1[3]);
                    *(u32x4*)(rowp + bj * HALF) = w;
                }
            }
    }
};
struct EpiDown {
    static constexpr bool PERM = false, AFTER_DRAIN = false;
    float* out; const u16* x1h;
    __device__ __forceinline__ void operator()(const f32x4 (&acc)[2][2][4][2], const Unit& u, int wr, int wc, int fr, int fq) const {
        const int col0 = u.pn * BM + wc * 32 + 4 * fq;
        u32x2 xr[2][4][2][2];
#pragma unroll
        for (int ai = 0; ai < 2; ++ai)
#pragma unroll
            for (int m = 0; m < 4; ++m) {
                const size_t off = (size_t)(u.pm * BM + ai * HALF + wr * 64 + m * 16 + fr) * DM + col0;
#pragma unroll
                for (int bj = 0; bj < 2; ++bj)
#pragma unroll
                    for (int n = 0; n < 2; ++n) xr[ai][m][bj][n] = *(const u32x2*)(x1h + off + bj * HALF + n * 16);
            }
#pragma unroll
        for (int ai = 0; ai < 2; ++ai)
#pragma unroll
            for (int m = 0; m < 4; ++m) {
                const size_t off = (size_t)(u.pm * BM + ai * HALF + wr * 64 + m * 16 + fr) * DM + col0;
#pragma unroll
                for (int bj = 0; bj < 2; ++bj)
#pragma unroll
                    for (int n = 0; n < 2; ++n) {
                        const h16x4 r = __builtin_bit_cast(h16x4, xr[ai][m][bj][n]);
                        f32x4 o = acc[ai][bj][m][n]; o[0] += (float)r[0]; o[1] += (float)r[1]; o[2] += (float)r[2]; o[3] += (float)r[3];
                        *(f32x4*)(out + off + bj * HALF + n * 16) = o;
                    }
            }
    }
};
struct EpiInProj {
    static constexpr bool PERM = true, AFTER_DRAIN = false;
    unsigned char* ws; const float* qg; const float* kg;
    __device__ __forceinline__ void operator()(const f32x4 (&acc)[2][2][4][2], const Unit& u, int wr, int wc, int fr, int fq) const {
        const int pn = u.pn;
        const bool normed = (pn < 2) || (pn < 5 && wc < 2);
        float gn[2][8];
        if (normed) {
            const float* gp = pn < 2 ? qg : kg;
#pragma unroll
            for (int bj = 0; bj < 2; ++bj) { const f32x4 a = *(const f32x4*)(gp + 32 * bj + 8 * fq), b = *(const f32x4*)(gp + 32 * bj + 8 * fq + 4);
#pragma unroll
                for (int e = 0; e < 4; ++e) { gn[bj][e] = a[e]; gn[bj][4 + e] = b[e]; } }
        }
        float lbv[2][8];
        if (pn == 7 || pn == 8) {
            const float* lp = (const float*)(ws + WS_LB) + 256 * (pn - 7) + 64 * wc + 8 * fq;
#pragma unroll
            for (int bj = 0; bj < 2; ++bj) { const f32x4 a = *(const f32x4*)(lp + 32 * bj), b = *(const f32x4*)(lp + 32 * bj + 4);
#pragma unroll
                for (int e = 0; e < 4; ++e) { lbv[bj][e] = a[e]; lbv[bj][4 + e] = b[e]; } }
        }
#pragma unroll
        for (int ai = 0; ai < 2; ++ai) {
            f32x4 rpv[4][4];
#pragma unroll
            for (int m = 0; m < 4; ++m) {
                if (normed && (m & 1) == 0) {
#pragma unroll
                    for (int mm = m; mm < m + 2; ++mm) { const int t_ = (u.pm * BM + ai * HALF + wr * 64 + mm * 16 + fr) & (SEQ - 1); const f32x4* rp_ = (const f32x4*)((const float*)(ws + WS_ROPE) + (size_t)t_ * 16);
#pragma unroll
                        for (int q4 = 0; q4 < 4; ++q4) rpv[mm][q4] = rp_[q4]; }
                }
                const int row = u.pm * BM + ai * HALF + wr * 64 + m * 16 + fr;
                const int b = row >> 13, t = row & (SEQ - 1);
                float v[2][8];
#pragma unroll
                for (int bj = 0; bj < 2; ++bj)
#pragma unroll
                    for (int e = 0; e < 4; ++e) { v[bj][e] = acc[ai][bj][m][0][e]; v[bj][4 + e] = acc[ai][bj][m][1][e]; }
                if (normed) {
                    float ss = 0.f;
#pragma unroll
                    for (int bj = 0; bj < 2; ++bj)
#pragma unroll
                        for (int e = 0; e < 8; ++e) ss += v[bj][e] * v[bj][e];
                    ss += __shfl_xor(ss, 16); ss += __shfl_xor(ss, 32);
                    const float rstd = 1.0f / sqrtf(ss * (1.0f / 64.f) + EPS);
#pragma unroll
                    for (int bj = 0; bj < 2; ++bj)
#pragma unroll
                        for (int e = 0; e < 8; ++e) v[bj][e] = v[bj][e] * rstd * gn[bj][e];
                    const f32x4 r0 = rpv[m][0], r1 = rpv[m][1], r2 = rpv[m][2], r3 = rpv[m][3];
                    const float cs[8] = {r0[0], r0[2], r1[0], r1[2], r2[0], r2[2], r3[0], r3[2]};
                    const float sn[8] = {r0[1], r0[3], r1[1], r1[3], r2[1], r2[3], r3[1], r3[3]};
#pragma unroll
                    for (int e = 0; e < 8; ++e) {
                        const float other = __shfl_xor(v[0][e], 16);
                        const float r1v = v[0][e] * cs[e] - other * sn[e];
                        const float r2v = v[0][e] * cs[e] + other * sn[e];
                        v[0][e] = fq == 0 ? r1v : (fq == 1 ? r2v : v[0][e]);
                    }
                    const float sc = pn < 2 ? 0.125f * 1.4426950408889634f : 1.0f;
                    u16* dst;
                    if (pn < 2) dst = (u16*)(ws + WS_Q) + (size_t)row * 512 + (4 * pn + wc) * 64 + 8 * fq;
                    else dst = (u16*)(ws + (pn == 2 ? WS_KC : pn == 3 ? WS_KS : WS_KW)) + ((size_t)(b * NG + wc) * SEQ + t) * 64 + 8 * fq;
#pragma unroll
                    for (int bj = 0; bj < 2; ++bj) {
                        u32x4 w; w.x = pkh(v[bj][0] * sc, v[bj][1] * sc); w.y = pkh(v[bj][2] * sc, v[bj][3] * sc); w.z = pkh(v[bj][4] * sc, v[bj][5] * sc); w.w = pkh(v[bj][6] * sc, v[bj][7] * sc);
                        *(u32x4*)(dst + 32 * bj) = w;
                    }
                } else if (pn < 5) {
                    const int g = wc - 2;
                    if (pn == 2) {
                        u16* dst = (u16*)(ws + WS_VC) + ((size_t)(b * NG + g) * SEQ + t) * 64 + 8 * fq;
#pragma unroll
                        for (int bj = 0; bj < 2; ++bj) {
                            u32x4 w; w.x = pkh(v[bj][0], v[bj][1]); w.y = pkh(v[bj][2], v[bj][3]); w.z = pkh(v[bj][4], v[bj][5]); w.w = pkh(v[bj][6], v[bj][7]);
                            *(u32x4*)(dst + 32 * bj) = w;
                        }
                    } else {
                        u16* dst = (u16*)(ws + (pn == 3 ? WS_VST : WS_VWT)) + (((size_t)(b * NG + g) * 128 + (t >> 6)) * 64 + 8 * fq) * 64 + (t & 63);
#pragma unroll
                        for (int bj = 0; bj < 2; ++bj)
#pragma unroll
                            for (int e = 0; e < 8; ++e) dst[(32 * bj + e) * 64] = f2h(v[bj][e]);
                    }
                } else if (pn < 13) {
                    const int kind = (pn - 5) >> 1;
                    const int col = 256 * ((pn - 5) & 1) + 64 * wc + 8 * fq;
                    u16* dst = (u16*)(ws + (kind == 0 ? WS_HQ : kind == 1 ? WS_HLOGF : kind == 2 ? WS_HV : WS_HG)) + (size_t)row * 512 + col;
#pragma unroll
                    for (int bj = 0; bj < 2; ++bj) {
                        float o[8];
#pragma unroll
                        for (int e = 0; e < 8; ++e) {
                            const float x = v[bj][e];
                            if (kind == 0 || kind == 3) o[e] = x * sigmoid_f(x);
                            else if (kind == 1) { const float l = lbv[bj][e]; o[e] = __logf(l + (1.f - l) * sigmoid_f(x)); }
                            else o[e] = x;
                        }
                        u32x4 w;
                        if (kind == 0 || kind == 2) { w.x = pkb(o[0], o[1]); w.y = pkb(o[2], o[3]); w.z = pkb(o[4], o[5]); w.w = pkb(o[6], o[7]); }
                        else { w.x = pkh(o[0], o[1]); w.y = pkh(o[2], o[3]); w.z = pkh(o[4], o[5]); w.w = pkh(o[6], o[7]); }
                        *(u32x4*)(dst + 32 * bj) = w;
                    }
                } else {
                    if (wc == 0 && fq < 3) {
                        float* dst = (float*)(ws + WS_GATES) + (size_t)row * 24 + 8 * fq;
                        f32x4 a, c;
#pragma unroll
                        for (int e = 0; e < 4; ++e) { a[e] = sigmoid_f(v[0][e]); c[e] = sigmoid_f(v[0][4 + e]); }
                        *(f32x4*)dst = a; *(f32x4*)(dst + 4) = c;
                    }
                }
            }
        }
    }
};
template <class Epi, class Sched, bool ALIGN_EPI = false, bool SP2 = false>
__device__ __forceinline__ void gemm_phase(PG8_LAS unsigned char* lds, const Gemm g, const Sched& S, const Epi& E, int wave_in) {
    const int tid = threadIdx.x, wid = __builtin_amdgcn_readfirstlane(tid >> 6), lane = tid & 63, wr = wid >> 2, wc = wid & 3, fr = lane & 15, fq = lane >> 4;
    const int K = g.K, nt = K / BK;
    unsigned voffA[2], voffB[2];
#pragma unroll
    for (int i = 0; i < 2; ++i) { int R, C; stage_rc(tid * 16 + i * 8192, R, C); const int Rb = Epi::PERM ? ((R & ~31) + perm32(R & 31)) : R;
        voffA[i] = (unsigned)(R * K + C) * 2u; voffB[i] = (unsigned)(Rb * K + C) * 2u; }
    const size_t kstep = (size_t)(BK * 2);
    const size_t hstep = (size_t)HALF * K * 2;
    const size_t tstep = 2 * hstep;
    const unsigned ldsw = (unsigned)wid * 1024u;
    const int aoff = lds_byte(wr * 64 + fr, fq * 8), boff = lds_byte(wc * 32 + fr, fq * 8);
#define PG8_SA(b, h) (((b) * 2 + (h)) * HTB)
#define PG8_SB(b, h) ((4 + (b) * 2 + (h)) * HTB)
#define PG8_STAGE(bufoff, gbase, voff) do { _Pragma("unroll") for (int _i = 0; _i < 2; ++_i) \
        __builtin_amdgcn_global_load_lds((const unsigned*)((const char*)(gbase) + (voff)[_i]), (PG8_LAS unsigned*)(lds + (bufoff) + ldsw + _i * 8192), 16, 0, 0); } while (0)
#define PG8_LDA(dst, b, h) do { _Pragma("unroll") for (int m = 0; m < 4; ++m) _Pragma("unroll") for (int k = 0; k < 2; ++k) dst[m][k] = *(const PG8_LAS bf16x8*)(lds + PG8_SA(b, h) + aoff + m * 2048 + k * 1024); } while (0)
#define PG8_LDB(dst, b, h) do { _Pragma("unroll") for (int n = 0; n < 2; ++n) _Pragma("unroll") for (int k = 0; k < 2; ++k) dst[n][k] = *(const PG8_LAS bf16x8*)(lds + PG8_SB(b, h) + boff + n * 2048 + k * 1024); } while (0)
#define PG8_MMA(ai, bj, At, Bt) do { __builtin_amdgcn_s_setprio(1); _Pragma("unroll") for (int m = 0; m < 4; ++m) _Pragma("unroll") for (int n = 0; n < 2; ++n) _Pragma("unroll") for (int k = 0; k < 2; ++k) \
        acc[ai][bj][m][n] = PG8_MFMA(Bt[n][k], At[m][k], acc[ai][bj][m][n]); __builtin_amdgcn_s_setprio(0); } while (0)
#define PG8_WAIT_V(n) asm volatile("s_waitcnt vmcnt(" #n ")" ::: "memory")
#define PG8_WAIT_L(n) asm volatile("s_waitcnt lgkmcnt(" #n ")" ::: "memory")
#define PG8_BAR __builtin_amdgcn_s_barrier()
#define PG8_SCHED __builtin_amdgcn_sched_barrier(0)
    Unit cur, nxt; int ui = 0;
    if (!S.next(0, cur)) return;
    f32x4 acc[2][2][4][2];
#pragma unroll
    for (int a = 0; a < 2; ++a)
#pragma unroll
        for (int b = 0; b < 2; ++b)
#pragma unroll
            for (int m = 0; m < 4; ++m)
#pragma unroll
                for (int n = 0; n < 2; ++n) acc[a][b][m][n] = (f32x4){0.f, 0.f, 0.f, 0.f};
    bf16x8 At[4][2], B0[2][2], B1[2][2];
    const char* cA = (const char*)g.A + (size_t)cur.pm * tstep; const char* cB = (const char*)g.Bt + (size_t)cur.pn * tstep;
    S.a_ready(cur);
    if constexpr (SP2) {
        PG8_STAGE(PG8_SB(0, 0), cB, voffB); PG8_STAGE(PG8_SB(0, 1), cB + hstep, voffB); PG8_STAGE(PG8_SA(0, 0), cA, voffA); PG8_STAGE(PG8_SA(0, 1), cA + hstep, voffA);
        if (wr == 1) PG8_BAR;
        PG8_WAIT_V(2); PG8_BAR;
        PG8_STAGE(PG8_SB(1, 0), cB + kstep, voffB); PG8_STAGE(PG8_SA(1, 0), cA + kstep, voffA); PG8_STAGE(PG8_SB(1, 1), cB + hstep + kstep, voffB);
        PG8_WAIT_V(6); PG8_BAR;
    } else {
        PG8_STAGE(PG8_SB(0, 0), cB, voffB); PG8_STAGE(PG8_SA(0, 0), cA, voffA); PG8_STAGE(PG8_SB(0, 1), cB + hstep, voffB); PG8_STAGE(PG8_SA(0, 1), cA + hstep, voffA);
        if (wr == 1) PG8_BAR;
        PG8_WAIT_V(4); PG8_BAR;
        PG8_STAGE(PG8_SB(1, 0), cB + kstep, voffB); PG8_STAGE(PG8_SA(1, 0), cA + kstep, voffA); PG8_STAGE(PG8_SB(1, 1), cB + hstep + kstep, voffB);
        PG8_WAIT_V(6); PG8_BAR;
    }
    for (;;) {
        const bool has_next = S.next(ui + 1, nxt);
        const char* nA = has_next ? (const char*)g.A + (size_t)nxt.pm * tstep : cA; const char* nB = has_next ? (const char*)g.Bt + (size_t)nxt.pn * tstep : cB;
        for (int t = 0; t < nt; t += 2) {
            const bool last = (t == nt - 2);
            const char* a1 = cA + (size_t)(t + 1) * kstep;
            const char* a2 = last ? nA : cA + (size_t)(t + 2) * kstep; const char* b2 = last ? nB : cB + (size_t)(t + 2) * kstep;
            const char* a3 = a2 + kstep; const char* b3 = b2 + kstep;
            if (last && has_next) S.a_ready(nxt);
            if constexpr (SP2) {
            PG8_LDB(B0, 0, 0); PG8_LDB(B1, 0, 1); PG8_SCHED; PG8_LDA(At, 0, 0); PG8_STAGE(PG8_SA(1, 1), a1 + hstep, voffA);
            PG8_WAIT_V(8); PG8_WAIT_L(0); PG8_BAR; PG8_MMA(0, 0, At, B0); PG8_MMA(0, 1, At, B1); PG8_BAR; PG8_SCHED;
            PG8_LDA(At, 0, 1); PG8_STAGE(PG8_SB(0, 0), b2, voffB); PG8_STAGE(PG8_SB(0, 1), b2 + hstep, voffB); PG8_STAGE(PG8_SA(0, 0), a2, voffA);
            PG8_WAIT_V(8); PG8_WAIT_L(0); PG8_BAR; PG8_MMA(1, 0, At, B0); PG8_MMA(1, 1, At, B1); PG8_BAR; PG8_SCHED;
            PG8_LDB(B0, 1, 0); PG8_LDB(B1, 1, 1); PG8_SCHED; PG8_LDA(At, 1, 0); PG8_STAGE(PG8_SA(0, 1), a2 + hstep, voffA);
            PG8_WAIT_V(8); PG8_WAIT_L(0); PG8_BAR; PG8_MMA(0, 0, At, B0); PG8_MMA(0, 1, At, B1); PG8_BAR; PG8_SCHED;
            PG8_LDA(At, 1, 1); PG8_STAGE(PG8_SB(1, 0), b3, voffB); PG8_STAGE(PG8_SB(1, 1), b3 + hstep, voffB); PG8_STAGE(PG8_SA(1, 0), a3, voffA);
            PG8_WAIT_V(8); PG8_WAIT_L(0); PG8_BAR; PG8_MMA(1, 0, At, B0); PG8_MMA(1, 1, At, B1); PG8_BAR; PG8_SCHED;
            } else {
            PG8_LDB(B0, 0, 0); PG8_SCHED; PG8_LDA(At, 0, 0); PG8_STAGE(PG8_SA(1, 1), a1 + hstep, voffA);
            PG8_WAIT_L(8); PG8_BAR; PG8_WAIT_L(0); PG8_MMA(0, 0, At, B0); PG8_BAR; PG8_SCHED;
            PG8_LDB(B1, 0, 1); PG8_STAGE(PG8_SB(0, 0), b2, voffB);
            PG8_BAR; PG8_WAIT_L(0); PG8_MMA(0, 1, At, B1); PG8_BAR;
            PG8_LDA(At, 0, 1); PG8_STAGE(PG8_SA(0, 0), a2, voffA);
            PG8_BAR; PG8_WAIT_L(0); PG8_MMA(1, 0, At, B0); PG8_BAR; PG8_SCHED;
            PG8_STAGE(PG8_SB(0, 1), b2 + hstep, voffB);
            PG8_WAIT_V(6); PG8_BAR; PG8_MMA(1, 1, At, B1); PG8_BAR;
            PG8_LDB(B0, 1, 0); PG8_SCHED; PG8_LDA(At, 1, 0); PG8_STAGE(PG8_SA(0, 1), a2 + hstep, voffA);
            PG8_WAIT_L(8); PG8_BAR; PG8_WAIT_L(0); PG8_MMA(0, 0, At, B0); PG8_BAR; PG8_SCHED;
            PG8_LDB(B1, 1, 1); PG8_STAGE(PG8_SB(1, 0), b3, voffB);
            PG8_BAR; PG8_WAIT_L(0); PG8_MMA(0, 1, At, B1); PG8_BAR;
            PG8_LDA(At, 1, 1); PG8_STAGE(PG8_SA(1, 0), a3, voffA);
            PG8_BAR; PG8_WAIT_L(0); PG8_MMA(1, 0, At, B0); PG8_BAR; PG8_SCHED;
            PG8_STAGE(PG8_SB(1, 1), b3 + hstep, voffB);
            PG8_WAIT_V(6); PG8_BAR; PG8_MMA(1, 1, At, B1); PG8_BAR;
            }
        }
        if constexpr (ALIGN_EPI) { if (wr == 0) PG8_BAR; }
        if constexpr (!Epi::AFTER_DRAIN) { E(acc, cur, wr, wc, fr, fq); S.done(cur); }
        if (!has_next) break;
#pragma unroll
        for (int a = 0; a < 2; ++a)
#pragma unroll
            for (int b = 0; b < 2; ++b)
#pragma unroll
                for (int m = 0; m < 4; ++m)
#pragma unroll
                    for (int n = 0; n < 2; ++n) acc[a][b][m][n] = (f32x4){0.f, 0.f, 0.f, 0.f};
        cur = nxt; cA = nA; cB = nB; ++ui;
        if constexpr (ALIGN_EPI) { if (wr == 1) PG8_BAR; }
    }
    PG8_WAIT_V(0);
    if constexpr (!ALIGN_EPI) { if (wr == 0) PG8_BAR; }
    PG8_BAR;
    if constexpr (Epi::AFTER_DRAIN) { E.fused(acc, cur, wr, wc, fr, fq, lds, wid, lane); S.done(cur); }
#undef PG8_SA
#undef PG8_SB
#undef PG8_STAGE
#undef PG8_LDA
#undef PG8_LDB
#undef PG8_MMA
#undef PG8_WAIT_V
#undef PG8_WAIT_L
#undef PG8_BAR
#undef PG8_SCHED
}
}
#define LDS_WAIT() asm volatile("s_waitcnt lgkmcnt(0)" ::: "memory")
#define VM_WAIT() asm volatile("s_waitcnt vmcnt(0)" ::: "memory")

struct Params {
    const float* in[18];
    float* out;
    unsigned char* ws;
    float invf[8];
    int ph_lo, ph_hi;
};

__device__ __forceinline__ void sincos_acc(float ang, float& s, float& c) {
    const double x = (double)ang;
    const double k = rint(x * 0.6366197723675814);
    double r = fma(-k, 1.5707963267948966, x); r = fma(-k, 6.123233995736766e-17, r);
    const int q = ((int)k) & 3;
    const double r2 = r * r;
    const double sp = r * (1.0 + r2 * (-1.0 / 6 + r2 * (1.0 / 120 + r2 * (-1.0 / 5040 + r2 * (1.0 / 362880 + r2 * (-1.0 / 39916800 + r2 * (1.0 / 6227020800.0)))))));
    const double cp = 1.0 + r2 * (-0.5 + r2 * (1.0 / 24 + r2 * (-1.0 / 720 + r2 * (1.0 / 40320 + r2 * (-1.0 / 3628800 + r2 * (1.0 / 479001600.0 + r2 * (-1.0 / 87178291200.0)))))));
    double ss, cc;
    if (q == 0) { ss = sp; cc = cp; } else if (q == 1) { ss = cp; cc = -sp; } else if (q == 2) { ss = -sp; cc = -cp; } else { ss = -cp; cc = sp; }
    s = (float)ss; c = (float)cc;
}

struct ColId { __device__ __forceinline__ int operator()(int n) const { return n; } };
struct ColWin {
    __device__ __forceinline__ int operator()(int P) const {
        const int pn = P >> 8, p = P & 255, bj = p >> 7, wc = (p >> 5) & 3, j = p & 31;
        const int Lp = 256 * pn + 64 * wc + 32 * bj + j;
        return Lp < 1280 ? Lp : (Lp < 3328 ? Lp + 24 : (Lp < 3352 ? Lp - 3328 + 1280 : -1));
    }
};
template <class SrcCol>
__device__ __forceinline__ void p0_transpose_item(const float* __restrict__ W, int K, int Nsrc, u16* WT, const float* rowscale, SrcCol sc, LAS float* scr, int kb, int nb, int lane) {
    const int k0 = 64 * kb, n0 = 32 * nb;
    const int scol = sc(n0 + (lane & 31));
#pragma unroll
    for (int i = 0; i < 32; ++i) {
        const int kk = 2 * i + (lane >> 5);
        float v = scol >= 0 ? W[(size_t)(k0 + kk) * Nsrc + scol] : 0.f;
        if (rowscale) v *= rowscale[k0 + kk];
        scr[kk * 33 + (lane & 31)] = v;
    }
    LDS_WAIT(); asm volatile("" ::: "memory");
    const int c = lane & 7;
#pragma unroll
    for (int j = 0; j < 4; ++j) {
        const int n = (lane >> 3) + 8 * j; const LAS float* s = scr + (8 * c) * 33 + n;
        u32x4 o; o.x = pkh(s[0 * 33], s[1 * 33]); o.y = pkh(s[2 * 33], s[3 * 33]); o.z = pkh(s[4 * 33], s[5 * 33]); o.w = pkh(s[6 * 33], s[7 * 33]);
        *(u32x4*)(WT + (size_t)(n0 + n) * K + k0 + 8 * c) = o;
    }
    LDS_WAIT(); asm volatile("" ::: "memory");
}

__device__ __forceinline__ void p0_late_transposes(const Params& p, LAS unsigned char* lds, int gw, int NGW, int wave, int lane) {
    unsigned char* ws = p.ws;
    LAS float* scr = (LAS float*)(lds + wave * 16384);
    constexpr int I_WOUT = 16 * 32, I_W1 = 16 * (FF / 32), I_W2 = (FF / 64) * 32, I_C1 = 32 * 4, I_C2 = 2 * 2;
    constexpr int NITEMS = I_WOUT + I_W1 + I_W2 + 2 * I_C1 + 2 * I_C2;
    for (int it = gw; it < NITEMS; it += NGW) {
        int r = it;
        if (r < I_C1) { p0_transpose_item(p.in[6], 2048, 128, (u16*)(ws + WS_CW1K_T), nullptr, ColId(), scr, r / 4, r % 4, lane); continue; } r -= I_C1;
        if (r < I_C1) { p0_transpose_item(p.in[9], 2048, 128, (u16*)(ws + WS_CW1V_T), nullptr, ColId(), scr, r / 4, r % 4, lane); continue; } r -= I_C1;
        if (r < I_C2) { p0_transpose_item(p.in[7], 128, 64, (u16*)(ws + WS_CW2K_T), nullptr, ColId(), scr, r / 2, r % 2, lane); continue; } r -= I_C2;
        if (r < I_C2) { p0_transpose_item(p.in[10], 128, 64, (u16*)(ws + WS_CW2V_T), nullptr, ColId(), scr, r / 2, r % 2, lane); continue; } r -= I_C2;
        if (r < I_WOUT) { p0_transpose_item(p.in[14], DM, DM, (u16*)(ws + WS_WOUT_T), nullptr, ColId(), scr, r / 32, r % 32, lane); continue; } r -= I_WOUT;
        if (r < I_W1) { p0_transpose_item(p.in[16], DM, FF, (u16*)(ws + WS_W1_T), p.in[15], ColId(), scr, r / (FF / 32), r % (FF / 32), lane); continue; } r -= I_W1;
        p0_transpose_item(p.in[17], FF, DM, (u16*)(ws + WS_W2_T), nullptr, ColId(), scr, r / 32, r % 32, lane);
    }
}
__device__ __forceinline__ void p0_prologue(const Params& p, LAS unsigned char* lds, int gw, int NGW, int wave, int lane) {
    unsigned char* ws = p.ws;
    LAS float* scr = (LAS float*)(lds + wave * 16384);
    constexpr int I_WIN = 16 * (DINP / 32);
    for (int it = gw; it < I_WIN; it += NGW) p0_transpose_item(p.in[2], DM, DIN, (u16*)(ws + WS_WIN_T), nullptr, ColWin(), scr, it / (DINP / 32), it % (DINP / 32), lane);
    {
        const float* gn = p.in[1];
        f32x4 gv[4];
#pragma unroll
        for (int j = 0; j < 4; ++j) gv[j] = ((const f32x4*)gn)[lane + 64 * j];
        for (int m = gw; m < MT; m += 4 * NGW) {
            f32x4 v[4][4]; float s[4];
#pragma unroll
            for (int r = 0; r < 4; ++r) {
                const int mr = m + r * NGW; const f32x4* xr = (const f32x4*)(p.in[0] + (size_t)(mr < MT ? mr : m) * DM) + lane;
#pragma unroll
                for (int j = 0; j < 4; ++j) v[r][j] = __builtin_nontemporal_load(xr + 64 * j);
            }
#pragma unroll
            for (int r = 0; r < 4; ++r) {
                float a = 0.f;
#pragma unroll
                for (int j = 0; j < 4; ++j) a += (v[r][j][0] * v[r][j][0] + v[r][j][1] * v[r][j][1]) + (v[r][j][2] * v[r][j][2] + v[r][j][3] * v[r][j][3]);
                s[r] = a;
            }
#pragma unroll
            for (int o = 1; o < 64; o <<= 1) {
#pragma unroll
                for (int r = 0; r < 4; ++r) s[r] += __shfl_xor(s[r], o);
            }
#pragma unroll
            for (int r = 0; r < 4; ++r) {
                const int mr = m + r * NGW;
                if (mr < MT) {
                    const float rstd = 1.0f / sqrtf(s[r] * (1.f / DM) + EPS);
                    u32x2* o8 = (u32x2*)((u16*)(ws + WS_XH) + (size_t)mr * DM) + lane;
#pragma unroll
                    for (int j = 0; j < 4; ++j) { u32x2 ww; ww.x = pkh(v[r][j][0] * rstd * gv[j][0], v[r][j][1] * rstd * gv[j][1]); ww.y = pkh(v[r][j][2] * rstd * gv[j][2], v[r][j][3] * rstd * gv[j][3]); o8[64 * j] = ww; }
                }
            }
        }
    }
    const int gt = gw * 64 + lane, NGT = NGW * 64;
    for (int i = gt; i < SEQ * 8; i += NGT) {
        const int pos = i >> 3, f = i & 7; float s, c; sincos_acc((float)pos * p.invf[f], s, c);
        ((f32x2*)(ws + WS_ROPE))[i] = (f32x2){c, s};
    }
    for (int i = gt; i < 512; i += NGT) {
        const float a = p.in[12][i], c = p.in[12][512 + i]; const float m = fmaxf(a, c); const float ea = expf(a - m), ec = expf(c - m);
        ((float*)(ws + WS_LB))[i] = ea / (ea + ec);
    }
    for (int i = gt; i < 2048; i += NGT) { ((u16*)(ws + WS_PEK))[i] = f2h(p.in[5][i]); ((u16*)(ws + WS_PEV))[i] = f2h(p.in[8][i]); }
}

#define XB_TMO      128
#define XB_XCNT(j)  (256  + 64 * (j))
#define XB_XSUB(j)  (1280 + 64 * (j))
#define XB_XGEN(j)  (2304 + 64 * (j))
#define XB_TOP      3328
#define XB_TOPGEN   3392
#define XCD_BAR_WORDS 3456
#define XB_SPIN_CAP (1u << 18)

__device__ __forceinline__ unsigned xb_ld(unsigned* p)              { return __hip_atomic_load(p, __ATOMIC_RELAXED, __HIP_MEMORY_SCOPE_AGENT); }
__device__ __forceinline__ unsigned xb_add(unsigned* p, unsigned v) { return __hip_atomic_fetch_add(p, v, __ATOMIC_RELAXED, __HIP_MEMORY_SCOPE_AGENT); }
__device__ __forceinline__ unsigned xb_xcc_id() { return (unsigned)__builtin_amdgcn_s_getreg((3 << 11) | 20) & 0xFu; }
#define XB_SPIN(cond, bar) do { unsigned _sp = 0; while (cond) { __builtin_amdgcn_s_sleep(1); \
    if ((++_sp & 255u) == 0u) { if (xb_ld(&(bar)[XB_TMO])) break; if (_sp > XB_SPIN_CAP) { atomicAdd(&(bar)[XB_TMO], 1u); break; } } } } while (0)

struct XcdBarrier {
    unsigned* bar; unsigned x;
    volatile LAS unsigned* st;
};

__device__ __forceinline__ XcdBarrier xcd_barrier_post(unsigned* bar, volatile LAS unsigned* st) {
    XcdBarrier b; b.bar = bar; b.x = xb_xcc_id(); b.st = st;
    if (threadIdx.x == 0) (void)xb_add(&bar[XB_XCNT(b.x)], 1u);
    return b;
}
__device__ __forceinline__ void xcd_barrier_complete(unsigned* bar, unsigned x, unsigned& nloc, unsigned& nx) {
    const unsigned G = gridDim.x * gridDim.y * gridDim.z;
    unsigned sum, cnt, mine, sp = 0u;
    for (;;) {
        sum = 0u; cnt = 0u; mine = 0u;
#pragma unroll
        for (unsigned j = 0; j < 16; ++j) { const unsigned c = xb_ld(&bar[XB_XCNT(j)]); sum += c; cnt += (c > 0u) ? 1u : 0u; mine = (j == x) ? c : mine; }
        if (sum == G) break;
        __builtin_amdgcn_s_sleep(1);
        if ((++sp & 255u) == 0u) { if (xb_ld(&bar[XB_TMO])) break; if (sp > XB_SPIN_CAP) { atomicAdd(&bar[XB_TMO], 1u); break; } }
    }
    nloc = mine > 0u ? mine : 1u; nx = cnt > 0u ? cnt : 1u;
}

__device__ __forceinline__ void xcd_barrier(const XcdBarrier& b) {
    asm volatile("s_waitcnt vmcnt(0)" ::: "memory");
    __syncthreads();
    if (threadIdx.x == 0) {
        unsigned* bar = b.bar;
        __builtin_amdgcn_s_waitcnt(0);
        unsigned nloc = b.st[0], nx = b.st[1];
        if (nloc == 0u) { xcd_barrier_complete(bar, b.x, nloc, nx); b.st[0] = nloc; b.st[1] = nx; }
        const unsigned old = xb_add(&bar[XB_XSUB(b.x)], 1u);
        const unsigned gen = old / nloc;
        if (old + 1u == (gen + 1u) * nloc) {
            __builtin_amdgcn_fence(__ATOMIC_RELEASE, "agent");
            asm volatile("s_waitcnt vmcnt(0)" ::: "memory");
            const unsigned og = xb_add(&bar[XB_TOP], 1u);
            const unsigned tg = og / nx;
            if (og + 1u == (tg + 1u) * nx) xb_add(&bar[XB_TOPGEN], 1u);
            else XB_SPIN(xb_ld(&bar[XB_TOPGEN]) == tg, bar);
            __builtin_amdgcn_fence(__ATOMIC_ACQUIRE, "agent");
            xb_add(&bar[XB_XGEN(b.x)], 1u);
            asm volatile("s_waitcnt vmcnt(0)" ::: "memory");
        } else {
            XB_SPIN(xb_ld(&bar[XB_XGEN(b.x)]) == gen, bar);
            __builtin_amdgcn_fence(__ATOMIC_ACQUIRE, "agent");
            asm volatile("s_waitcnt vmcnt(0)" ::: "memory");
        }
    }
    __syncthreads();
}

constexpr float LOG2E = 1.4426950408889634f;
constexpr float OFF2 = 4.0f * LOG2E;
constexpr int AT_PITCH = 144;
constexpr int AT_TILE = 64 * AT_PITCH;
constexpr int AT_LDS = 4 * AT_TILE;
#define MFMA32H(a, b, c) __builtin_amdgcn_mfma_f32_32x32x16_f16((a), (b), (c), 0, 0, 0)
#define MFMA16H(a, b, c) __builtin_amdgcn_mfma_f32_16x16x32_f16((a), (b), (c), 0, 0, 0)
#define MFMA32B(a, b, c) __builtin_amdgcn_mfma_f32_32x32x16_bf16((a), (b), (c), 0, 0, 0)

#define AT_BAR() do { asm volatile("s_waitcnt lgkmcnt(0)" ::: "memory"); __builtin_amdgcn_s_barrier(); asm volatile("" ::: "memory"); } while (0)
template <int MODE>
__device__ __forceinline__ void attn_tiles(LAS unsigned char* lds, const u16* __restrict__ Kbg, const u16* __restrict__ VTbg, const h16x8 (&qf)[4], int qt, int j0, int qh, int wave, int lane,
                                           unsigned sw0, unsigned sw1, unsigned sw2, unsigned sw3, f32x16 (&o)[2], float& lsum) {
    const int tid = threadIdx.x, r32 = lane & 31, hi = lane >> 5;
    const int srow = tid >> 3, sch = tid & 7;
    const u16* ksrc = Kbg + (size_t)srow * 64 + 8 * sch;
    const u16* vsrc = VTbg + (size_t)srow * 64 + 8 * sch;
    const int sdst = srow * AT_PITCH + sch * 16;
    const int prow = (r32 & 0x13) | ((r32 & 8) >> 1) | ((r32 & 4) << 1);
    const int koff = prow * AT_PITCH + hi * 16;
    const int voff = r32 * AT_PITCH + hi * 16;
    const int qrel = 32 * qh + r32;
    u32x4 kA = *(const u32x4*)(ksrc + (size_t)j0 * 4096), vA = *(const u32x4*)(vsrc + (size_t)j0 * 4096);
    u32x4 kB = kA, vB = vA;
    if (j0 + 1 <= qt) { kB = *(const u32x4*)(ksrc + (size_t)(j0 + 1) * 4096); vB = *(const u32x4*)(vsrc + (size_t)(j0 + 1) * 4096); }
    *(LAS u32x4*)(lds + sdst) = kA; *(LAS u32x4*)(lds + 2 * AT_TILE + sdst) = vA;
    h16x8 qg0 = qf[0], qg1 = qf[1], qg2 = qf[2], qg3 = qf[3];
    asm volatile("" : "+v"(qg0), "+v"(qg1), "+v"(qg2), "+v"(qg3));
    const u32x4 onesw = {0x3c003c00u, 0x3c003c00u, 0x3c003c00u, 0x3c003c00u};
    f32x16 negoff;
#pragma unroll
    for (int i = 0; i < 16; ++i) negoff[i] = -OFF2;
    asm volatile("" : "+v"(negoff));
    f32x16 ol;
#pragma unroll
    for (int i = 0; i < 16; ++i) ol[i] = 0.f;
    AT_BAR();
    for (int j = j0; j <= qt; ++j) {
        const int buf = (j - j0) & 1;
        if (j + 2 <= qt) { kA = *(const u32x4*)(ksrc + (size_t)(j + 2) * 4096); vA = *(const u32x4*)(vsrc + (size_t)(j + 2) * 4096); }
        LAS unsigned char* kb = lds + buf * AT_TILE; LAS unsigned char* vb = lds + (2 + buf) * AT_TILE;
        bool sel = true;
        if (MODE == 1) { const unsigned w = j < 32 ? sw0 : (j < 64 ? sw1 : (j < 96 ? sw2 : sw3)); sel = (w >> (j & 31)) & 1u; }
        if (MODE == 0 || __any(sel)) {
            h16x8 kf[8];
#pragma unroll
            for (int kh = 0; kh < 2; ++kh)
#pragma unroll
                for (int d0 = 0; d0 < 4; ++d0) kf[kh * 4 + d0] = *(const LAS h16x8*)(kb + kh * 32 * AT_PITCH + koff + d0 * 32);
            __builtin_amdgcn_sched_barrier(0);
            f32x16 s[2];
#pragma unroll
            for (int kh = 0; kh < 2; ++kh) {
#pragma unroll
                for (int d0 = 0; d0 < 4; ++d0) s[kh] = MFMA32H(kf[kh * 4 + d0], (d0 == 0 ? qg0 : d0 == 1 ? qg1 : d0 == 2 ? qg2 : qg3), (d0 == 0 ? negoff : s[kh]));
            }
            h16x8 vfr[8];
#pragma unroll
            for (int dt = 0; dt < 2; ++dt)
#pragma unroll
                for (int kk = 0; kk < 4; ++kk) vfr[dt * 4 + kk] = *(const LAS h16x8*)(vb + dt * 32 * AT_PITCH + voff + kk * 32);
            __builtin_amdgcn_sched_barrier(0);
            const int dj = qt - j;
            const bool edge_hi = (dj == 0), edge_lo = (MODE == 0) && (dj == 8);
            u32x4 pw[2][2];
            if (edge_hi || edge_lo) {
#pragma unroll
                for (int kh = 0; kh < 2; ++kh)
#pragma unroll
                    for (int sp = 0; sp < 2; ++sp) {
                        float pv[8];
#pragma unroll
                        for (int e = 0; e < 8; ++e) {
                            const int kin = 32 * kh + 16 * sp + 8 * hi + e;
                            float pe = __builtin_amdgcn_exp2f(s[kh][8 * sp + e]);
                            if (edge_hi) pe = (kin <= qrel) ? pe : 0.f;
                            if (edge_lo) pe = (kin > qrel) ? pe : 0.f;
                            pv[e] = pe;
                        }
                        pw[kh][sp] = (u32x4){pkh(pv[0], pv[1]), pkh(pv[2], pv[3]), pkh(pv[4], pv[5]), pkh(pv[6], pv[7])};
                    }
            } else {
#pragma unroll
                for (int kh = 0; kh < 2; ++kh)
#pragma unroll
                    for (int sp = 0; sp < 2; ++sp) {
                        float pv[8];
#pragma unroll
                        for (int e = 0; e < 8; ++e) pv[e] = __builtin_amdgcn_exp2f(s[kh][8 * sp + e]);
                        pw[kh][sp] = (u32x4){pkh(pv[0], pv[1]), pkh(pv[2], pv[3]), pkh(pv[4], pv[5]), pkh(pv[6], pv[7])};
                    }
            }
            if (MODE == 1) {
                const unsigned mk = sel ? 0xffffffffu : 0u;
#pragma unroll
                for (int kh = 0; kh < 2; ++kh)
#pragma unroll
                    for (int sp = 0; sp < 2; ++sp) { pw[kh][sp].x &= mk; pw[kh][sp].y &= mk; pw[kh][sp].z &= mk; pw[kh][sp].w &= mk; }
            }
#pragma unroll
            for (int kh = 0; kh < 2; ++kh)
#pragma unroll
                for (int sp = 0; sp < 2; ++sp) {
                    const h16x8 pb = __builtin_bit_cast(h16x8, pw[kh][sp]);
#pragma unroll
                    for (int dt = 0; dt < 2; ++dt) o[dt] = MFMA32H(vfr[dt * 4 + 2 * kh + sp], pb, o[dt]);
                    ol = MFMA32H(__builtin_bit_cast(h16x8, onesw), pb, ol);
                }
        }
        if (j < qt) { *(LAS u32x4*)(lds + (buf ^ 1) * AT_TILE + sdst) = kB; *(LAS u32x4*)(lds + (2 + (buf ^ 1)) * AT_TILE + sdst) = vB; }
        kB = kA; vB = vA;
        AT_BAR();
    }
    lsum = 0.5f * ol[0];
}

__device__ __forceinline__ void win_unit(unsigned char* ws, LAS unsigned char* lds, int u, int wave, int lane) {
    const int qt = u & 127, bg = u >> 7, b = bg >> 1, g = bg & 1;
    const int h = wave >> 1, qh = wave & 1, r32 = lane & 31, hi = lane >> 5;
    const int t = 64 * qt + 32 * qh + r32;
    const size_t row = (size_t)b * SEQ + t;
    const u16* qp = (const u16*)(ws + WS_Q) + row * 512 + (4 * g + h) * 64 + 8 * hi;
    h16x8 qf[4];
#pragma unroll
    for (int d0 = 0; d0 < 4; ++d0) qf[d0] = *(const h16x8*)(qp + 16 * d0);
    f32x16 o[2]; float l = 0.f;
#pragma unroll
    for (int i = 0; i < 16; ++i) { o[0][i] = 0.f; o[1][i] = 0.f; }
    const int j0 = qt > 8 ? qt - 8 : 0;
    attn_tiles<0>(lds, (const u16*)(ws + WS_KW) + (size_t)bg * SEQ * 64, (const u16*)(ws + WS_VWT) + (size_t)bg * 64 * SEQ, qf, qt, j0, qh, wave, lane, 0u, 0u, 0u, 0u, o, l);
    l += __shfl_xor(l, 32);
    const float sc = ((const float*)(ws + WS_GATES))[row * 24 + (4 * g + h) * 3 + 2] / l;
    u16* dst = (u16*)(ws + WS_OWIN) + row * 512 + (4 * g + h) * 64 + 4 * hi;
#pragma unroll
    for (int dt = 0; dt < 2; ++dt)
#pragma unroll
        for (int r4 = 0; r4 < 4; ++r4) {
            u32x2 w; w.x = pkh(o[dt][4 * r4] * sc, o[dt][4 * r4 + 1] * sc); w.y = pkh(o[dt][4 * r4 + 2] * sc, o[dt][4 * r4 + 3] * sc);
            *(u32x2*)(dst + 32 * dt + 8 * r4) = w;
        }
}

constexpr int CM_SP = 132, CM_HP = 136;
__device__ __forceinline__ void cmp_mlp_unit(unsigned char* ws, LAS unsigned char* lds, int u, int wave, int lane) {
    const int mt = u & 31, bg = (u >> 5) & 3, kv = u >> 7;
    const int tid = threadIdx.x, r = lane & 15, quad = lane >> 4;
    LAS float* slab = (LAS float*)lds;
    LAS u16* hb = (LAS u16*)(lds + 8 * 16 * CM_SP * 4);
    const u16* src = (const u16*)(ws + (kv ? WS_VC : WS_KC)) + (size_t)bg * SEQ * 64;
    const u16* pe = (const u16*)(ws + (kv ? WS_PEV : WS_PEK));
    const u16* w1t = (const u16*)(ws + (kv ? WS_CW1V_T : WS_CW1K_T));
    const int n = 16 * mt + r;
    const int nc = n < NCMP ? n : NCMP - 1;
    const u16* arow = src + (size_t)nc * 1024 + 8 * quad;
    const u16* brow = w1t + (size_t)r * 2048 + 8 * quad;
    f32x4 acc[8];
#pragma unroll
    for (int c = 0; c < 8; ++c) acc[c] = (f32x4){0.f, 0.f, 0.f, 0.f};
    const int kbase = 256 * wave;
#pragma unroll 1
    for (int hf = 0; hf < 2; ++hf) {
#pragma unroll
        for (int st = 0; st < 4; ++st) {
            const int k0 = kbase + 32 * (4 * hf + st);
            const h16x8 av = *(const h16x8*)(arow + k0) + *(const h16x8*)(pe + k0 + 8 * quad);
#pragma unroll
            for (int c = 0; c < 8; ++c) { const h16x8 bf = *(const h16x8*)(brow + (size_t)(16 * c) * 2048 + k0); acc[c] = MFMA16H(av, bf, acc[c]); }
        }
    }
#pragma unroll
    for (int c = 0; c < 8; ++c)
#pragma unroll
        for (int i = 0; i < 4; ++i) slab[(wave * 16 + 4 * quad + i) * CM_SP + 16 * c + r] = acc[c][i];
    AT_BAR();
#pragma unroll
    for (int jj = 0; jj < 4; ++jj) {
        const int idx = tid + NTHREADS * jj, row = idx >> 7, col = idx & 127;
        float x = 0.f;
#pragma unroll
        for (int w8 = 0; w8 < 8; ++w8) x += slab[(w8 * 16 + row) * CM_SP + col];
        hb[row * CM_HP + col] = f2h(x * sigmoid_f(x));
    }
    AT_BAR();
    if (wave < 4) {
        const u16* w2t = (const u16*)(ws + (kv ? WS_CW2V_T : WS_CW2K_T)) + (size_t)(16 * wave + r) * 128 + 8 * quad;
        f32x4 oc = {0.f, 0.f, 0.f, 0.f};
#pragma unroll
        for (int ks = 0; ks < 4; ++ks) {
            const h16x8 af = *(const LAS h16x8*)(hb + r * CM_HP + 32 * ks + 8 * quad);
            const h16x8 bf = *(const h16x8*)(w2t + 32 * ks);
            oc = MFMA16H(af, bf, oc);
        }
        const int d = 16 * wave + r, n0 = 16 * mt + 4 * quad;
        if (kv == 0) {
            u16* dst = (u16*)(ws + WS_KCMP) + (size_t)bg * 512 * 64 + d;
#pragma unroll
            for (int i = 0; i < 4; ++i) dst[(size_t)(n0 + i) * 64] = (n0 + i) < NCMP ? f2h(oc[i]) : (u16)0;
        } else {
            u32x2 w; w.x = pkh(oc[0], oc[1]); w.y = pkh(oc[2], (n0 + 3) < NCMP ? oc[3] : 0.f);
            *(u32x2*)((u16*)(ws + WS_VCMPT) + ((size_t)bg * 64 + d) * 512 + n0) = w;
        }
    }
    AT_BAR();
}
constexpr int NS_IMP_P = 132, NS_MAXIT = 288, NS_SLOT = 32 * 144;
constexpr int NS_OFF_IMP = 0, NS_OFF_KC = 67584;
constexpr int NS_OFF_SLOT = 0, NS_OFF_SLOTL = 2 * 8 * NS_SLOT, NS_OFF_OA = NS_OFF_SLOTL + 2048;
constexpr int NS_OFF_BM = 141312, NS_OFF_ITEMS = 142336, NS_OFF_CNT = 145792;
static_assert(2 * 64 * NS_IMP_P * 4 <= NS_OFF_KC && NS_OFF_KC + 512 * 144 <= NS_OFF_BM && NS_OFF_OA + 4 * 512 * 16 <= NS_OFF_BM &&
              NS_OFF_ITEMS + NS_MAXIT * 12 <= NS_OFF_CNT && NS_OFF_CNT + 16 + 1024 <= LDS_BYTES - 256 && AT_LDS <= NS_OFF_BM, "nsa LDS map");
#define NS_BAR() do { asm volatile("s_waitcnt lgkmcnt(0)" ::: "memory"); __builtin_amdgcn_s_barrier(); asm volatile("" ::: "memory"); } while (0)

__device__ __forceinline__ void nsa_unit(unsigned char* ws, LAS unsigned char* lds, int bg, int qt, int wave, int lane) {
    const int tid = threadIdx.x; const int b = bg >> 1, g = bg & 1;
    LAS float* imp = (LAS float*)(lds + NS_OFF_IMP);
    LAS unsigned* bm = (LAS unsigned*)(lds + NS_OFF_BM);
    LAS unsigned char* kcl = lds + NS_OFF_KC;
    LAS unsigned* items = (LAS unsigned*)(lds + NS_OFF_ITEMS);
    LAS unsigned* cnt = (LAS unsigned*)(lds + NS_OFF_CNT);
    const float* gates = (const float*)(ws + WS_GATES);
    for (int i = tid; i < 2 * 64 * NS_IMP_P; i += NTHREADS) imp[i] = 0.f;
    if (tid == 0) cnt[0] = 0u;
    {
        const int amax = 4 * qt + 3;
        int nrows = 32 * ((amax + 31) >> 5); nrows = nrows > 512 ? 512 : nrows;
        const u16* kcg = (const u16*)(ws + WS_KCMP) + (size_t)bg * 512 * 64;
        u32x4 tmp[8];
#pragma unroll
        for (int ii = 0; ii < 8; ++ii) { const int i = tid + NTHREADS * ii; if (i < nrows * 8) tmp[ii] = *(const u32x4*)(kcg + (size_t)i * 8); }
#pragma unroll
        for (int ii = 0; ii < 8; ++ii) { const int i = tid + NTHREADS * ii; if (i < nrows * 8) *(LAS u32x4*)(kcl + (i >> 3) * 144 + (i & 7) * 16) = tmp[ii]; }
    }
    AT_BAR();
    {
        int ln1 = lane; asm volatile("" : "+v"(ln1));
        const int qg = wave & 3, hp = wave >> 2, qi = ln1 & 15, quad = ln1 >> 4;
        const int a = 4 * qt + qg;
        const int nlim = (qi == 15) ? a - 1 : a - 2;
        const int nT = (a + 15) >> 4, nP = (nT + 1) >> 1;
        const int q = 16 * qg + qi; const size_t row = (size_t)b * SEQ + 64 * qt + q;
        const u16* vtg = (const u16*)(ws + WS_VCMPT) + (size_t)bg * 64 * 512;
        const LAS unsigned char* kl = kcl + qi * 144 + quad * 16;
        LAS float* ir = imp + (hp * 64 + q) * NS_IMP_P + quad;
        h16x8 qf2[2][2];
#pragma unroll
        for (int hh = 0; hh < 2; ++hh)
#pragma unroll
            for (int ks = 0; ks < 2; ++ks) qf2[hh][ks] = *(const h16x8*)((const u16*)(ws + WS_Q) + row * 512 + (4 * g + 2 * hp + hh) * 64 + 32 * ks + 8 * quad);
        float m[2] = {-1e30f, -1e30f}, l[2] = {0.f, 0.f};
        for (int P = 0; P < nP; ++P) {
            h16x8 kp[2][2];
#pragma unroll
            for (int tt = 0; tt < 2; ++tt) { kp[tt][0] = *(const LAS h16x8*)(kl + (2 * P + tt) * 16 * 144); kp[tt][1] = *(const LAS h16x8*)(kl + (2 * P + tt) * 16 * 144 + 64); }
            f32x4 sv[2][2];
#pragma unroll
            for (int tt = 0; tt < 2; ++tt)
#pragma unroll
                for (int hh = 0; hh < 2; ++hh) { f32x4 z = {0.f, 0.f, 0.f, 0.f}; z = MFMA16H(kp[tt][0], qf2[hh][0], z); sv[tt][hh] = MFMA16H(kp[tt][1], qf2[hh][1], z); }
#pragma unroll
            for (int hh = 0; hh < 2; ++hh) {
                float mx = m[hh];
#pragma unroll
                for (int tt = 0; tt < 2; ++tt)
#pragma unroll
                    for (int i = 0; i < 4; ++i) mx = (16 * (2 * P + tt) + 4 * quad + i <= nlim) ? fmaxf(mx, sv[tt][hh][i]) : mx;
                float add = 0.f;
#pragma unroll
                for (int tt = 0; tt < 2; ++tt)
#pragma unroll
                    for (int i = 0; i < 4; ++i) add += (16 * (2 * P + tt) + 4 * quad + i <= nlim) ? __builtin_amdgcn_exp2f(sv[tt][hh][i] - mx) : 0.f;
                l[hh] = l[hh] * __builtin_amdgcn_exp2f(m[hh] - mx) + add; m[hh] = mx;
            }
        }
        float mall[2], inv[2];
#pragma unroll
        for (int hh = 0; hh < 2; ++hh) {
            float ma = fmaxf(m[hh], __shfl_xor(m[hh], 16)); ma = fmaxf(ma, __shfl_xor(ma, 32));
            float lw = l[hh] * __builtin_amdgcn_exp2f(m[hh] - ma); lw += __shfl_xor(lw, 16); lw += __shfl_xor(lw, 32);
            mall[hh] = ma; inv[hh] = lw > 0.f ? 1.0f / lw : 0.f;
        }
        f32x4 oc[2][4];
#pragma unroll
        for (int hh = 0; hh < 2; ++hh)
#pragma unroll
            for (int dt = 0; dt < 4; ++dt) oc[hh][dt] = (f32x4){0.f, 0.f, 0.f, 0.f};
        float cwrap = 0.f;
        u32x2 vn[4][2];
#pragma unroll
        for (int dt = 0; dt < 4; ++dt) { const u16* vp = vtg + (size_t)(16 * dt + qi) * 512 + 4 * quad; vn[dt][0] = *(const u32x2*)vp; vn[dt][1] = *(const u32x2*)(vp + 16); }
        for (int P = 0; P < nP; ++P) {
            u32x4 va4[4];
#pragma unroll
            for (int dt = 0; dt < 4; ++dt) va4[dt] = (u32x4){vn[dt][0].x, vn[dt][0].y, vn[dt][1].x, vn[dt][1].y};
            if (P + 1 < nP) {
#pragma unroll
                for (int dt = 0; dt < 4; ++dt) { const u16* vp = vtg + (size_t)(16 * dt + qi) * 512 + 32 * (P + 1) + 4 * quad; vn[dt][0] = *(const u32x2*)vp; vn[dt][1] = *(const u32x2*)(vp + 16); }
            }
            h16x8 kp[2][2];
#pragma unroll
            for (int tt = 0; tt < 2; ++tt) { kp[tt][0] = *(const LAS h16x8*)(kl + (2 * P + tt) * 16 * 144); kp[tt][1] = *(const LAS h16x8*)(kl + (2 * P + tt) * 16 * 144 + 64); }
            f32x4 sv[2][2];
#pragma unroll
            for (int tt = 0; tt < 2; ++tt)
#pragma unroll
                for (int hh = 0; hh < 2; ++hh) { f32x4 z = {0.f, 0.f, 0.f, 0.f}; z = MFMA16H(kp[tt][0], qf2[hh][0], z); sv[tt][hh] = MFMA16H(kp[tt][1], qf2[hh][1], z); }
            u32x4 pw[2];
            float A2[2], C2[2];
#pragma unroll
            for (int tt = 0; tt < 2; ++tt) {
                const int n0 = 16 * (2 * P + tt) + 4 * quad;
                float A = 0.f, C = 0.f;
#pragma unroll
                for (int hh = 0; hh < 2; ++hh) {
                    float pv[4];
#pragma unroll
                    for (int i = 0; i < 4; ++i) pv[i] = (n0 + i <= nlim) ? __builtin_amdgcn_exp2f(sv[tt][hh][i] - mall[hh]) * inv[hh] : 0.f;
                    A += (pv[0] + pv[1]) + (pv[2] + 0.5f * pv[3]); C += 0.5f * pv[3];
                    if (tt == 0) { pw[hh].x = pkh(pv[0], pv[1]); pw[hh].y = pkh(pv[2], pv[3]); } else { pw[hh].z = pkh(pv[0], pv[1]); pw[hh].w = pkh(pv[2], pv[3]); }
                }
                A2[tt] = A; C2[tt] = C;
            }
            const float cup0 = __shfl_up(C2[0], 16), cup1 = __shfl_up(C2[1], 16);
            const float cw0 = __shfl(C2[0], qi + 48), cw1 = __shfl(C2[1], qi + 48);
            ir[4 * (2 * P)] = A2[0] + (quad > 0 ? cup0 : cwrap);
            ir[4 * (2 * P + 1)] = A2[1] + (quad > 0 ? cup1 : cw0);
            cwrap = cw1;
#pragma unroll
            for (int dt = 0; dt < 4; ++dt) {
#pragma unroll
                for (int hh = 0; hh < 2; ++hh) oc[hh][dt] = MFMA16H(__builtin_bit_cast(h16x8, va4[dt]), __builtin_bit_cast(h16x8, pw[hh]), oc[hh][dt]);
            }
        }
        if (quad == 0 && 2 * nP < 32) ir[4 * (2 * nP)] = cwrap;
#pragma unroll
        for (int hh = 0; hh < 2; ++hh) {
            const int h = 2 * hp + hh;
            const float g0 = gates[row * 24 + (4 * g + h) * 3 + 0];
#pragma unroll
            for (int dt = 0; dt < 4; ++dt) {
                u32x2 w; w.x = pkh(oc[hh][dt][0] * g0, oc[hh][dt][1] * g0); w.y = pkh(oc[hh][dt][2] * g0, oc[hh][dt][3] * g0);
                *(u32x2*)((u16*)(ws + WS_Y) + row * DM + (4 * g + h) * 64 + 16 * dt + 4 * quad) = w;
            }
        }
    }
    __syncthreads();
    {
        const int cur = qt, nf = cur == 0 ? 1 : (cur == 1 ? 2 : 3), need = NTOP - nf, jhi = cur - 2;
        int ln2 = lane; asm volatile("" : "+v"(ln2));
        const int j1 = ln2, j2 = ln2 + 64;
        const bool c1 = (j1 >= 1 && j1 <= jhi), c2 = (j2 <= jhi);
        const bool f1 = (j1 == 0) || (j1 == cur) || (j1 == cur - 1), f2 = (j2 == cur) || (j2 == cur - 1);
#pragma unroll 1
        for (int q0 = 0; q0 < 8; q0 += 4) {
            unsigned u1[4], u2[4];
#pragma unroll
            for (int k = 0; k < 4; ++k) {
                const int q = 8 * wave + q0 + k;
                const LAS float* ir0 = imp + q * NS_IMP_P; const LAS float* ir1 = imp + (64 + q) * NS_IMP_P;
                u1[k] = __float_as_uint(ir0[j1] + ir1[j1]); u2[k] = __float_as_uint(ir0[j2] + ir1[j2]);
                u1[k] = c1 ? u1[k] : 0u; u2[k] = c2 ? u2[k] : 0u;
            }
            unsigned pre[4] = {0u, 0u, 0u, 0u};
            if (jhi > need) {
                for (int bit = 30; bit >= 0; --bit) {
#pragma unroll
                    for (int k = 0; k < 4; ++k) {
                        const unsigned tr = pre[k] | (1u << bit);
                        const int cge = __popcll(__ballot(u1[k] >= tr)) + __popcll(__ballot(u2[k] >= tr));
                        pre[k] = cge >= need ? tr : pre[k];
                    }
                }
            }
#pragma unroll
            for (int k = 0; k < 4; ++k) {
                const int q = 8 * wave + q0 + k;
                bool s1 = f1 || c1, s2 = f2 || c2;
                if (jhi > need) {
                    const unsigned long long g1 = __ballot(c1 && u1[k] > pre[k]), g2 = __ballot(c2 && u2[k] > pre[k]);
                    const unsigned long long e1 = __ballot(c1 && u1[k] == pre[k]), e2 = __ballot(c2 && u2[k] == pre[k]);
                    const int rem = need - (__popcll(g1) + __popcll(g2));
                    const int er1 = __builtin_amdgcn_mbcnt_hi((unsigned)(e1 >> 32), __builtin_amdgcn_mbcnt_lo((unsigned)e1, 0u));
                    const int er2 = __popcll(e1) + __builtin_amdgcn_mbcnt_hi((unsigned)(e2 >> 32), __builtin_amdgcn_mbcnt_lo((unsigned)e2, 0u));
                    s1 = f1 || (c1 && (u1[k] > pre[k] || (u1[k] == pre[k] && er1 < rem)));
                    s2 = f2 || (c2 && (u2[k] > pre[k] || (u2[k] == pre[k] && er2 < rem)));
                }
                const unsigned long long m1 = __ballot(s1), m2 = __ballot(s2);
                if (ln2 == 0) { bm[q * 4 + 0] = (unsigned)m1; bm[q * 4 + 1] = (unsigned)(m1 >> 32); bm[q * 4 + 2] = (unsigned)m2; bm[q * 4 + 3] = (unsigned)(m2 >> 32); }
            }
        }
    }
    AT_BAR();
    {
        constexpr int MB_QL = 0, MB_QP = 528, MB_KV = 33792, MB_SLOT = MB_KV + 8 * AT_TILE, MB_SP = 144, MB_SLOTL = MB_SLOT + 8 * 32 * MB_SP, MB_PERM = MB_SLOTL + 1024;
        static_assert(64 * MB_QP <= MB_KV && MB_PERM + 512 <= LDS_BYTES - 256, "mbr LDS map");
        int ln3 = lane, td3 = tid; asm volatile("" : "+v"(ln3), "+v"(td3));
        const int r32 = ln3 & 31, hi = ln3 >> 5, qi = r32 >> 2, h = r32 & 3;
        const int prow = (r32 & 0x13) | ((r32 & 8) >> 1) | ((r32 & 4) << 1);
        const int oq = td3 >> 3, oh = (td3 >> 1) & 3, ohf = td3 & 1;
        LAS unsigned char* ql = lds + MB_QL;
        LAS unsigned char* kvl = lds + MB_KV;
        LAS unsigned char* slots = lds + MB_SLOT;
        LAS float* slotl = (LAS float*)(lds + MB_SLOTL);
        LAS unsigned char* permw = lds + MB_PERM + wave * 64;
        {
            const u16* qsrc = (const u16*)(ws + WS_Q) + ((size_t)b * SEQ + 64 * qt) * 512 + 4 * g * 64;
#pragma unroll
            for (int i = 0; i < 4; ++i) { const int idx = td3 + NTHREADS * i, r = idx >> 5, pc = idx & 31; *(LAS u32x4*)(ql + r * MB_QP + pc * 16) = *(const u32x4*)(qsrc + (size_t)r * 512 + pc * 8); }
        }
        const int srow = td3 >> 3, sch = td3 & 7;
        const u16* ksrc = (const u16*)(ws + WS_KS) + (size_t)bg * SEQ * 64 + (size_t)srow * 64 + 8 * sch;
        const u16* vsrc = (const u16*)(ws + WS_VST) + (size_t)bg * 64 * SEQ + (size_t)srow * 64 + 8 * sch;
        const int sdst = srow * AT_PITCH + sch * 16;
        const int nrnd = (qt + 4) >> 2;
        u32x4 kr[4], vr[4];
#define MB_LOAD(R_) do { _Pragma("unroll") for (int bi = 0; bi < 4; ++bi) { const int jb_ = 4 * (R_) + bi; const int jc_ = jb_ <= qt ? jb_ : qt; \
            kr[bi] = *(const u32x4*)(ksrc + (size_t)jc_ * 4096); vr[bi] = *(const u32x4*)(vsrc + (size_t)jc_ * 4096); } } while (0)
#define MB_STORE() do { _Pragma("unroll") for (int bi = 0; bi < 4; ++bi) { *(LAS u32x4*)(kvl + bi * AT_TILE + sdst) = kr[bi]; *(LAS u32x4*)(kvl + (4 + bi) * AT_TILE + sdst) = vr[bi]; } } while (0)
        MB_LOAD(0);
        const unsigned mybm0 = bm[ln3 * 4 + 0], mybm1 = bm[ln3 * 4 + 1], mybm2 = bm[ln3 * 4 + 2], mybm3 = bm[ln3 * 4 + 3];
        MB_STORE();
        h16x2 oa[16]; float la = 0.f;
#pragma unroll
        for (int e = 0; e < 16; ++e) oa[e] = (h16x2){(h16)0.f, (h16)0.f};
        const u32x4 onesw = {0x3c003c00u, 0x3c003c00u, 0x3c003c00u, 0x3c003c00u};
        const int koff = prow * AT_PITCH + hi * 16, voff = 4 * AT_TILE + r32 * AT_PITCH + hi * 16;
        const unsigned blo = oq >= 32 ? 0xffffffffu : ((1u << oq) - 1u), bhi = oq >= 32 ? ((1u << (oq - 32)) - 1u) : 0u;
        const unsigned obit = 1u << (oq & 31); const bool ohigh = oq >= 32;
        AT_BAR();
        for (int R = 0; R < nrnd; ++R) {
            if (R + 1 < nrnd) MB_LOAD(R + 1);
            unsigned long long mk[4]; int cb[4], base[4]; int NI = 0;
#pragma unroll
            for (int bi = 0; bi < 4; ++bi) {
                const int j = 4 * R + bi;
                const unsigned mw = j < 32 ? mybm0 : (j < 64 ? mybm1 : (j < 96 ? mybm2 : mybm3));
                const bool bit = (j <= qt) && ((mw >> (j & 31)) & 1u);
                mk[bi] = __ballot(bit); cb[bi] = __popcll(mk[bi]); base[bi] = NI; NI += (cb[bi] + 7) >> 3;
            }
            const int nsub = (NI + 7) >> 3;
            for (int sr = 0; sr < nsub; ++sr) {
                const int it = 8 * sr + wave;
                if (it < NI) {
                    int bi = 0;
                    if (it >= base[1]) bi = 1;
                    if (it >= base[2]) bi = 2;
                    if (it >= base[3]) bi = 3;
                    const unsigned long long mkb = bi == 0 ? mk[0] : (bi == 1 ? mk[1] : (bi == 2 ? mk[2] : mk[3]));
                    const int cbb = bi == 0 ? cb[0] : (bi == 1 ? cb[1] : (bi == 2 ? cb[2] : cb[3]));
                    const int sub = it - (bi == 0 ? base[0] : (bi == 1 ? base[1] : (bi == 2 ? base[2] : base[3])));
                    const int j = 4 * R + bi;
                    const unsigned mwj = j < 32 ? mybm0 : (j < 64 ? mybm1 : (j < 96 ? mybm2 : mybm3));
                    const bool bit = (mwj >> (j & 31)) & 1u;
                    const int rank = __builtin_amdgcn_mbcnt_hi((unsigned)(mkb >> 32), __builtin_amdgcn_mbcnt_lo((unsigned)mkb, 0u));
                    if (bit) permw[rank] = (unsigned char)ln3;
                    h16x8 qf[4], kf[8];
#pragma unroll
                    for (int kh = 0; kh < 2; ++kh)
#pragma unroll
                        for (int d0 = 0; d0 < 4; ++d0) kf[kh * 4 + d0] = *(const LAS h16x8*)(kvl + bi * AT_TILE + kh * 32 * AT_PITCH + koff + d0 * 32);
                    const int slotq = 8 * sub + qi;
                    const bool valid = slotq < cbb;
                    const int q = valid ? (int)permw[slotq] : 0;
#pragma unroll
                    for (int d0 = 0; d0 < 4; ++d0) qf[d0] = *(const LAS h16x8*)(ql + q * MB_QP + h * 128 + d0 * 32 + hi * 16);
                    __builtin_amdgcn_sched_barrier(0);
                    f32x16 sx[2];
#pragma unroll
                    for (int kh = 0; kh < 2; ++kh) {
#pragma unroll
                        for (int e = 0; e < 16; ++e) sx[kh][e] = -(OFF2 + 4.0f);
#pragma unroll
                        for (int d0 = 0; d0 < 4; ++d0) sx[kh] = MFMA32H(kf[kh * 4 + d0], qf[d0], sx[kh]);
                    }
                    h16x8 vfr[8];
#pragma unroll
                    for (int dt = 0; dt < 2; ++dt)
#pragma unroll
                        for (int kk = 0; kk < 4; ++kk) vfr[dt * 4 + kk] = *(const LAS h16x8*)(kvl + bi * AT_TILE + voff + dt * 32 * AT_PITCH + kk * 32);
                    __builtin_amdgcn_sched_barrier(0);
                    const bool diag = (j == qt);
                    const unsigned vmk = valid ? 0xffffffffu : 0u;
                    u32x4 pw[4];
#pragma unroll
                    for (int kk = 0; kk < 4; ++kk) {
                        float pv[8];
#pragma unroll
                        for (int e = 0; e < 8; ++e) {
                            float pe = __builtin_amdgcn_exp2f(sx[kk >> 1][8 * (kk & 1) + e]);
                            if (diag) pe = (16 * kk + 8 * hi + e <= q) ? pe : 0.f;
                            pv[e] = pe;
                        }
                        pw[kk] = (u32x4){pkh(pv[0], pv[1]) & vmk, pkh(pv[2], pv[3]) & vmk, pkh(pv[4], pv[5]) & vmk, pkh(pv[6], pv[7]) & vmk};
                    }
                    f32x16 o[2], ol;
#pragma unroll
                    for (int e = 0; e < 16; ++e) { o[0][e] = 0.f; o[1][e] = 0.f; ol[e] = 0.f; }
#pragma unroll
                    for (int kk = 0; kk < 4; ++kk) {
                        const h16x8 pb2 = __builtin_bit_cast(h16x8, pw[kk]);
#pragma unroll
                        for (int dt = 0; dt < 2; ++dt) o[dt] = MFMA32H(vfr[dt * 4 + kk], pb2, o[dt]);
                        ol = MFMA32H(__builtin_bit_cast(h16x8, onesw), pb2, ol);
                    }
                    LAS unsigned char* sp = slots + (wave * 32 + r32) * MB_SP + hi * 8;
#pragma unroll
                    for (int dt = 0; dt < 2; ++dt)
#pragma unroll
                        for (int r4 = 0; r4 < 4; ++r4) { u32x2 w; w.x = pkh(o[dt][4 * r4], o[dt][4 * r4 + 1]); w.y = pkh(o[dt][4 * r4 + 2], o[dt][4 * r4 + 3]); *(LAS u32x2*)(sp + dt * 64 + r4 * 16) = w; }
                    if (hi == 0) slotl[wave * 32 + r32] = ol[0];
                }
                AT_BAR();
                if (sr == nsub - 1 && R + 1 < nrnd) MB_STORE();
#pragma unroll
                for (int bi = 0; bi < 4; ++bi) {
                    const unsigned mlo = (unsigned)mk[bi], mhi = (unsigned)(mk[bi] >> 32);
                    if ((ohigh ? mhi : mlo) & obit) {
                        const int rk = __builtin_popcount(mlo & blo) + __builtin_popcount(mhi & bhi);
                        const int itb = base[bi] + (rk >> 3);
                        if ((itb >> 3) == sr) {
                            const int sl = itb & 7, col = 4 * (rk & 7) + oh;
                            const LAS unsigned char* sp = slots + (sl * 32 + col) * MB_SP + ohf * 64;
#pragma unroll
                            for (int c8 = 0; c8 < 4; ++c8) {
                                const h16x8 v = *(const LAS h16x8*)(sp + c8 * 16);
#pragma unroll
                                for (int e = 0; e < 4; ++e) oa[4 * c8 + e] += (h16x2){v[2 * e], v[2 * e + 1]};
                            }
                            la += slotl[sl * 32 + col];
                        }
                    }
                }
                AT_BAR();
            }
            if (nsub == 0 && R + 1 < nrnd) { MB_STORE(); AT_BAR(); }
        }
#undef MB_LOAD
#undef MB_STORE
        {
            const size_t row = (size_t)b * SEQ + 64 * qt + oq;
            const float g1 = gates[row * 24 + (4 * g + oh) * 3 + 1];
            const float sc = g1 / la;
            const u16* owp = (const u16*)(ws + WS_OWIN) + row * 512 + (4 * g + oh) * 64 + 32 * ohf;
            u16* yp = (u16*)(ws + WS_Y) + row * DM + (4 * g + oh) * 64 + 32 * ohf;
            float ssq = 0.f;
#pragma unroll
            for (int c8 = 0; c8 < 4; ++c8) {
                const h16x8 cw = *(const h16x8*)(yp + 8 * c8), ww = *(const h16x8*)(owp + 8 * c8);
                float y[8];
#pragma unroll
                for (int e = 0; e < 8; ++e) { y[e] = (float)oa[4 * c8 + (e >> 1)][e & 1] * sc + (float)cw[e] + (float)ww[e]; ssq += y[e] * y[e]; }
                const u32x4 w = {pkh(y[0], y[1]), pkh(y[2], y[3]), pkh(y[4], y[5]), pkh(y[6], y[7])};
                *(u32x4*)(yp + 8 * c8) = w;
            }
            ssq += __shfl_xor(ssq, 1); ssq += __shfl_xor(ssq, 2); ssq += __shfl_xor(ssq, 4);
            if ((td3 & 7) == 0) ((float*)(ws + WS_SSQ))[row * 2 + g] = ssq;
        }
    }
    __syncthreads();
}

__device__ __forceinline__ void nsa_finalize_unit(unsigned char* ws, const float* gain, int u, int wave, int lane) {
    const f32x4 g0 = *(const f32x4*)(gain + 8 * lane), g1 = *(const f32x4*)(gain + 8 * lane + 4);
#pragma unroll 1
    for (int i0 = 0; i0 < 16; i0 += 8) {
        f32x2 sq[8]; h16x8 v[8];
#pragma unroll
        for (int i = 0; i < 8; ++i) {
            const size_t row = (size_t)u * 128 + wave * 16 + i0 + i;
            sq[i] = *(const f32x2*)((const float*)(ws + WS_SSQ) + row * 2);
            v[i] = *(const h16x8*)((const u16*)(ws + WS_Y) + row * DM + 8 * lane);
        }
#pragma unroll
        for (int i = 0; i < 8; ++i) {
            const size_t row = (size_t)u * 128 + wave * 16 + i0 + i;
            const float rs = 1.0f / sqrtf((sq[i][0] + sq[i][1]) * (1.0f / 512.f) + EPS);
            u32x4 w;
            w.x = pkh((float)v[i][0] * rs * g0[0], (float)v[i][1] * rs * g0[1]); w.y = pkh((float)v[i][2] * rs * g0[2], (float)v[i][3] * rs * g0[3]);
            w.z = pkh((float)v[i][4] * rs * g1[0], (float)v[i][5] * rs * g1[1]); w.w = pkh((float)v[i][6] * rs * g1[2], (float)v[i][7] * rs * g1[3]);
            *(u32x4*)((u16*)(ws + WS_Y) + row * DM + 8 * lane) = w;
        }
    }
}
constexpr int HG_LFP = 129;
constexpr int HG_OFF_LF = 0, HG_OFF_SEG = 33024, HG_OFF_KT = 35072, HG_OFF_VT = 35072 + 18432;
constexpr int H3_OFF_QT = 35072, H3_OFF_KH = H3_OFF_QT + 17408, H3_OFF_VT = H3_OFF_KH + 17408, H3_OFF_SSQ = H3_OFF_VT + 18432;
static_assert(H3_OFF_SSQ + 256 <= LDS_BYTES, "hgrn LDS map");

__device__ __forceinline__ void hg_load_logf(const unsigned char* ws, LAS float* lf, size_t row0, int h, int tid) {
#pragma unroll
    for (int i = 0; i < 2; ++i) {
        const int idx = tid + NTHREADS * i, s = idx >> 4, ch = idx & 15;
        const h16x8 v = *(const h16x8*)((const u16*)(ws + WS_HLOGF) + (row0 + s) * 512 + h * 128 + 8 * ch);
#pragma unroll
        for (int e = 0; e < 8; ++e) lf[s * HG_LFP + 8 * ch + e] = (float)v[e];
    }
}
__device__ __forceinline__ void hg_stage_vt(const unsigned char* ws, LAS u16* vt, size_t row0, int h, int tid) {
#pragma unroll
    for (int i = 0; i < 2; ++i) {
        const int idx = tid + NTHREADS * i, s = idx & 63, ch = idx >> 6;
        const s16x8 v = *(const s16x8*)((const u16*)(ws + WS_HV) + (row0 + s) * 512 + h * 128 + 8 * ch);
#pragma unroll
        for (int e = 0; e < 8; ++e) vt[(8 * ch + e) * 72 + s] = (u16)v[e];
    }
}

__device__ __forceinline__ void hgrn_h1_units(unsigned char* ws, LAS unsigned char* lds, int u0, int stride, int nu, int wave, int lane) {
    if (u0 >= nu) return;
    const int tid = threadIdx.x, r32 = lane & 31, hi = lane >> 5;
    LAS float* lf = (LAS float*)(lds + HG_OFF_LF);
    LAS float* seg = (LAS float*)(lds + HG_OFF_SEG);
    LAS u16* kt = (LAS u16*)(lds + HG_OFF_KT);
    LAS u16* vt = (LAS u16*)(lds + HG_OFF_VT);
    h16x8 lfr[2]; s16x8 vvr[2];
#define H1_LOAD(uu) do { const int c_ = (uu) & 127, bh_ = (uu) >> 7; const size_t r0_ = (size_t)(bh_ >> 2) * SEQ + 64 * c_; const int h_ = bh_ & 3; \
        _Pragma("unroll") for (int i = 0; i < 2; ++i) { const int idx = tid + NTHREADS * i; \
            lfr[i] = *(const h16x8*)((const u16*)(ws + WS_HLOGF) + (r0_ + (idx >> 4)) * 512 + h_ * 128 + 8 * (idx & 15)); \
            vvr[i] = *(const s16x8*)((const u16*)(ws + WS_HV) + (r0_ + (idx & 63)) * 512 + h_ * 128 + 8 * (idx >> 6)); } } while (0)
    H1_LOAD(u0);
    for (int u = u0; u < nu; u += stride) {
        const int c = u & 127, bh = u >> 7;
#pragma unroll
        for (int i = 0; i < 2; ++i) {
            const int idx = tid + NTHREADS * i;
            { const int s = idx >> 4, ch = idx & 15;
#pragma unroll
              for (int e = 0; e < 8; ++e) lf[s * HG_LFP + 8 * ch + e] = (float)lfr[i][e]; }
            { const int s = idx & 63, ch = idx >> 6;
#pragma unroll
              for (int e = 0; e < 8; ++e) vt[(8 * ch + e) * 72 + s] = (u16)vvr[i][e]; }
        }
        if (u + stride < nu) H1_LOAD(u + stride);
        AT_BAR();
        const int d = tid & 127, sg = tid >> 7;
        float lg[16]; float tot = 0.f;
#pragma unroll
        for (int i = 0; i < 16; ++i) { lg[i] = lf[(16 * sg + i) * HG_LFP + d]; tot += lg[i]; }
        seg[sg * 128 + d] = tot;
        AT_BAR();
        {
            float R = 0.f;
            for (int s2 = sg + 1; s2 < 4; ++s2) R += seg[s2 * 128 + d];
#pragma unroll
            for (int i = 15; i >= 0; --i) {
                const float ke = (1.0f - __expf(lg[i])) * __expf(R);
                kt[d * 72 + 16 * sg + i] = f2b(ke);
                R += lg[i];
            }
            if (sg == 0) ((float*)(ws + WS_HD))[((size_t)bh * 128 + c) * 128 + d] = __expf(R);
        }
        AT_BAR();
        {
            const int vtile = wave & 3;
            s16x8 bfr[4];
#pragma unroll
            for (int ks = 0; ks < 4; ++ks) bfr[ks] = *(const LAS s16x8*)(vt + (32 * vtile + r32) * 72 + 16 * ks + 8 * hi);
            u16* dst = (u16*)(ws + WS_HL) + (((size_t)bh * 128 + c) * 128 + 32 * vtile + r32) * 128;
#pragma unroll
            for (int dd = 0; dd < 2; ++dd) {
                const int dtile = 2 * (wave >> 2) + dd;
                f32x16 acc;
#pragma unroll
                for (int i = 0; i < 16; ++i) acc[i] = 0.f;
                s16x8 afr[4];
#pragma unroll
                for (int ks = 0; ks < 4; ++ks) afr[ks] = *(const LAS s16x8*)(kt + (32 * dtile + r32) * 72 + 16 * ks + 8 * hi);
#pragma unroll
                for (int ks = 0; ks < 4; ++ks) acc = MFMA32B(afr[ks], bfr[ks], acc);
#pragma unroll
                for (int r4 = 0; r4 < 4; ++r4) {
                    u32x2 w; w.x = pkb(acc[4 * r4], acc[4 * r4 + 1]); w.y = pkb(acc[4 * r4 + 2], acc[4 * r4 + 3]);
                    *(u32x2*)(dst + 32 * dtile + 8 * r4 + 4 * hi) = w;
                }
            }
        }
        AT_BAR();
    }
#undef H1_LOAD
}

__device__ __forceinline__ void hgrn_h2_unit(unsigned char* ws, int u, int wave, int lane) {
    if (wave >= 2) return;
    const int gt = u * 128 + wave * 64 + lane;
    const int bh = gt >> 12, v = (gt >> 5) & 127, d0 = 4 * (gt & 31);
    const u16* lp = (const u16*)(ws + WS_HL) + ((size_t)bh * 128 * 128 + v) * 128 + d0;
    u16* sp = (u16*)(ws + WS_HS) + ((size_t)bh * 128 * 128 + v) * 128 + d0;
    const float* dp = (const float*)(ws + WS_HD) + (size_t)bh * 128 * 128 + d0;
    float S0 = 0.f, S1 = 0.f, S2 = 0.f, S3 = 0.f;
#pragma unroll 1
    for (int c0 = 0; c0 < 128; c0 += 16) {
        u32x2 lw[16]; f32x4 dv[16];
#pragma unroll
        for (int i = 0; i < 16; ++i) { lw[i] = *(const u32x2*)(lp + (size_t)(c0 + i) * 16384); dv[i] = *(const f32x4*)(dp + (c0 + i) * 128); }
#pragma unroll
        for (int i = 0; i < 16; ++i) {
            u32x2 w; w.x = pkb(S0, S1); w.y = pkb(S2, S3);
            *(u32x2*)(sp + (size_t)(c0 + i) * 16384) = w;
            S0 = dv[i][0] * S0 + __builtin_bit_cast(float, lw[i].x << 16); S1 = dv[i][1] * S1 + __builtin_bit_cast(float, lw[i].x & 0xffff0000u);
            S2 = dv[i][2] * S2 + __builtin_bit_cast(float, lw[i].y << 16); S3 = dv[i][3] * S3 + __builtin_bit_cast(float, lw[i].y & 0xffff0000u);
        }
    }
}

constexpr int H3_OFF_QR = H3_OFF_SSQ + 256;
static_assert(H3_OFF_QR + 64 * 136 * 2 <= LDS_BYTES - 256, "hgrn h3 LDS map");
__device__ __forceinline__ void hgrn_h3_units(unsigned char* ws, LAS unsigned char* lds, const float* ogain, int u0, int stride, int nu, int wave, int lane) {
    if (u0 >= nu) return;
    const int tid = threadIdx.x, r32 = lane & 31, hi = lane >> 5;
    LAS float* lf = (LAS float*)(lds + HG_OFF_LF);
    LAS float* seg = (LAS float*)(lds + HG_OFF_SEG);
    LAS u16* qt = (LAS u16*)(lds + H3_OFF_QT);
    LAS u16* kh = (LAS u16*)(lds + H3_OFF_KH);
    LAS u16* vt = (LAS u16*)(lds + H3_OFF_VT);
    LAS float* ssq = (LAS float*)(lds + H3_OFF_SSQ);
    LAS u16* qr = (LAS u16*)(lds + H3_OFF_QR);
    h16x8 lfr[2]; s16x8 vvr[2], qqr[2];
#define H3_LOAD(uu) do { const int c_ = (uu) & 127, bh_ = (uu) >> 7; const size_t r0_ = (size_t)(bh_ >> 2) * SEQ + 64 * c_; const int h_ = bh_ & 3; \
        _Pragma("unroll") for (int i = 0; i < 2; ++i) { const int idx = tid + NTHREADS * i; \
            lfr[i] = *(const h16x8*)((const u16*)(ws + WS_HLOGF) + (r0_ + (idx >> 4)) * 512 + h_ * 128 + 8 * (idx & 15)); \
            qqr[i] = *(const s16x8*)((const u16*)(ws + WS_HQ) + (r0_ + (idx >> 4)) * 512 + h_ * 128 + 8 * (idx & 15)); \
            vvr[i] = *(const s16x8*)((const u16*)(ws + WS_HV) + (r0_ + (idx & 63)) * 512 + h_ * 128 + 8 * (idx >> 6)); } } while (0)
    H3_LOAD(u0);
    for (int u = u0; u < nu; u += stride) {
        const int c = u & 127, bh = u >> 7, b = bh >> 2, h = bh & 3;
        const size_t row0 = (size_t)b * SEQ + 64 * c;
#pragma unroll
        for (int i = 0; i < 2; ++i) {
            const int idx = tid + NTHREADS * i;
            { const int s = idx >> 4, ch = idx & 15;
#pragma unroll
              for (int e = 0; e < 8; ++e) lf[s * HG_LFP + 8 * ch + e] = (float)lfr[i][e];
              *(LAS s16x8*)(qr + s * 136 + 8 * ch) = qqr[i]; }
            { const int s = idx & 63, ch = idx >> 6;
#pragma unroll
              for (int e = 0; e < 8; ++e) vt[(8 * ch + e) * 72 + s] = (u16)vvr[i][e]; }
        }
        if (tid < 64) ssq[tid] = 0.f;
        if (u + stride < nu) H3_LOAD(u + stride);
        s16x8 sfr[8];
        {
            const u16* sp = (const u16*)(ws + WS_HS) + (((size_t)bh * 128 + c) * 128 + 32 * (wave >> 1) + r32) * 128 + 8 * hi;
#pragma unroll
            for (int ks = 0; ks < 8; ++ks) sfr[ks] = *(const s16x8*)(sp + 16 * ks);
        }
        AT_BAR();
        const int d = tid & 127, sg = tid >> 7;
        float lg[16]; float tot = 0.f;
#pragma unroll
        for (int i = 0; i < 16; ++i) { lg[i] = lf[(16 * sg + i) * HG_LFP + d]; tot += lg[i]; }
        seg[sg * 128 + d] = tot;
        AT_BAR();
        {
            float Bc = 0.f;
            for (int s2 = 0; s2 < sg; ++s2) Bc += seg[s2 * 128 + d];
#pragma unroll
            for (int i = 0; i < 16; ++i) {
                Bc += lg[i];
                const float qv = b2f(qr[(16 * sg + i) * 136 + d]);
                qt[(16 * sg + i) * 136 + d] = f2b(qv * __expf(Bc));
                kh[(16 * sg + i) * 136 + d] = f2b((1.0f - __expf(lg[i])) * __expf(fminf(-Bc, 80.f)));
            }
        }
        AT_BAR();
        {
            const int th = wave & 1, vtile = wave >> 1;
            s16x8 qf[8];
#pragma unroll
            for (int ks = 0; ks < 8; ++ks) qf[ks] = *(const LAS s16x8*)(qt + (32 * th + r32) * 136 + 16 * ks + 8 * hi);
            f32x16 acc;
#pragma unroll
            for (int i = 0; i < 16; ++i) acc[i] = 0.f;
            {
#pragma unroll
                for (int ks = 0; ks < 8; ++ks) acc = MFMA32B(sfr[ks], qf[ks], acc);
            }
            const int prow = (r32 & 0x13) | ((r32 & 8) >> 1) | ((r32 & 4) << 1);
            for (int sh = 0; sh <= th; ++sh) {
                f32x16 x;
#pragma unroll
                for (int i = 0; i < 16; ++i) x[i] = 0.f;
                s16x8 kfr[8], vfr2[2];
#pragma unroll
                for (int ks = 0; ks < 8; ++ks) kfr[ks] = *(const LAS s16x8*)(kh + (32 * sh + prow) * 136 + 16 * ks + 8 * hi);
#pragma unroll
                for (int sp2 = 0; sp2 < 2; ++sp2) vfr2[sp2] = *(const LAS s16x8*)(vt + (32 * vtile + r32) * 72 + 32 * sh + 16 * sp2 + 8 * hi);
#pragma unroll
                for (int ks = 0; ks < 8; ++ks) x = MFMA32B(kfr[ks], qf[ks], x);
                u32x4 pw[2];
#pragma unroll
                for (int sp2 = 0; sp2 < 2; ++sp2) {
                    float xv[8];
#pragma unroll
                    for (int e = 0; e < 8; ++e) { const int sin_ = 16 * sp2 + 8 * hi + e; const bool ok = (sh < th) || (sin_ <= r32); xv[e] = ok ? x[8 * sp2 + e] : 0.f; }
                    pw[sp2] = (u32x4){pkb(xv[0], xv[1]), pkb(xv[2], xv[3]), pkb(xv[4], xv[5]), pkb(xv[6], xv[7])};
                }
#pragma unroll
                for (int sp2 = 0; sp2 < 2; ++sp2) acc = MFMA32B(vfr2[sp2], __builtin_bit_cast(s16x8, pw[sp2]), acc);
            }
            const int t = 32 * th + r32;
            const u16* gp = (const u16*)(ws + WS_HG) + (row0 + t) * 512 + h * 128 + 32 * vtile + 4 * hi;
            u32x2 gw4[4];
#pragma unroll
            for (int r4 = 0; r4 < 4; ++r4) gw4[r4] = *(const u32x2*)(gp + 8 * r4);
            float sq = 0.f;
#pragma unroll
            for (int i = 0; i < 16; ++i) sq += acc[i] * acc[i];
            sq += __shfl_xor(sq, 32);
            if (hi == 0) (void)__hip_atomic_fetch_add(ssq + t, sq, __ATOMIC_RELAXED, __HIP_MEMORY_SCOPE_WORKGROUP);
            AT_BAR();
            const float rs = 1.0f / sqrtf(ssq[t] * (1.0f / 128.f) + EPS);
            u16* yp = (u16*)(ws + WS_Y) + (row0 + t) * DM + 512 + h * 128 + 32 * vtile + 4 * hi;
            const float* gn = ogain + 32 * vtile + 4 * hi;
#pragma unroll
            for (int r4 = 0; r4 < 4; ++r4) {
                const h16x4 gv = __builtin_bit_cast(h16x4, gw4[r4]);
                const f32x4 gg = *(const f32x4*)(gn + 8 * r4);
                u32x2 w;
                w.x = pkh(acc[4 * r4] * rs * gg[0] * (float)gv[0], acc[4 * r4 + 1] * rs * gg[1] * (float)gv[1]);
                w.y = pkh(acc[4 * r4 + 2] * rs * gg[2] * (float)gv[2], acc[4 * r4 + 3] * rs * gg[3] * (float)gv[3]);
                *(u32x2*)(yp + 8 * r4) = w;
            }
        }
        AT_BAR();
    }
#undef H3_LOAD
}
__global__ void __launch_bounds__(NTHREADS, 2) mk_fwd(Params p) {
    extern __shared__ __attribute__((aligned(16))) unsigned char lds_raw[];
    LAS unsigned char* lds = (LAS unsigned char*)lds_raw;
    const int tid = threadIdx.x, lane = tid & 63, wave = __builtin_amdgcn_readfirstlane(tid >> 6);
    const int G = gridDim.x, bx = blockIdx.x;
    const int vcu = (G % 8 == 0) ? (bx % 8) * (G / 8) + bx / 8 : bx;
    const int gw = vcu * NWAVES + wave, NGW = G * NWAVES;
    unsigned char* ws = p.ws;
#define IN(k) (p.ph_lo <= (k) && (k) < p.ph_hi)
    volatile LAS unsigned* xst = (volatile LAS unsigned*)(lds + LDS_BYTES - 256);
    unsigned* barw = (unsigned*)(ws + WS_CTL);
    XcdBarrier xbar; xbar.bar = barw; xbar.x = 0; xbar.st = xst;
    const bool fused = (p.ph_hi - p.ph_lo) > 1;
    if (fused) {
        if (tid < 2) xst[tid] = 0u;
        __syncthreads();
        xbar = xcd_barrier_post(barw, xst);
    }
#define SEAM(k) do { if (IN(k) && IN((k) + 1)) xcd_barrier(xbar); } while (0)

    if (IN(0)) { p0_prologue(p, lds, gw, NGW, wave, lane); }
    SEAM(0);
    if (IN(1)) {
        pg8::Gemm g{(const u16*)(ws + WS_XH), (const u16*)(ws + WS_WIN_T), MT, DINP, DM}; pg8::StaticOrder S; S.init(MT, DINP, G, bx);
        pg8::EpiInProj E{ws, p.in[3], p.in[4]};
        pg8::gemm_phase<pg8::EpiInProj, pg8::StaticOrder, true, true>(lds, g, S, E, wave);
        const int nfull = (MT / 256) * (DINP / 256) - 3 * G;
        if (nfull < 0 || nfull >= G) p0_late_transposes(p, lds, gw, NGW, wave, lane);
        else if (bx >= nfull) p0_late_transposes(p, lds, (bx - nfull) * NWAVES + wave, (G - nfull) * NWAVES, wave, lane);
    }
    SEAM(1);
    if (IN(2)) {
        constexpr int NU_WIN = 512, NU_CMP = 256, NU_H1 = 1024;
        for (int u = bx; u < NU_WIN + NU_CMP + NU_H1; u += G) {
            if (u < NU_WIN) win_unit(ws, lds, u, wave, lane);
            else if (u < NU_WIN + NU_CMP) cmp_mlp_unit(ws, lds, u - NU_WIN, wave, lane);
            else { hgrn_h1_units(ws, lds, u - NU_WIN - NU_CMP, G, NU_H1, wave, lane); break; }
        }
    }
    SEAM(2);
    if (IN(3)) {
        for (int v = bx; v < 512 + 256; v += G) {
            if (v < 512) {
                int bg, qt;
                if (G == 256) { const int c = v & 255, mem = (c & 1) * 32 + (c >> 3); bg = (c & 7) >> 1; qt = (v < 256) ? mem : 127 - mem; }
                else { const int vv = v & 255; bg = vv >> 6; qt = (v < 256) ? (vv & 63) : 127 - (vv & 63); }
                nsa_unit(ws, lds, bg, qt, wave, lane);
            }
            else hgrn_h2_unit(ws, v - 512, wave, lane);
        }
    }
    SEAM(3);
    if (IN(4)) {
        for (int u = bx; u < 128 + 1024; u += G) {
            if (u < 128) nsa_finalize_unit(ws, p.in[11], u, wave, lane);
            else { hgrn_h3_units(ws, lds, p.in[13], u - 128, G, 1024, wave, lane); break; }
        }
    }
    SEAM(4);
    if (IN(5)) {
        pg8::Gemm g{(const u16*)(ws + WS_Y), (const u16*)(ws + WS_WOUT_T), MT, DM, DM}; pg8::StaticOrder S; S.init(MT, DM, G, bx);
        pg8::EpiOutProj E{p.in[0], (u16*)(ws + WS_X1H), (float*)(ws + WS_SSQ1)};
        pg8::gemm_phase<pg8::EpiOutProj, pg8::StaticOrder, true, true>(lds, g, S, E, wave);
    }
    SEAM(5);
    if (IN(6)) {
        pg8::Gemm g{(const u16*)(ws + WS_X1H), (const u16*)(ws + WS_W1_T), MT, FF, DM}; pg8::StaticOrder S; S.init(MT, FF, G, bx);
        pg8::EpiUp E{(u16*)(ws + WS_HID), (const float*)(ws + WS_SSQ1)};
        pg8::gemm_phase<pg8::EpiUp, pg8::StaticOrder, true, true>(lds, g, S, E, wave);
    }
    SEAM(6);
    if (IN(7)) {
        pg8::Gemm g{(const u16*)(ws + WS_HID), (const u16*)(ws + WS_W2_T), MT, DM, FF}; pg8::StaticOrder S; S.init(MT, DM, G, bx);
        pg8::EpiDown E{p.out, (const u16*)(ws + WS_X1H)};
        pg8::gemm_phase<pg8::EpiDown, pg8::StaticOrder, true, true>(lds, g, S, E, wave);
    }
#undef IN
#undef SEAM
}
static int g_grid = 0;
extern "C" void kernel_launch(void* const* d_in, const int* in_sizes, int n_in, void* d_out, int out_size, void* d_ws, size_t ws_size, hipStream_t stream) {
    if (g_grid == 0) {
        int dev = 0, cus = 0, per_cu = 0;
        (void)hipGetDevice(&dev); (void)hipDeviceGetAttribute(&cus, hipDeviceAttributeMultiprocessorCount, dev);
        (void)hipFuncSetAttribute((const void*)mk_fwd, hipFuncAttributeMaxDynamicSharedMemorySize, LDS_BYTES);
        if (hipOccupancyMaxActiveBlocksPerMultiprocessor(&per_cu, (const void*)mk_fwd, NTHREADS, LDS_BYTES) != hipSuccess || per_cu < 1) { per_cu = 1; (void)hipGetLastError(); }
        if (cus <= 0) cus = 256;
        g_grid = cus;
    }
    Params P{};
    for (int i = 0; i < 18; ++i) P.in[i] = (const float*)d_in[i];
    P.out = (float*)d_out; P.ws = (unsigned char*)d_ws;
    for (int i = 0; i < 8; ++i) P.invf[i] = (float)pow(500000.0, -(double)(2 * i) / 16.0);
    P.ph_lo = 0; P.ph_hi = 8;
    (void)hipMemsetAsync((char*)d_ws + WS_CTL, 0, XCD_BAR_WORDS * sizeof(unsigned), stream);
    void* args[] = {&P};
    hipError_t e = hipLaunchCooperativeKernel((const void*)mk_fwd, dim3(g_grid), dim3(NTHREADS), args, LDS_BYTES, stream);
    if (e != hipSuccess) fprintf(stderr, "cooperative launch failed: %s (grid %d)\n", hipGetErrorString(e), g_grid);
}
```

```cpp
#include <hip/hip_runtime.h>
#include <hip/hip_cooperative_groups.h>
#include <cstdio>
#include <cstdint>
#include <cmath>
namespace cg = cooperative_groups;

#define LAS __attribute__((address_space(3)))
typedef _Float16 h16;
typedef _Float16 h16x2 __attribute__((ext_vector_type(2)));
typedef _Float16 h16x4 __attribute__((ext_vector_type(4)));
typedef _Float16 h16x8 __attribute__((ext_vector_type(8)));
typedef __bf16 b16x2 __attribute__((ext_vector_type(2)));
typedef __bf16 b16x8 __attribute__((ext_vector_type(8)));
typedef short s16x8 __attribute__((ext_vector_type(8)));
typedef short s16x4 __attribute__((ext_vector_type(4)));
typedef float f32x2 __attribute__((ext_vector_type(2)));
typedef float f32x4 __attribute__((ext_vector_type(4)));
typedef float f32x16 __attribute__((ext_vector_type(16)));
typedef unsigned u32x2 __attribute__((ext_vector_type(2)));
typedef unsigned u32x4 __attribute__((ext_vector_type(4)));
typedef unsigned short u16;

__device__ __forceinline__ unsigned pkh(float lo, float hi) { f32x2 v = {lo, hi}; h16x2 h = __builtin_convertvector(v, h16x2); return __builtin_bit_cast(unsigned, h); }
__device__ __forceinline__ unsigned pkb(float lo, float hi) { f32x2 v = {lo, hi}; b16x2 h = __builtin_convertvector(v, b16x2); return __builtin_bit_cast(unsigned, h); }
__device__ __forceinline__ float h2f(u16 v) { return (float)__builtin_bit_cast(h16, v); }
__device__ __forceinline__ float b2f(u16 v) { return __builtin_bit_cast(float, (unsigned)v << 16); }
__device__ __forceinline__ u16 f2h(float f) { return __builtin_bit_cast(u16, (h16)f); }
__device__ __forceinline__ u16 f2b(float f) { return (u16)(pkb(f, 0.f) & 0xffffu); }
__device__ __forceinline__ float wave_sum(float v) {
#pragma unroll
    for (int o = 1; o < 64; o <<= 1) v += __shfl_xor(v, o);
    return v;
}
typedef int i32x4 __attribute__((ext_vector_type(4)));
typedef int i32x8 __attribute__((ext_vector_type(8)));
constexpr float F8_MAX = 448.f, HID_SCALE = 8.f, W2_SCALE = 1024.f;
__device__ __forceinline__ float clamp8(float x) { return fminf(fmaxf(x, -F8_MAX), F8_MAX); }
__device__ __forceinline__ unsigned pkf8x4(float a, float b, float c, float d) { int p = 0; p = __builtin_amdgcn_cvt_pk_fp8_f32(a, b, p, false); p = __builtin_amdgcn_cvt_pk_fp8_f32(c, d, p, true); return (unsigned)p; }
__device__ __forceinline__ float sigmoid_f(float x) { return __builtin_amdgcn_rcpf(1.f + __expf(-x)); }

constexpr int BATCH = 2, SEQ = 8192, DM = 1024, MT = BATCH * SEQ, DIN = 3352, DINP = 3584, FF = 4096;
constexpr int NG = 2, HPG = 4, HD = 64, NQH = 8;
constexpr int NCMP = 511, NSLC = 128, NTOP = 16, WINDOW = 512;
constexpr int HGH = 4, HGD = 128;
constexpr float EPS = 1e-6f;
constexpr int C_Q = 0, C_KC = 512, C_VC = 640, C_KS = 768, C_VS = 896, C_KW = 1024, C_VW = 1152, C_GATE = 1280,
              C_HQ = 1304, C_HF = 1816, C_HI = 2328, C_HG = 2840;

constexpr size_t MiB = 1u << 20;
constexpr size_t WS_CTL = 0;
constexpr size_t WS_WIN_T = 1 * MiB;
constexpr size_t WS_WOUT_T = 8 * MiB;
constexpr size_t WS_W1_T = 10 * MiB;
constexpr size_t WS_W2_T = 18 * MiB;
constexpr size_t WS_CW1K_T = 26 * MiB;
constexpr size_t WS_CW1V_T = 26 * MiB + 512 * 1024;
constexpr size_t WS_CW2K_T = 27 * MiB;
constexpr size_t WS_CW2V_T = 27 * MiB + 16 * 1024;
constexpr size_t WS_PEK = 27 * MiB + 32 * 1024;
constexpr size_t WS_PEV = 27 * MiB + 40 * 1024;
constexpr size_t WS_LB = 27 * MiB + 48 * 1024;
constexpr size_t WS_ROPE = 27 * MiB + 256 * 1024;
constexpr size_t WS_XH = 28 * MiB;
constexpr size_t WS_HL = 28 * MiB;
constexpr size_t WS_X1H = 28 * MiB;
constexpr size_t WS_Q = 60 * MiB;
constexpr size_t WS_KC = 76 * MiB;
constexpr size_t WS_KS = 80 * MiB;
constexpr size_t WS_KW = 84 * MiB;
constexpr size_t WS_VC = 88 * MiB;
constexpr size_t WS_VST = 92 * MiB;
constexpr size_t WS_VWT = 96 * MiB;
constexpr size_t WS_GATES = 100 * MiB;
constexpr size_t WS_KCMP = 101 * MiB + 512 * 1024;
constexpr size_t WS_VCMPT = 101 * MiB + 768 * 1024;
constexpr size_t WS_HD = 102 * MiB;
constexpr size_t WS_SSQ = 102 * MiB + 512 * 1024;
constexpr size_t WS_SSQ1 = 103 * MiB;
constexpr size_t WS_HQ = 104 * MiB;
constexpr size_t WS_HLOGF = 120 * MiB;
constexpr size_t WS_HV = 136 * MiB;
constexpr size_t WS_HG = 152 * MiB;
constexpr size_t WS_OWIN = 168 * MiB;
constexpr size_t WS_HS = 184 * MiB;
constexpr size_t WS_Y = 216 * MiB;
constexpr size_t WS_HID = 104 * MiB;
constexpr size_t WS_END = 256 * MiB;

constexpr int NWAVES = 8, NTHREADS = 512;
constexpr int LDS_BYTES = 147456;

#define MK_LANE() ((int)__builtin_amdgcn_mbcnt_hi(~0u, __builtin_amdgcn_mbcnt_lo(~0u, 0u)))
namespace pg8 {
#define PG8_LAS __attribute__((address_space(3)))
typedef unsigned short bf16_t;
typedef short bf16x8 __attribute__((ext_vector_type(8)));
typedef float f32x4 __attribute__((ext_vector_type(4)));
typedef unsigned u32x4 __attribute__((ext_vector_type(4)));
constexpr int BM = 256, BK = 64, HALF = 128, HTB = HALF * BK * 2  , STAGE_BYTES = 8 * HTB, NXCD = 8, WGM = 8;

__host__ __device__ __forceinline__ int lds_byte(int r, int c) { const int st = (r >> 4) * 2 + (c >> 5), rr = r & 15, cc = c & 31, ob = rr * 64 + cc * 2; return st * 1024 + (ob ^ (((ob >> 9) & 1) << 5)); }
__host__ __device__ __forceinline__ void stage_rc(int b, int& R, int& C) { const int st = b / 1024, sb = b % 1024, swz = sb ^ (((sb >> 9) & 1) << 5); R = (st >> 1) * 16 + swz / 64; C = (st & 1) * 32 + (swz % 64) / 2; }
__host__ __device__ __forceinline__ int perm32(int rho) { const int n = rho >> 4, i = rho & 15; return 8 * (i >> 2) + 4 * n + (i & 3); }

struct Unit { int pm, pn; };
struct Gemm { const bf16_t* A; const bf16_t* Bt; int M, N, K; };

struct StaticOrder {
    int nM, nN, nwg, G, c;
    __host__ __device__ void init(int M, int N, int G_, int c_) { nM = M / BM; nN = N / BM; nwg = nM * nN; G = G_; c = c_; }
    __host__ __device__ bool next(int i, Unit& u) const {
        const long L = (long)i * G + c; if (L >= nwg) return false;
        int wgid = (int)L; { const int q = nwg / NXCD, r = nwg % NXCD, xcd = wgid % NXCD, off = wgid / NXCD; wgid = (xcd < r ? xcd * (q + 1) : r * (q + 1) + (xcd - r) * q) + off; }
        const int nig = WGM * nN, gid = wgid / nig, fm = gid * WGM, gsz = (nM - fm) < WGM ? (nM - fm) : WGM;
        u.pm = fm + ((wgid % nig) % gsz); u.pn = (wgid % nig) / gsz; return true;
    }
    __device__ __forceinline__ void a_ready(const Unit&) const {}
    __device__ __forceinline__ void done(const Unit&) const {}
};

#define PG8_MFMA(a, b, c) __builtin_amdgcn_mfma_f32_16x16x32_f16(__builtin_bit_cast(h16x8, (a)), __builtin_bit_cast(h16x8, (b)), (c), 0, 0, 0)
struct EpiOutProj {
    static constexpr bool PERM = false, AFTER_DRAIN = false;
    const float* x; u16* x1h; float* ssq1;
    __device__ __forceinline__ void operator()(const f32x4 (&acc)[2][2][4][2], const Unit& u, int wr, int wc, int fr, int fq) const {
        const int col0 = u.pn * BM + wc * 32 + 4 * fq;
#pragma unroll
        for (int ai = 0; ai < 2; ++ai) {
            f32x4 xr[4][2][2];
#pragma unroll
            for (int m = 0; m < 4; ++m) {
                const size_t off = (size_t)(u.pm * BM + ai * HALF + wr * 64 + m * 16 + fr) * DM + col0;
#pragma unroll
                for (int bj = 0; bj < 2; ++bj)
#pragma unroll
                    for (int n = 0; n < 2; ++n) xr[m][bj][n] = *(const f32x4*)(x + off + bj * HALF + n * 16);
            }
#pragma unroll
            for (int m = 0; m < 4; ++m) {
                const int row = u.pm * BM + ai * HALF + wr * 64 + m * 16 + fr;
                const size_t off = (size_t)row * DM + col0;
                float ss = 0.f;
#pragma unroll
                for (int bj = 0; bj < 2; ++bj)
#pragma unroll
                    for (int n = 0; n < 2; ++n) {
                        const f32x4 v = acc[ai][bj][m][n] + xr[m][bj][n];
                        u32x2 w; w.x = pkh(v[0], v[1]); w.y = pkh(v[2], v[3]);
                        *(u32x2*)(x1h + off + bj * HALF + n * 16) = w;
                        ss += (v[0] * v[0] + v[1] * v[1]) + (v[2] * v[2] + v[3] * v[3]);
                    }
                ss += __shfl_xor(ss, 16); ss += __shfl_xor(ss, 32);
                if (fq == 0) ssq1[(size_t)row * 16 + u.pn * 4 + wc] = ss;
            }
        }
    }
};
struct EpiUp {
    static constexpr bool PERM = true, AFTER_DRAIN = false;
    unsigned char* hid; const float* ssq1;
    __device__ __forceinline__ void operator()(const f32x4 (&acc)[2][2][4][2], const Unit& u, int wr, int wc, int fr, int fq) const {
        const int col0 = u.pn * BM + wc * 32 + 8 * fq;
        f32x4 sv[2][4];
#pragma unroll
        for (int ai = 0; ai < 2; ++ai)
#pragma unroll
            for (int m = 0; m < 4; ++m) sv[ai][m] = *(const f32x4*)(ssq1 + (size_t)(u.pm * BM + ai * HALF + wr * 64 + m * 16 + fr) * 16 + 4 * fq);
#pragma unroll
        for (int ai = 0; ai < 2; ++ai)
#pragma unroll
            for (int m = 0; m < 4; ++m) {
                const int row = u.pm * BM + ai * HALF + wr * 64 + m * 16 + fr;
                float tot = (sv[ai][m][0] + sv[ai][m][1]) + (sv[ai][m][2] + sv[ai][m][3]);
                tot += __shfl_xor(tot, 16); tot += __shfl_xor(tot, 32);
                const float rs = __builtin_amdgcn_rsqf(tot * (1.0f / DM) + EPS) * 2.8284271247461903f;
                unsigned char* rowp = hid + (size_t)row * FF + col0;
#pragma unroll
                for (int bj = 0; bj < 2; ++bj) {
                    f32x4 v0 = acc[ai][bj][m][0] * rs, v1 = acc[ai][bj][m][1] * rs;
#pragma unroll
                    for (int e = 0; e < 4; ++e) { const float a = fmaxf(v0[e], 0.f), b = fmaxf(v1[e], 0.f); v0[e] = fminf(a * a, F8_MAX); v1[e] = fminf(b * b, F8_MAX); }
                    u32x2 w; w.x = pkf8x4(v0[0], v0[1], v0[2], v0[3]); w.y = pkf8x4(v1[0], v1[1], v1[2], v1[3]);
                    *(u32x2*)(rowp + bj * HALF) = w;
                }
            }
    }
};
struct EpiDown {
    static constexpr bool PERM = false, AFTER_DRAIN = false;
    float* out; const u16* x1h;
    __device__ __forceinline__ void operator()(const f32x4 (&acc)[2][2][4][2], const Unit& u, int wr, int wc, int fr, int fq) const {
        const int col0 = u.pn * BM + wc * 32 + 4 * fq;
        constexpr float DS = 1.0f / (HID_SCALE * W2_SCALE);
#pragma unroll
        for (int ai = 0; ai < 2; ++ai) {
            u32x2 xr[4][2][2];
#pragma unroll
            for (int m = 0; m < 4; ++m) {
                const size_t off = (size_t)(u.pm * BM + ai * HALF + wr * 64 + m * 16 + fr) * DM + col0;
#pragma unroll
                for (int bj = 0; bj < 2; ++bj)
#pragma unroll
                    for (int n = 0; n < 2; ++n) xr[m][bj][n] = *(const u32x2*)(x1h + off + bj * HALF + n * 16);
            }
#pragma unroll
            for (int m = 0; m < 4; ++m) {
                const size_t off = (size_t)(u.pm * BM + ai * HALF + wr * 64 + m * 16 + fr) * DM + col0;
#pragma unroll
                for (int bj = 0; bj < 2; ++bj)
#pragma unroll
                    for (int n = 0; n < 2; ++n) {
                        const h16x4 r = __builtin_bit_cast(h16x4, xr[m][bj][n]);
                        f32x4 o = acc[ai][bj][m][n]; o[0] = o[0] * DS + (float)r[0]; o[1] = o[1] * DS + (float)r[1]; o[2] = o[2] * DS + (float)r[2]; o[3] = o[3] * DS + (float)r[3];
                        *(f32x4*)(out + off + bj * HALF + n * 16) = o;
                    }
            }
        }
    }
};
struct EpiInProj {
    static constexpr bool PERM = true, AFTER_DRAIN = false;
    unsigned char* ws; const float* qg; const float* kg;
    __device__ __forceinline__ void operator()(const f32x4 (&acc)[2][2][4][2], const Unit& u, int wr, int wc, int fr, int fq) const {
        const int pn = u.pn;
        const bool normed = (pn < 2) || (pn < 5 && wc < 2);
        float gn[2][8];
        if (normed) {
            const float* gp = pn < 2 ? qg : kg;
#pragma unroll
            for (int bj = 0; bj < 2; ++bj) { const f32x4 a = *(const f32x4*)(gp + 32 * bj + 8 * fq), b = *(const f32x4*)(gp + 32 * bj + 8 * fq + 4);
#pragma unroll
                for (int e = 0; e < 4; ++e) { gn[bj][e] = a[e]; gn[bj][4 + e] = b[e]; } }
        }
        float lbv[2][8];
        if (pn == 7 || pn == 8) {
            const float* lp = (const float*)(ws + WS_LB) + 256 * (pn - 7) + 64 * wc + 8 * fq;
#pragma unroll
            for (int bj = 0; bj < 2; ++bj) { const f32x4 a = *(const f32x4*)(lp + 32 * bj), b = *(const f32x4*)(lp + 32 * bj + 4);
#pragma unroll
                for (int e = 0; e < 4; ++e) { lbv[bj][e] = a[e]; lbv[bj][4 + e] = b[e]; } }
        }
#pragma unroll
        for (int ai = 0; ai < 2; ++ai) {
            f32x4 rpv[4][4];
#pragma unroll
            for (int m = 0; m < 4; ++m) {
                if (normed && (m & 1) == 0) {
#pragma unroll
                    for (int mm = m; mm < m + 2; ++mm) { const int t_ = (u.pm * BM + ai * HALF + wr * 64 + mm * 16 + fr) & (SEQ - 1); const f32x4* rp_ = (const f32x4*)((const float*)(ws + WS_ROPE) + (size_t)t_ * 16);
#pragma unroll
                        for (int q4 = 0; q4 < 4; ++q4) rpv[mm][q4] = rp_[q4]; }
                }
                const int row = u.pm * BM + ai * HALF + wr * 64 + m * 16 + fr;
                const int b = row >> 13, t = row & (SEQ - 1);
                float v[2][8];
#pragma unroll
                for (int bj = 0; bj < 2; ++bj)
#pragma unroll
                    for (int e = 0; e < 4; ++e) { v[bj][e] = acc[ai][bj][m][0][e]; v[bj][4 + e] = acc[ai][bj][m][1][e]; }
                if (normed) {
                    float ss = 0.f;
#pragma unroll
                    for (int bj = 0; bj < 2; ++bj)
#pragma unroll
                        for (int e = 0; e < 8; ++e) ss += v[bj][e] * v[bj][e];
                    ss += __shfl_xor(ss, 16); ss += __shfl_xor(ss, 32);
                    const float rstd = 1.0f / sqrtf(ss * (1.0f / 64.f) + EPS);
#pragma unroll
                    for (int bj = 0; bj < 2; ++bj)
#pragma unroll
                        for (int e = 0; e < 8; ++e) v[bj][e] = v[bj][e] * rstd * gn[bj][e];
                    const f32x4 r0 = rpv[m][0], r1 = rpv[m][1], r2 = rpv[m][2], r3 = rpv[m][3];
                    const float cs[8] = {r0[0], r0[2], r1[0], r1[2], r2[0], r2[2], r3[0], r3[2]};
                    const float sn[8] = {r0[1], r0[3], r1[1], r1[3], r2[1], r2[3], r3[1], r3[3]};
#pragma unroll
                    for (int e = 0; e < 8; ++e) {
                        const float other = __shfl_xor(v[0][e], 16);
                        const float r1v = v[0][e] * cs[e] - other * sn[e];
                        const float r2v = v[0][e] * cs[e] + other * sn[e];
                        v[0][e] = fq == 0 ? r1v : (fq == 1 ? r2v : v[0][e]);
                    }
                    const float sc = pn < 2 ? 0.125f * 1.4426950408889634f : 1.0f;
                    u16* dst;
                    if (pn < 2) dst = (u16*)(ws + WS_Q) + (size_t)row * 512 + (4 * pn + wc) * 64 + 8 * fq;
                    else dst = (u16*)(ws + (pn == 2 ? WS_KC : pn == 3 ? WS_KS : WS_KW)) + ((size_t)(b * NG + wc) * SEQ + t) * 64 + 8 * fq;
#pragma unroll
                    for (int bj = 0; bj < 2; ++bj) {
                        u32x4 w; w.x = pkh(v[bj][0] * sc, v[bj][1] * sc); w.y = pkh(v[bj][2] * sc, v[bj][3] * sc); w.z = pkh(v[bj][4] * sc, v[bj][5] * sc); w.w = pkh(v[bj][6] * sc, v[bj][7] * sc);
                        *(u32x4*)(dst + 32 * bj) = w;
                    }
                } else if (pn < 5) {
                    const int g = wc - 2;
                    if (pn == 2) {
                        u16* dst = (u16*)(ws + WS_VC) + ((size_t)(b * NG + g) * SEQ + t) * 64 + 8 * fq;
#pragma unroll
                        for (int bj = 0; bj < 2; ++bj) {
                            u32x4 w; w.x = pkh(v[bj][0], v[bj][1]); w.y = pkh(v[bj][2], v[bj][3]); w.z = pkh(v[bj][4], v[bj][5]); w.w = pkh(v[bj][6], v[bj][7]);
                            *(u32x4*)(dst + 32 * bj) = w;
                        }
                    } else {
                        u16* dst = (u16*)(ws + (pn == 3 ? WS_VST : WS_VWT)) + (((size_t)(b * NG + g) * 128 + (t >> 6)) * 64 + 8 * fq) * 64 + (t & 63);
#pragma unroll
                        for (int bj = 0; bj < 2; ++bj)
#pragma unroll
                            for (int e = 0; e < 8; ++e) dst[(32 * bj + e) * 64] = f2h(v[bj][e]);
                    }
                } else if (pn < 13) {
                    const int kind = (pn - 5) >> 1;
                    const int col = 256 * ((pn - 5) & 1) + 64 * wc + 8 * fq;
                    u16* dst = (u16*)(ws + (kind == 0 ? WS_HQ : kind == 1 ? WS_HLOGF : kind == 2 ? WS_HV : WS_HG)) + (size_t)row * 512 + col;
#pragma unroll
                    for (int bj = 0; bj < 2; ++bj) {
                        float o[8];
#pragma unroll
                        for (int e = 0; e < 8; ++e) {
                            const float x = v[bj][e];
                            if (kind == 0 || kind == 3) o[e] = x * sigmoid_f(x);
                            else if (kind == 1) { const float l = lbv[bj][e]; o[e] = __logf(l + (1.f - l) * sigmoid_f(x)); }
                            else o[e] = x;
                        }
                        u32x4 w;
                        if (kind == 0 || kind == 2) { w.x = pkb(o[0], o[1]); w.y = pkb(o[2], o[3]); w.z = pkb(o[4], o[5]); w.w = pkb(o[6], o[7]); }
                        else { w.x = pkh(o[0], o[1]); w.y = pkh(o[2], o[3]); w.z = pkh(o[4], o[5]); w.w = pkh(o[6], o[7]); }
                        *(u32x4*)(dst + 32 * bj) = w;
                    }
                } else {
                    if (wc == 0 && fq < 3) {
                        float* dst = (float*)(ws + WS_GATES) + (size_t)row * 24 + 8 * fq;
                        f32x4 a, c;
#pragma unroll
                        for (int e = 0; e < 4; ++e) { a[e] = sigmoid_f(v[0][e]); c[e] = sigmoid_f(v[0][4 + e]); }
                        *(f32x4*)dst = a; *(f32x4*)(dst + 4) = c;
                    }
                }
            }
        }
    }
};
template <class Epi, class Sched, bool ALIGN_EPI = false, bool SP2 = false, bool MX8 = false>
__device__ __forceinline__ void gemm_phase(PG8_LAS unsigned char* lds, const Gemm g, const Sched& S, const Epi& E, int wave_in) {
    const int tid = threadIdx.x, wid = __builtin_amdgcn_readfirstlane(tid >> 6), lane = tid & 63, wr = wid >> 2, wc = wid & 3, fr = lane & 15, fq = lane >> 4;
    const int K = g.K, nt = K / BK;
    unsigned voffA[2], voffB[2];
#pragma unroll
    for (int i = 0; i < 2; ++i) { int R, C; stage_rc(tid * 16 + i * 8192, R, C); const int Rb = Epi::PERM ? ((R & ~31) + perm32(R & 31)) : R;
        voffA[i] = (unsigned)(R * K + C) * 2u; voffB[i] = (unsigned)(Rb * K + C) * 2u; }
    const size_t kstep = (size_t)(BK * 2);
    const size_t hstep = (size_t)HALF * K * 2;
    const size_t tstep = 2 * hstep;
    const unsigned ldsw = (unsigned)wid * 1024u;
    const int aoff = lds_byte(wr * 64 + fr, fq * 8), boff = lds_byte(wc * 32 + fr, fq * 8);
#define PG8_SA(b, h) (((b) * 2 + (h)) * HTB)
#define PG8_SB(b, h) ((4 + (b) * 2 + (h)) * HTB)
#define PG8_STAGE(bufoff, gbase, voff) do { _Pragma("unroll") for (int _i = 0; _i < 2; ++_i) \
        __builtin_amdgcn_global_load_lds((const unsigned*)((const char*)(gbase) + (voff)[_i]), (PG8_LAS unsigned*)(lds + (bufoff) + ldsw + _i * 8192), 16, 0, 0); } while (0)
#define PG8_LDA(dst, b, h) do { _Pragma("unroll") for (int m = 0; m < 4; ++m) _Pragma("unroll") for (int k = 0; k < 2; ++k) dst[m][k] = *(const PG8_LAS bf16x8*)(lds + PG8_SA(b, h) + aoff + m * 2048 + k * 1024); } while (0)
#define PG8_LDB(dst, b, h) do { _Pragma("unroll") for (int n = 0; n < 2; ++n) _Pragma("unroll") for (int k = 0; k < 2; ++k) dst[n][k] = *(const PG8_LAS bf16x8*)(lds + PG8_SB(b, h) + boff + n * 2048 + k * 1024); } while (0)
#define PG8_CAT(x0, x1) __builtin_shufflevector(__builtin_bit_cast(i32x4, (x0)), __builtin_bit_cast(i32x4, (x1)), 0, 1, 2, 3, 4, 5, 6, 7)
#define PG8_MMA(ai, bj, At, Bt) do { __builtin_amdgcn_s_setprio(1); _Pragma("unroll") for (int m = 0; m < 4; ++m) _Pragma("unroll") for (int n = 0; n < 2; ++n) { \
        if constexpr (MX8) asm volatile("v_mfma_scale_f32_16x16x128_f8f6f4 %0, %1, %2, %0, %3, %3 op_sel_hi:[0,0,0]" : "+v"(acc[ai][bj][m][n]) : "v"(PG8_CAT(Bt[n][0], Bt[n][1])), "v"(PG8_CAT(At[m][0], At[m][1])), "v"(mxs)); \
        else { _Pragma("unroll") for (int k = 0; k < 2; ++k) acc[ai][bj][m][n] = PG8_MFMA(Bt[n][k], At[m][k], acc[ai][bj][m][n]); } } __builtin_amdgcn_s_setprio(0); } while (0)
#define PG8_WAIT_V(n) asm volatile("s_waitcnt vmcnt(" #n ")" ::: "memory")
#define PG8_WAIT_L(n) asm volatile("s_waitcnt lgkmcnt(" #n ")" ::: "memory")
#define PG8_BAR __builtin_amdgcn_s_barrier()
#define PG8_SCHED __builtin_amdgcn_sched_barrier(0)
    const int mxs = 0x7F7F7F7F;
    Unit cur, nxt; int ui = 0;
    if (!S.next(0, cur)) return;
    f32x4 acc[2][2][4][2];
#pragma unroll
    for (int a = 0; a < 2; ++a)
#pragma unroll
        for (int b = 0; b < 2; ++b)
#pragma unroll
            for (int m = 0; m < 4; ++m)
#pragma unroll
                for (int n = 0; n < 2; ++n) acc[a][b][m][n] = (f32x4){0.f, 0.f, 0.f, 0.f};
    bf16x8 At[4][2], B0[2][2], B1[2][2];
    const char* cA = (const char*)g.A + (size_t)cur.pm * tstep; const char* cB = (const char*)g.Bt + (size_t)cur.pn * tstep;
    S.a_ready(cur);
    if constexpr (SP2) {
        PG8_STAGE(PG8_SB(0, 0), cB, voffB); PG8_STAGE(PG8_SB(0, 1), cB + hstep, voffB); PG8_STAGE(PG8_SA(0, 0), cA, voffA); PG8_STAGE(PG8_SA(0, 1), cA + hstep, voffA);
        if (wr == 1) PG8_BAR;
        PG8_WAIT_V(2); PG8_BAR;
        PG8_STAGE(PG8_SB(1, 0), cB + kstep, voffB); PG8_STAGE(PG8_SA(1, 0), cA + kstep, voffA); PG8_STAGE(PG8_SB(1, 1), cB + hstep + kstep, voffB);
        PG8_WAIT_V(6); PG8_BAR;
    } else {
        PG8_STAGE(PG8_SB(0, 0), cB, voffB); PG8_STAGE(PG8_SA(0, 0), cA, voffA); PG8_STAGE(PG8_SB(0, 1), cB + hstep, voffB); PG8_STAGE(PG8_SA(0, 1), cA + hstep, voffA);
        if (wr == 1) PG8_BAR;
        PG8_WAIT_V(4); PG8_BAR;
        PG8_STAGE(PG8_SB(1, 0), cB + kstep, voffB); PG8_STAGE(PG8_SA(1, 0), cA + kstep, voffA); PG8_STAGE(PG8_SB(1, 1), cB + hstep + kstep, voffB);
        PG8_WAIT_V(6); PG8_BAR;
    }
    for (;;) {
        const bool has_next = S.next(ui + 1, nxt);
        const char* nA = has_next ? (const char*)g.A + (size_t)nxt.pm * tstep : cA; const char* nB = has_next ? (const char*)g.Bt + (size_t)nxt.pn * tstep : cB;
        for (int t = 0; t < nt; t += 2) {
            const bool last = (t == nt - 2);
            const char* a1 = cA + (size_t)(t + 1) * kstep;
            const char* a2 = last ? nA : cA + (size_t)(t + 2) * kstep; const char* b2 = last ? nB : cB + (size_t)(t + 2) * kstep;
            const char* a3 = a2 + kstep; const char* b3 = b2 + kstep;
            if (last && has_next) S.a_ready(nxt);
            if constexpr (SP2) {
            PG8_LDB(B0, 0, 0); PG8_LDB(B1, 0, 1); PG8_SCHED; PG8_LDA(At, 0, 0); PG8_STAGE(PG8_SA(1, 1), a1 + hstep, voffA);
            PG8_WAIT_V(8); PG8_WAIT_L(0); PG8_BAR; PG8_MMA(0, 0, At, B0); PG8_MMA(0, 1, At, B1); PG8_BAR; PG8_SCHED;
            PG8_LDA(At, 0, 1); PG8_STAGE(PG8_SB(0, 0), b2, voffB); PG8_STAGE(PG8_SB(0, 1), b2 + hstep, voffB); PG8_STAGE(PG8_SA(0, 0), a2, voffA);
            PG8_WAIT_V(8); PG8_WAIT_L(0); PG8_BAR; PG8_MMA(1, 0, At, B0); PG8_MMA(1, 1, At, B1); PG8_BAR; PG8_SCHED;
            PG8_LDB(B0, 1, 0); PG8_LDB(B1, 1, 1); PG8_SCHED; PG8_LDA(At, 1, 0); PG8_STAGE(PG8_SA(0, 1), a2 + hstep, voffA);
            PG8_WAIT_V(8); PG8_WAIT_L(0); PG8_BAR; PG8_MMA(0, 0, At, B0); PG8_MMA(0, 1, At, B1); PG8_BAR; PG8_SCHED;
            PG8_LDA(At, 1, 1); PG8_STAGE(PG8_SB(1, 0), b3, voffB); PG8_STAGE(PG8_SB(1, 1), b3 + hstep, voffB); PG8_STAGE(PG8_SA(1, 0), a3, voffA);
            PG8_WAIT_V(8); PG8_WAIT_L(0); PG8_BAR; PG8_MMA(1, 0, At, B0); PG8_MMA(1, 1, At, B1); PG8_BAR; PG8_SCHED;
            } else {
            PG8_LDB(B0, 0, 0); PG8_SCHED; PG8_LDA(At, 0, 0); PG8_STAGE(PG8_SA(1, 1), a1 + hstep, voffA);
            PG8_WAIT_L(8); PG8_BAR; PG8_WAIT_L(0); PG8_MMA(0, 0, At, B0); PG8_BAR; PG8_SCHED;
            PG8_LDB(B1, 0, 1); PG8_STAGE(PG8_SB(0, 0), b2, voffB);
            PG8_BAR; PG8_WAIT_L(0); PG8_MMA(0, 1, At, B1); PG8_BAR;
            PG8_LDA(At, 0, 1); PG8_STAGE(PG8_SA(0, 0), a2, voffA);
            PG8_BAR; PG8_WAIT_L(0); PG8_MMA(1, 0, At, B0); PG8_BAR; PG8_SCHED;
            PG8_STAGE(PG8_SB(0, 1), b2 + hstep, voffB);
            PG8_WAIT_V(6); PG8_BAR; PG8_MMA(1, 1, At, B1); PG8_BAR;
            PG8_LDB(B0, 1, 0); PG8_SCHED; PG8_LDA(At, 1, 0); PG8_STAGE(PG8_SA(0, 1), a2 + hstep, voffA);
            PG8_WAIT_L(8); PG8_BAR; PG8_WAIT_L(0); PG8_MMA(0, 0, At, B0); PG8_BAR; PG8_SCHED;
            PG8_LDB(B1, 1, 1); PG8_STAGE(PG8_SB(1, 0), b3, voffB);
            PG8_BAR; PG8_WAIT_L(0); PG8_MMA(0, 1, At, B1); PG8_BAR;
            PG8_LDA(At, 1, 1); PG8_STAGE(PG8_SA(1, 0), a3, voffA);
            PG8_BAR; PG8_WAIT_L(0); PG8_MMA(1, 0, At, B0); PG8_BAR; PG8_SCHED;
            PG8_STAGE(PG8_SB(1, 1), b3 + hstep, voffB);
            PG8_WAIT_V(6); PG8_BAR; PG8_MMA(1, 1, At, B1); PG8_BAR;
            }
        }
        if constexpr (MX8) asm volatile("s_nop 15\n\ts_nop 15" ::: "memory");
        if constexpr (ALIGN_EPI) { if (wr == 0) PG8_BAR; }
        if constexpr (!Epi::AFTER_DRAIN) { E(acc, cur, wr, wc, fr, fq); S.done(cur); }
        if (!has_next) break;
#pragma unroll
        for (int a = 0; a < 2; ++a)
#pragma unroll
            for (int b = 0; b < 2; ++b)
#pragma unroll
                for (int m = 0; m < 4; ++m)
#pragma unroll
                    for (int n = 0; n < 2; ++n) acc[a][b][m][n] = (f32x4){0.f, 0.f, 0.f, 0.f};
        cur = nxt; cA = nA; cB = nB; ++ui;
        if constexpr (ALIGN_EPI) { if (wr == 1) PG8_BAR; }
    }
    PG8_WAIT_V(0);
    if constexpr (!ALIGN_EPI) { if (wr == 0) PG8_BAR; }
    PG8_BAR;
    if constexpr (Epi::AFTER_DRAIN) { E.fused(acc, cur, wr, wc, fr, fq, lds, wid, lane); S.done(cur); }
#undef PG8_SA
#undef PG8_SB
#undef PG8_STAGE
#undef PG8_LDA
#undef PG8_LDB
#undef PG8_MMA
#undef PG8_CAT
#undef PG8_WAIT_V
#undef PG8_WAIT_L
#undef PG8_BAR
#undef PG8_SCHED
}
}
#define LDS_WAIT() asm volatile("s_waitcnt lgkmcnt(0)" ::: "memory")
#define VM_WAIT() asm volatile("s_waitcnt vmcnt(0)" ::: "memory")

struct Params {
    const float* in[18];
    float* out;
    unsigned char* ws;
    float invf[8];
    int ph_lo, ph_hi;
};

__device__ __forceinline__ void sincos_acc(float ang, float& s, float& c) {
    const double x = (double)ang;
    const double k = rint(x * 0.6366197723675814);
    double r = fma(-k, 1.5707963267948966, x); r = fma(-k, 6.123233995736766e-17, r);
    const int q = ((int)k) & 3;
    const double r2 = r * r;
    const double sp = r * (1.0 + r2 * (-1.0 / 6 + r2 * (1.0 / 120 + r2 * (-1.0 / 5040 + r2 * (1.0 / 362880 + r2 * (-1.0 / 39916800 + r2 * (1.0 / 6227020800.0)))))));
    const double cp = 1.0 + r2 * (-0.5 + r2 * (1.0 / 24 + r2 * (-1.0 / 720 + r2 * (1.0 / 40320 + r2 * (-1.0 / 3628800 + r2 * (1.0 / 479001600.0 + r2 * (-1.0 / 87178291200.0)))))));
    double ss, cc;
    if (q == 0) { ss = sp; cc = cp; } else if (q == 1) { ss = cp; cc = -sp; } else if (q == 2) { ss = -sp; cc = -cp; } else { ss = -cp; cc = sp; }
    s = (float)ss; c = (float)cc;
}

struct ColId { __device__ __forceinline__ int operator()(int n) const { return n; } };
struct ColWin {
    __device__ __forceinline__ int operator()(int P) const {
        const int pn = P >> 8, p = P & 255, bj = p >> 7, wc = (p >> 5) & 3, j = p & 31;
        const int Lp = 256 * pn + 64 * wc + 32 * bj + j;
        return Lp < 1280 ? Lp : (Lp < 3328 ? Lp + 24 : (Lp < 3352 ? Lp - 3328 + 1280 : -1));
    }
};
template <class SrcCol, bool F8 = false>
__device__ __forceinline__ void p0_transpose_item(const float* __restrict__ W, int K, int Nsrc, u16* WT, const float* rowscale, SrcCol sc, LAS float* scr, int kb, int nb, int lane) {
    const int k0 = 64 * kb, n0 = 32 * nb;
    const int scol = sc(n0 + (lane & 31));
#pragma unroll
    for (int i = 0; i < 32; ++i) {
        const int kk = 2 * i + (lane >> 5);
        float v = scol >= 0 ? W[(size_t)(k0 + kk) * Nsrc + scol] : 0.f;
        if (rowscale) v *= rowscale[k0 + kk];
        scr[kk * 33 + (lane & 31)] = v;
    }
    LDS_WAIT(); asm volatile("" ::: "memory");
    const int c = lane & 7;
#pragma unroll
    for (int j = 0; j < 4; ++j) {
        const int n = (lane >> 3) + 8 * j; const LAS float* s = scr + (8 * c) * 33 + n;
        if constexpr (F8) {
            u32x2 o; o.x = pkf8x4(clamp8(s[0 * 33] * W2_SCALE), clamp8(s[1 * 33] * W2_SCALE), clamp8(s[2 * 33] * W2_SCALE), clamp8(s[3 * 33] * W2_SCALE));
            o.y = pkf8x4(clamp8(s[4 * 33] * W2_SCALE), clamp8(s[5 * 33] * W2_SCALE), clamp8(s[6 * 33] * W2_SCALE), clamp8(s[7 * 33] * W2_SCALE));
            *(u32x2*)((unsigned char*)WT + (size_t)(n0 + n) * K + k0 + 8 * c) = o;
        } else {
        u32x4 o; o.x = pkh(s[0 * 33], s[1 * 33]); o.y = pkh(s[2 * 33], s[3 * 33]); o.z = pkh(s[4 * 33], s[5 * 33]); o.w = pkh(s[6 * 33], s[7 * 33]);
        *(u32x4*)(WT + (size_t)(n0 + n) * K + k0 + 8 * c) = o;
        }
    }
    LDS_WAIT(); asm volatile("" ::: "memory");
}

__device__ __forceinline__ void p0_late_transposes(const Params& p, LAS unsigned char* lds, int gw, int NGW, int wave, int lane) {
    unsigned char* ws = p.ws;
    LAS float* scr = (LAS float*)(lds + wave * 16384);
    constexpr int I_WOUT = 16 * 32, I_W1 = 16 * (FF / 32), I_W2 = (FF / 64) * 32, I_C1 = 32 * 4, I_C2 = 2 * 2;
    constexpr int NITEMS = I_WOUT + I_W1 + I_W2 + 2 * I_C1 + 2 * I_C2;
    for (int it = gw; it < NITEMS; it += NGW) {
        int r = it;
        if (r < I_C1) { p0_transpose_item(p.in[6], 2048, 128, (u16*)(ws + WS_CW1K_T), nullptr, ColId(), scr, r / 4, r % 4, lane); continue; } r -= I_C1;
        if (r < I_C1) { p0_transpose_item(p.in[9], 2048, 128, (u16*)(ws + WS_CW1V_T), nullptr, ColId(), scr, r / 4, r % 4, lane); continue; } r -= I_C1;
        if (r < I_C2) { p0_transpose_item(p.in[7], 128, 64, (u16*)(ws + WS_CW2K_T), nullptr, ColId(), scr, r / 2, r % 2, lane); continue; } r -= I_C2;
        if (r < I_C2) { p0_transpose_item(p.in[10], 128, 64, (u16*)(ws + WS_CW2V_T), nullptr, ColId(), scr, r / 2, r % 2, lane); continue; } r -= I_C2;
        if (r < I_WOUT) { p0_transpose_item(p.in[14], DM, DM, (u16*)(ws + WS_WOUT_T), nullptr, ColId(), scr, r / 32, r % 32, lane); continue; } r -= I_WOUT;
        if (r < I_W1) { p0_transpose_item(p.in[16], DM, FF, (u16*)(ws + WS_W1_T), p.in[15], ColId(), scr, r / (FF / 32), r % (FF / 32), lane); continue; } r -= I_W1;
        p0_transpose_item<ColId, true>(p.in[17], FF, DM, (u16*)(ws + WS_W2_T), nullptr, ColId(), scr, r / 32, r % 32, lane);
    }
}
__device__ __forceinline__ void p0_prologue(const Params& p, LAS unsigned char* lds, int gw, int NGW, int wave, int lane) {
    unsigned char* ws = p.ws;
    LAS float* scr = (LAS float*)(lds + wave * 16384);
    constexpr int I_WIN = 16 * (DINP / 32);
    for (int it = gw; it < I_WIN; it += NGW) p0_transpose_item(p.in[2], DM, DIN, (u16*)(ws + WS_WIN_T), nullptr, ColWin(), scr, it / (DINP / 32), it % (DINP / 32), lane);
    {
        const float* gn = p.in[1];
        f32x4 gv[4];
#pragma unroll
        for (int j = 0; j < 4; ++j) gv[j] = ((const f32x4*)gn)[lane + 64 * j];
        for (int m = gw; m < MT; m += 4 * NGW) {
            f32x4 v[4][4]; float s[4];
#pragma unroll
            for (int r = 0; r < 4; ++r) {
                const int mr = m + r * NGW; const f32x4* xr = (const f32x4*)(p.in[0] + (size_t)(mr < MT ? mr : m) * DM) + lane;
#pragma unroll
                for (int j = 0; j < 4; ++j) v[r][j] = __builtin_nontemporal_load(xr + 64 * j);
            }
#pragma unroll
            for (int r = 0; r < 4; ++r) {
                float a = 0.f;
#pragma unroll
                for (int j = 0; j < 4; ++j) a += (v[r][j][0] * v[r][j][0] + v[r][j][1] * v[r][j][1]) + (v[r][j][2] * v[r][j][2] + v[r][j][3] * v[r][j][3]);
                s[r] = a;
            }
#pragma unroll
            for (int o = 1; o < 64; o <<= 1) {
#pragma unroll
                for (int r = 0; r < 4; ++r) s[r] += __shfl_xor(s[r], o);
            }
#pragma unroll
            for (int r = 0; r < 4; ++r) {
                const int mr = m + r * NGW;
                if (mr < MT) {
                    const float rstd = 1.0f / sqrtf(s[r] * (1.f / DM) + EPS);
                    u32x2* o8 = (u32x2*)((u16*)(ws + WS_XH) + (size_t)mr * DM) + lane;
#pragma unroll
                    for (int j = 0; j < 4; ++j) { u32x2 ww; ww.x = pkh(v[r][j][0] * rstd * gv[j][0], v[r][j][1] * rstd * gv[j][1]); ww.y = pkh(v[r][j][2] * rstd * gv[j][2], v[r][j][3] * rstd * gv[j][3]); o8[64 * j] = ww; }
                }
            }
        }
    }
    const int gt = gw * 64 + lane, NGT = NGW * 64;
    for (int i = gt; i < SEQ * 8; i += NGT) {
        const int pos = i >> 3, f = i & 7; float s, c; sincos_acc((float)pos * p.invf[f], s, c);
        ((f32x2*)(ws + WS_ROPE))[i] = (f32x2){c, s};
    }
    for (int i = gt; i < 512; i += NGT) {
        const float a = p.in[12][i], c = p.in[12][512 + i]; const float m = fmaxf(a, c); const float ea = expf(a - m), ec = expf(c - m);
        ((float*)(ws + WS_LB))[i] = ea / (ea + ec);
    }
    for (int i = gt; i < 2048; i += NGT) { ((u16*)(ws + WS_PEK))[i] = f2h(p.in[5][i]); ((u16*)(ws + WS_PEV))[i] = f2h(p.in[8][i]); }
}

#define XB_TMO      128
#define XB_XCNT(j)  (256  + 64 * (j))
#define XB_XSUB(j)  (1280 + 64 * (j))
#define XB_XGEN(j)  (2304 + 64 * (j))
#define XB_TOP      3328
#define XB_TOPGEN   3392
#define XCD_BAR_WORDS 3456
#define XB_SPIN_CAP (1u << 18)

__device__ __forceinline__ unsigned xb_ld(unsigned* p)              { return __hip_atomic_load(p, __ATOMIC_RELAXED, __HIP_MEMORY_SCOPE_AGENT); }
__device__ __forceinline__ unsigned xb_add(unsigned* p, unsigned v) { return __hip_atomic_fetch_add(p, v, __ATOMIC_RELAXED, __HIP_MEMORY_SCOPE_AGENT); }
__device__ __forceinline__ unsigned xb_xcc_id() { return (unsigned)__builtin_amdgcn_s_getreg((3 << 11) | 20) & 0xFu; }
#define XB_SPIN(cond, bar) do { unsigned _sp = 0; while (cond) { __builtin_amdgcn_s_sleep(1); \
    if ((++_sp & 255u) == 0u) { if (xb_ld(&(bar)[XB_TMO])) break; if (_sp > XB_SPIN_CAP) { atomicAdd(&(bar)[XB_TMO], 1u); break; } } } } while (0)

struct XcdBarrier {
    unsigned* bar; unsigned x;
    volatile LAS unsigned* st;
};

__device__ __forceinline__ XcdBarrier xcd_barrier_post(unsigned* bar, volatile LAS unsigned* st) {
    XcdBarrier b; b.bar = bar; b.x = xb_xcc_id(); b.st = st;
    if (threadIdx.x == 0) (void)xb_add(&bar[XB_XCNT(b.x)], 1u);
    return b;
}
__device__ __forceinline__ void xcd_barrier_complete(unsigned* bar, unsigned x, unsigned& nloc, unsigned& nx) {
    const unsigned G = gridDim.x * gridDim.y * gridDim.z;
    unsigned sum, cnt, mine, sp = 0u;
    for (;;) {
        sum = 0u; cnt = 0u; mine = 0u;
#pragma unroll
        for (unsigned j = 0; j < 16; ++j) { const unsigned c = xb_ld(&bar[XB_XCNT(j)]); sum += c; cnt += (c > 0u) ? 1u : 0u; mine = (j == x) ? c : mine; }
        if (sum == G) break;
        __builtin_amdgcn_s_sleep(1);
        if ((++sp & 255u) == 0u) { if (xb_ld(&bar[XB_TMO])) break; if (sp > XB_SPIN_CAP) { atomicAdd(&bar[XB_TMO], 1u); break; } }
    }
    nloc = mine > 0u ? mine : 1u; nx = cnt > 0u ? cnt : 1u;
}

__device__ __forceinline__ void xcd_barrier(const XcdBarrier& b) {
    asm volatile("s_waitcnt vmcnt(0)" ::: "memory");
    __syncthreads();
    if (threadIdx.x == 0) {
        unsigned* bar = b.bar;
        __builtin_amdgcn_s_waitcnt(0);
        unsigned nloc = b.st[0], nx = b.st[1];
        if (nloc == 0u) { xcd_barrier_complete(bar, b.x, nloc, nx); b.st[0] = nloc; b.st[1] = nx; }
        const unsigned old = xb_add(&bar[XB_XSUB(b.x)], 1u);
        const unsigned gen = old / nloc;
        if (old + 1u == (gen + 1u) * nloc) {
            __builtin_amdgcn_fence(__ATOMIC_RELEASE, "agent");
            asm volatile("s_waitcnt vmcnt(0)" ::: "memory");
            const unsigned og = xb_add(&bar[XB_TOP], 1u);
            const unsigned tg = og / nx;
            if (og + 1u == (tg + 1u) * nx) xb_add(&bar[XB_TOPGEN], 1u);
            else XB_SPIN(xb_ld(&bar[XB_TOPGEN]) == tg, bar);
            __builtin_amdgcn_fence(__ATOMIC_ACQUIRE, "agent");
            xb_add(&bar[XB_XGEN(b.x)], 1u);
            asm volatile("s_waitcnt vmcnt(0)" ::: "memory");
        } else {
            XB_SPIN(xb_ld(&bar[XB_XGEN(b.x)]) == gen, bar);
            __builtin_amdgcn_fence(__ATOMIC_ACQUIRE, "agent");
            asm volatile("s_waitcnt vmcnt(0)" ::: "memory");
        }
    }
    __syncthreads();
}

constexpr float LOG2E = 1.4426950408889634f;
constexpr float OFF2 = 4.0f * LOG2E;
constexpr int AT_PITCH = 144;
constexpr int AT_TILE = 64 * AT_PITCH;
constexpr int AT_LDS = 4 * AT_TILE;
#define MFMA32H(a, b, c) __builtin_amdgcn_mfma_f32_32x32x16_f16((a), (b), (c), 0, 0, 0)
#define MFMA16H(a, b, c) __builtin_amdgcn_mfma_f32_16x16x32_f16((a), (b), (c), 0, 0, 0)
#define MFMA32B(a, b, c) __builtin_amdgcn_mfma_f32_32x32x16_bf16((a), (b), (c), 0, 0, 0)

#define AT_BAR() do { asm volatile("s_waitcnt lgkmcnt(0)" ::: "memory"); __builtin_amdgcn_s_barrier(); asm volatile("" ::: "memory"); } while (0)
template <int MODE>
__device__ __forceinline__ void attn_tiles(LAS unsigned char* lds, const u16* __restrict__ Kbg, const u16* __restrict__ VTbg, const h16x8 (&qf)[4], int qt, int j0, int qh, int wave, int lane,
                                           unsigned sw0, unsigned sw1, unsigned sw2, unsigned sw3, f32x16 (&o)[2], float& lsum) {
    const int tid = threadIdx.x, r32 = lane & 31, hi = lane >> 5;
    const int srow = tid >> 3, sch = tid & 7;
    const u16* ksrc = Kbg + (size_t)srow * 64 + 8 * sch;
    const u16* vsrc = VTbg + (size_t)srow * 64 + 8 * sch;
    const int sdst = srow * AT_PITCH + sch * 16;
    const int prow = (r32 & 0x13) | ((r32 & 8) >> 1) | ((r32 & 4) << 1);
    const int koff = prow * AT_PITCH + hi * 16;
    const int voff = r32 * AT_PITCH + hi * 16;
    const int qrel = 32 * qh + r32;
    u32x4 kA = *(const u32x4*)(ksrc + (size_t)j0 * 4096), vA = *(const u32x4*)(vsrc + (size_t)j0 * 4096);
    u32x4 kB = kA, vB = vA;
    if (j0 + 1 <= qt) { kB = *(const u32x4*)(ksrc + (size_t)(j0 + 1) * 4096); vB = *(const u32x4*)(vsrc + (size_t)(j0 + 1) * 4096); }
    *(LAS u32x4*)(lds + sdst) = kA; *(LAS u32x4*)(lds + 2 * AT_TILE + sdst) = vA;
    h16x8 qg0 = qf[0], qg1 = qf[1], qg2 = qf[2], qg3 = qf[3];
    asm volatile("" : "+v"(qg0), "+v"(qg1), "+v"(qg2), "+v"(qg3));
    const u32x4 onesw = {0x3c003c00u, 0x3c003c00u, 0x3c003c00u, 0x3c003c00u};
    f32x16 negoff;
#pragma unroll
    for (int i = 0; i < 16; ++i) negoff[i] = -OFF2;
    asm volatile("" : "+v"(negoff));
    f32x16 ol;
#pragma unroll
    for (int i = 0; i < 16; ++i) ol[i] = 0.f;
    AT_BAR();
    for (int j = j0; j <= qt; ++j) {
        const int buf = (j - j0) & 1;
        if (j + 2 <= qt) { kA = *(const u32x4*)(ksrc + (size_t)(j + 2) * 4096); vA = *(const u32x4*)(vsrc + (size_t)(j + 2) * 4096); }
        LAS unsigned char* kb = lds + buf * AT_TILE; LAS unsigned char* vb = lds + (2 + buf) * AT_TILE;
        bool sel = true;
        if (MODE == 1) { const unsigned w = j < 32 ? sw0 : (j < 64 ? sw1 : (j < 96 ? sw2 : sw3)); sel = (w >> (j & 31)) & 1u; }
        if (MODE == 0 || __any(sel)) {
            h16x8 kf[8];
#pragma unroll
            for (int kh = 0; kh < 2; ++kh)
#pragma unroll
                for (int d0 = 0; d0 < 4; ++d0) kf[kh * 4 + d0] = *(const LAS h16x8*)(kb + kh * 32 * AT_PITCH + koff + d0 * 32);
            __builtin_amdgcn_sched_barrier(0);
            f32x16 s[2];
#pragma unroll
            for (int kh = 0; kh < 2; ++kh) {
#pragma unroll
                for (int d0 = 0; d0 < 4; ++d0) s[kh] = MFMA32H(kf[kh * 4 + d0], (d0 == 0 ? qg0 : d0 == 1 ? qg1 : d0 == 2 ? qg2 : qg3), (d0 == 0 ? negoff : s[kh]));
            }
            h16x8 vfr[8];
#pragma unroll
            for (int dt = 0; dt < 2; ++dt)
#pragma unroll
                for (int kk = 0; kk < 4; ++kk) vfr[dt * 4 + kk] = *(const LAS h16x8*)(vb + dt * 32 * AT_PITCH + voff + kk * 32);
            __builtin_amdgcn_sched_barrier(0);
            const int dj = qt - j;
            const bool edge_hi = (dj == 0), edge_lo = (MODE == 0) && (dj == 8);
            u32x4 pw[2][2];
            if (edge_hi || edge_lo) {
#pragma unroll
                for (int kh = 0; kh < 2; ++kh)
#pragma unroll
                    for (int sp = 0; sp < 2; ++sp) {
                        float pv[8];
#pragma unroll
                        for (int e = 0; e < 8; ++e) {
                            const int kin = 32 * kh + 16 * sp + 8 * hi + e;
                            float pe = __builtin_amdgcn_exp2f(s[kh][8 * sp + e]);
                            if (edge_hi) pe = (kin <= qrel) ? pe : 0.f;
                            if (edge_lo) pe = (kin > qrel) ? pe : 0.f;
                            pv[e] = pe;
                        }
                        pw[kh][sp] = (u32x4){pkh(pv[0], pv[1]), pkh(pv[2], pv[3]), pkh(pv[4], pv[5]), pkh(pv[6], pv[7])};
                    }
            } else {
#pragma unroll
                for (int kh = 0; kh < 2; ++kh)
#pragma unroll
                    for (int sp = 0; sp < 2; ++sp) {
                        float pv[8];
#pragma unroll
                        for (int e = 0; e < 8; ++e) pv[e] = __builtin_amdgcn_exp2f(s[kh][8 * sp + e]);
                        pw[kh][sp] = (u32x4){pkh(pv[0], pv[1]), pkh(pv[2], pv[3]), pkh(pv[4], pv[5]), pkh(pv[6], pv[7])};
                    }
            }
            if (MODE == 1) {
                const unsigned mk = sel ? 0xffffffffu : 0u;
#pragma unroll
                for (int kh = 0; kh < 2; ++kh)
#pragma unroll
                    for (int sp = 0; sp < 2; ++sp) { pw[kh][sp].x &= mk; pw[kh][sp].y &= mk; pw[kh][sp].z &= mk; pw[kh][sp].w &= mk; }
            }
#pragma unroll
            for (int kh = 0; kh < 2; ++kh)
#pragma unroll
                for (int sp = 0; sp < 2; ++sp) {
                    const h16x8 pb = __builtin_bit_cast(h16x8, pw[kh][sp]);
#pragma unroll
                    for (int dt = 0; dt < 2; ++dt) o[dt] = MFMA32H(vfr[dt * 4 + 2 * kh + sp], pb, o[dt]);
                    ol = MFMA32H(__builtin_bit_cast(h16x8, onesw), pb, ol);
                }
        }
        if (j < qt) { *(LAS u32x4*)(lds + (buf ^ 1) * AT_TILE + sdst) = kB; *(LAS u32x4*)(lds + (2 + (buf ^ 1)) * AT_TILE + sdst) = vB; }
        kB = kA; vB = vA;
        AT_BAR();
    }
    lsum = 0.5f * ol[0];
}

__device__ __forceinline__ void win_unit(unsigned char* ws, LAS unsigned char* lds, int u, int wave, int lane) {
    const int qt = u & 127, bg = u >> 7, b = bg >> 1, g = bg & 1;
    const int h = wave >> 1, qh = wave & 1, r32 = lane & 31, hi = lane >> 5;
    const int t = 64 * qt + 32 * qh + r32;
    const size_t row = (size_t)b * SEQ + t;
    const u16* qp = (const u16*)(ws + WS_Q) + row * 512 + (4 * g + h) * 64 + 8 * hi;
    h16x8 qf[4];
#pragma unroll
    for (int d0 = 0; d0 < 4; ++d0) qf[d0] = *(const h16x8*)(qp + 16 * d0);
    f32x16 o[2]; float l = 0.f;
#pragma unroll
    for (int i = 0; i < 16; ++i) { o[0][i] = 0.f; o[1][i] = 0.f; }
    const int j0 = qt > 8 ? qt - 8 : 0;
    attn_tiles<0>(lds, (const u16*)(ws + WS_KW) + (size_t)bg * SEQ * 64, (const u16*)(ws + WS_VWT) + (size_t)bg * 64 * SEQ, qf, qt, j0, qh, wave, lane, 0u, 0u, 0u, 0u, o, l);
    l += __shfl_xor(l, 32);
    const float sc = ((const float*)(ws + WS_GATES))[row * 24 + (4 * g + h) * 3 + 2] / l;
    u16* dst = (u16*)(ws + WS_OWIN) + row * 512 + (4 * g + h) * 64 + 4 * hi;
#pragma unroll
    for (int dt = 0; dt < 2; ++dt)
#pragma unroll
        for (int r4 = 0; r4 < 4; ++r4) {
            u32x2 w; w.x = pkh(o[dt][4 * r4] * sc, o[dt][4 * r4 + 1] * sc); w.y = pkh(o[dt][4 * r4 + 2] * sc, o[dt][4 * r4 + 3] * sc);
            *(u32x2*)(dst + 32 * dt + 8 * r4) = w;
        }
}

constexpr int CM_SP = 132, CM_HP = 136;
__device__ __forceinline__ void cmp_mlp_unit(unsigned char* ws, LAS unsigned char* lds, int u, int wave, int lane) {
    const int mt = u & 31, bg = (u >> 5) & 3, kv = u >> 7;
    const int tid = threadIdx.x, r = lane & 15, quad = lane >> 4;
    LAS float* slab = (LAS float*)lds;
    LAS u16* hb = (LAS u16*)(lds + 8 * 16 * CM_SP * 4);
    const u16* src = (const u16*)(ws + (kv ? WS_VC : WS_KC)) + (size_t)bg * SEQ * 64;
    const u16* pe = (const u16*)(ws + (kv ? WS_PEV : WS_PEK));
    const u16* w1t = (const u16*)(ws + (kv ? WS_CW1V_T : WS_CW1K_T));
    const int n = 16 * mt + r;
    const int nc = n < NCMP ? n : NCMP - 1;
    const u16* arow = src + (size_t)nc * 1024 + 8 * quad;
    const u16* brow = w1t + (size_t)r * 2048 + 8 * quad;
    f32x4 acc[8];
#pragma unroll
    for (int c = 0; c < 8; ++c) acc[c] = (f32x4){0.f, 0.f, 0.f, 0.f};
    const int kbase = 256 * wave;
#pragma unroll 1
    for (int hf = 0; hf < 2; ++hf) {
#pragma unroll
        for (int st = 0; st < 4; ++st) {
            const int k0 = kbase + 32 * (4 * hf + st);
            const h16x8 av = *(const h16x8*)(arow + k0) + *(const h16x8*)(pe + k0 + 8 * quad);
#pragma unroll
            for (int c = 0; c < 8; ++c) { const h16x8 bf = *(const h16x8*)(brow + (size_t)(16 * c) * 2048 + k0); acc[c] = MFMA16H(av, bf, acc[c]); }
        }
    }
#pragma unroll
    for (int c = 0; c < 8; ++c)
#pragma unroll
        for (int i = 0; i < 4; ++i) slab[(wave * 16 + 4 * quad + i) * CM_SP + 16 * c + r] = acc[c][i];
    AT_BAR();
#pragma unroll
    for (int jj = 0; jj < 4; ++jj) {
        const int idx = tid + NTHREADS * jj, row = idx >> 7, col = idx & 127;
        float x = 0.f;
#pragma unroll
        for (int w8 = 0; w8 < 8; ++w8) x += slab[(w8 * 16 + row) * CM_SP + col];
        hb[row * CM_HP + col] = f2h(x * sigmoid_f(x));
    }
    AT_BAR();
    if (wave < 4) {
        const u16* w2t = (const u16*)(ws + (kv ? WS_CW2V_T : WS_CW2K_T)) + (size_t)(16 * wave + r) * 128 + 8 * quad;
        f32x4 oc = {0.f, 0.f, 0.f, 0.f};
#pragma unroll
        for (int ks = 0; ks < 4; ++ks) {
            const h16x8 af = *(const LAS h16x8*)(hb + r * CM_HP + 32 * ks + 8 * quad);
            const h16x8 bf = *(const h16x8*)(w2t + 32 * ks);
            oc = MFMA16H(af, bf, oc);
        }
        const int d = 16 * wave + r, n0 = 16 * mt + 4 * quad;
        if (kv == 0) {
            u16* dst = (u16*)(ws + WS_KCMP) + (size_t)bg * 512 * 64 + d;
#pragma unroll
            for (int i = 0; i < 4; ++i) dst[(size_t)(n0 + i) * 64] = (n0 + i) < NCMP ? f2h(oc[i]) : (u16)0;
        } else {
            u32x2 w; w.x = pkh(oc[0], oc[1]); w.y = pkh(oc[2], (n0 + 3) < NCMP ? oc[3] : 0.f);
            *(u32x2*)((u16*)(ws + WS_VCMPT) + ((size_t)bg * 64 + d) * 512 + n0) = w;
        }
    }
    AT_BAR();
}
constexpr int NS_IMP_P = 132, NS_MAXIT = 288, NS_SLOT = 32 * 144;
constexpr int NS_OFF_IMP = 0, NS_OFF_KC = 67584;
constexpr int NS_OFF_SLOT = 0, NS_OFF_SLOTL = 2 * 8 * NS_SLOT, NS_OFF_OA = NS_OFF_SLOTL + 2048;
constexpr int NS_OFF_BM = 141312, NS_OFF_ITEMS = 142336, NS_OFF_CNT = 145792;
static_assert(2 * 64 * NS_IMP_P * 4 <= NS_OFF_KC && NS_OFF_KC + 512 * 144 <= NS_OFF_BM && NS_OFF_OA + 4 * 512 * 16 <= NS_OFF_BM &&
              NS_OFF_ITEMS + NS_MAXIT * 12 <= NS_OFF_CNT && NS_OFF_CNT + 16 + 1024 <= LDS_BYTES - 256 && AT_LDS <= NS_OFF_BM, "nsa LDS map");
#define NS_BAR() do { asm volatile("s_waitcnt lgkmcnt(0)" ::: "memory"); __builtin_amdgcn_s_barrier(); asm volatile("" ::: "memory"); } while (0)

__device__ __forceinline__ void nsa_unit(unsigned char* ws, LAS unsigned char* lds, int bg, int qt, int wave, int lane) {
    const int tid = threadIdx.x; const int b = bg >> 1, g = bg & 1;
    LAS float* imp = (LAS float*)(lds + NS_OFF_IMP);
    LAS unsigned* bm = (LAS unsigned*)(lds + NS_OFF_BM);
    LAS unsigned char* kcl = lds + NS_OFF_KC;
    LAS unsigned* items = (LAS unsigned*)(lds + NS_OFF_ITEMS);
    LAS unsigned* cnt = (LAS unsigned*)(lds + NS_OFF_CNT);
    const float* gates = (const float*)(ws + WS_GATES);
    for (int i = tid; i < 2 * 64 * NS_IMP_P; i += NTHREADS) imp[i] = 0.f;
    if (tid == 0) cnt[0] = 0u;
    {
        const int amax = 4 * qt + 3;
        int nrows = 32 * ((amax + 31) >> 5); nrows = nrows > 512 ? 512 : nrows;
        const u16* kcg = (const u16*)(ws + WS_KCMP) + (size_t)bg * 512 * 64;
        u32x4 tmp[8];
#pragma unroll
        for (int ii = 0; ii < 8; ++ii) { const int i = tid + NTHREADS * ii; if (i < nrows * 8) tmp[ii] = *(const u32x4*)(kcg + (size_t)i * 8); }
#pragma unroll
        for (int ii = 0; ii < 8; ++ii) { const int i = tid + NTHREADS * ii; if (i < nrows * 8) *(LAS u32x4*)(kcl + (i >> 3) * 144 + (i & 7) * 16) = tmp[ii]; }
    }
    AT_BAR();
    {
        int ln1 = lane; asm volatile("" : "+v"(ln1));
        const int qg = wave & 3, hp = wave >> 2, qi = ln1 & 15, quad = ln1 >> 4;
        const int a = 4 * qt + qg;
        const int nlim = (qi == 15) ? a - 1 : a - 2;
        const int nT = (a + 15) >> 4, nP = (nT + 1) >> 1;
        const int q = 16 * qg + qi; const size_t row = (size_t)b * SEQ + 64 * qt + q;
        const u16* vtg = (const u16*)(ws + WS_VCMPT) + (size_t)bg * 64 * 512;
        const LAS unsigned char* kl = kcl + qi * 144 + quad * 16;
        LAS float* ir = imp + (hp * 64 + q) * NS_IMP_P + quad;
        h16x8 qf2[2][2];
#pragma unroll
        for (int hh = 0; hh < 2; ++hh)
#pragma unroll
            for (int ks = 0; ks < 2; ++ks) qf2[hh][ks] = *(const h16x8*)((const u16*)(ws + WS_Q) + row * 512 + (4 * g + 2 * hp + hh) * 64 + 32 * ks + 8 * quad);
        float m[2] = {-1e30f, -1e30f}, l[2] = {0.f, 0.f};
        for (int P = 0; P < nP; ++P) {
            h16x8 kp[2][2];
#pragma unroll
            for (int tt = 0; tt < 2; ++tt) { kp[tt][0] = *(const LAS h16x8*)(kl + (2 * P + tt) * 16 * 144); kp[tt][1] = *(const LAS h16x8*)(kl + (2 * P + tt) * 16 * 144 + 64); }
            f32x4 sv[2][2];
#pragma unroll
            for (int tt = 0; tt < 2; ++tt)
#pragma unroll
                for (int hh = 0; hh < 2; ++hh) { f32x4 z = {0.f, 0.f, 0.f, 0.f}; z = MFMA16H(kp[tt][0], qf2[hh][0], z); sv[tt][hh] = MFMA16H(kp[tt][1], qf2[hh][1], z); }
#pragma unroll
            for (int hh = 0; hh < 2; ++hh) {
                float mx = m[hh];
#pragma unroll
                for (int tt = 0; tt < 2; ++tt)
#pragma unroll
                    for (int i = 0; i < 4; ++i) mx = (16 * (2 * P + tt) + 4 * quad + i <= nlim) ? fmaxf(mx, sv[tt][hh][i]) : mx;
                float add = 0.f;
#pragma unroll
                for (int tt = 0; tt < 2; ++tt)
#pragma unroll
                    for (int i = 0; i < 4; ++i) add += (16 * (2 * P + tt) + 4 * quad + i <= nlim) ? __builtin_amdgcn_exp2f(sv[tt][hh][i] - mx) : 0.f;
                l[hh] = l[hh] * __builtin_amdgcn_exp2f(m[hh] - mx) + add; m[hh] = mx;
            }
        }
        float mall[2], inv[2];
#pragma unroll
        for (int hh = 0; hh < 2; ++hh) {
            float ma = fmaxf(m[hh], __shfl_xor(m[hh], 16)); ma = fmaxf(ma, __shfl_xor(ma, 32));
            float lw = l[hh] * __builtin_amdgcn_exp2f(m[hh] - ma); lw += __shfl_xor(lw, 16); lw += __shfl_xor(lw, 32);
            mall[hh] = ma; inv[hh] = lw > 0.f ? 1.0f / lw : 0.f;
        }
        f32x4 oc[2][4];
#pragma unroll
        for (int hh = 0; hh < 2; ++hh)
#pragma unroll
            for (int dt = 0; dt < 4; ++dt) oc[hh][dt] = (f32x4){0.f, 0.f, 0.f, 0.f};
        float cwrap = 0.f;
        u32x2 vn[4][2];
#pragma unroll
        for (int dt = 0; dt < 4; ++dt) { const u16* vp = vtg + (size_t)(16 * dt + qi) * 512 + 4 * quad; vn[dt][0] = *(const u32x2*)vp; vn[dt][1] = *(const u32x2*)(vp + 16); }
        for (int P = 0; P < nP; ++P) {
            u32x4 va4[4];
#pragma unroll
            for (int dt = 0; dt < 4; ++dt) va4[dt] = (u32x4){vn[dt][0].x, vn[dt][0].y, vn[dt][1].x, vn[dt][1].y};
            if (P + 1 < nP) {
#pragma unroll
                for (int dt = 0; dt < 4; ++dt) { const u16* vp = vtg + (size_t)(16 * dt + qi) * 512 + 32 * (P + 1) + 4 * quad; vn[dt][0] = *(const u32x2*)vp; vn[dt][1] = *(const u32x2*)(vp + 16); }
            }
            h16x8 kp[2][2];
#pragma unroll
            for (int tt = 0; tt < 2; ++tt) { kp[tt][0] = *(const LAS h16x8*)(kl + (2 * P + tt) * 16 * 144); kp[tt][1] = *(const LAS h16x8*)(kl + (2 * P + tt) * 16 * 144 + 64); }
            f32x4 sv[2][2];
#pragma unroll
            for (int tt = 0; tt < 2; ++tt)
#pragma unroll
                for (int hh = 0; hh < 2; ++hh) { f32x4 z = {0.f, 0.f, 0.f, 0.f}; z = MFMA16H(kp[tt][0], qf2[hh][0], z); sv[tt][hh] = MFMA16H(kp[tt][1], qf2[hh][1], z); }
            u32x4 pw[2];
            float A2[2], C2[2];
#pragma unroll
            for (int tt = 0; tt < 2; ++tt) {
                const int n0 = 16 * (2 * P + tt) + 4 * quad;
                float A = 0.f, C = 0.f;
#pragma unroll
                for (int hh = 0; hh < 2; ++hh) {
                    float pv[4];
#pragma unroll
                    for (int i = 0; i < 4; ++i) pv[i] = (n0 + i <= nlim) ? __builtin_amdgcn_exp2f(sv[tt][hh][i] - mall[hh]) * inv[hh] : 0.f;
                    A += (pv[0] + pv[1]) + (pv[2] + 0.5f * pv[3]); C += 0.5f * pv[3];
                    if (tt == 0) { pw[hh].x = pkh(pv[0], pv[1]); pw[hh].y = pkh(pv[2], pv[3]); } else { pw[hh].z = pkh(pv[0], pv[1]); pw[hh].w = pkh(pv[2], pv[3]); }
                }
                A2[tt] = A; C2[tt] = C;
            }
            const float cup0 = __shfl_up(C2[0], 16), cup1 = __shfl_up(C2[1], 16);
            const float cw0 = __shfl(C2[0], qi + 48), cw1 = __shfl(C2[1], qi + 48);
            ir[4 * (2 * P)] = A2[0] + (quad > 0 ? cup0 : cwrap);
            ir[4 * (2 * P + 1)] = A2[1] + (quad > 0 ? cup1 : cw0);
            cwrap = cw1;
#pragma unroll
            for (int dt = 0; dt < 4; ++dt) {
#pragma unroll
                for (int hh = 0; hh < 2; ++hh) oc[hh][dt] = MFMA16H(__builtin_bit_cast(h16x8, va4[dt]), __builtin_bit_cast(h16x8, pw[hh]), oc[hh][dt]);
            }
        }
        if (quad == 0 && 2 * nP < 32) ir[4 * (2 * nP)] = cwrap;
#pragma unroll
        for (int hh = 0; hh < 2; ++hh) {
            const int h = 2 * hp + hh;
            const float g0 = gates[row * 24 + (4 * g + h) * 3 + 0];
#pragma unroll
            for (int dt = 0; dt < 4; ++dt) {
                u32x2 w; w.x = pkh(oc[hh][dt][0] * g0, oc[hh][dt][1] * g0); w.y = pkh(oc[hh][dt][2] * g0, oc[hh][dt][3] * g0);
                *(u32x2*)((u16*)(ws + WS_Y) + row * DM + (4 * g + h) * 64 + 16 * dt + 4 * quad) = w;
            }
        }
    }
    __syncthreads();
    {
        const int cur = qt, nf = cur == 0 ? 1 : (cur == 1 ? 2 : 3), need = NTOP - nf, jhi = cur - 2;
        int ln2 = lane; asm volatile("" : "+v"(ln2));
        const int j1 = ln2, j2 = ln2 + 64;
        const bool c1 = (j1 >= 1 && j1 <= jhi), c2 = (j2 <= jhi);
        const bool f1 = (j1 == 0) || (j1 == cur) || (j1 == cur - 1), f2 = (j2 == cur) || (j2 == cur - 1);
#pragma unroll 1
        for (int q0 = 0; q0 < 8; q0 += 4) {
            unsigned u1[4], u2[4];
#pragma unroll
            for (int k = 0; k < 4; ++k) {
                const int q = 8 * wave + q0 + k;
                const LAS float* ir0 = imp + q * NS_IMP_P; const LAS float* ir1 = imp + (64 + q) * NS_IMP_P;
                u1[k] = __float_as_uint(ir0[j1] + ir1[j1]); u2[k] = __float_as_uint(ir0[j2] + ir1[j2]);
                u1[k] = c1 ? u1[k] : 0u; u2[k] = c2 ? u2[k] : 0u;
            }
            unsigned pre[4] = {0u, 0u, 0u, 0u};
            if (jhi > need) {
                for (int bit = 30; bit >= 0; --bit) {
#pragma unroll
                    for (int k = 0; k < 4; ++k) {
                        const unsigned tr = pre[k] | (1u << bit);
                        const int cge = __popcll(__ballot(u1[k] >= tr)) + __popcll(__ballot(u2[k] >= tr));
                        pre[k] = cge >= need ? tr : pre[k];
                    }
                }
            }
#pragma unroll
            for (int k = 0; k < 4; ++k) {
                const int q = 8 * wave + q0 + k;
                bool s1 = f1 || c1, s2 = f2 || c2;
                if (jhi > need) {
                    const unsigned long long g1 = __ballot(c1 && u1[k] > pre[k]), g2 = __ballot(c2 && u2[k] > pre[k]);
                    const unsigned long long e1 = __ballot(c1 && u1[k] == pre[k]), e2 = __ballot(c2 && u2[k] == pre[k]);
                    const int rem = need - (__popcll(g1) + __popcll(g2));
                    const int er1 = __builtin_amdgcn_mbcnt_hi((unsigned)(e1 >> 32), __builtin_amdgcn_mbcnt_lo((unsigned)e1, 0u));
                    const int er2 = __popcll(e1) + __builtin_amdgcn_mbcnt_hi((unsigned)(e2 >> 32), __builtin_amdgcn_mbcnt_lo((unsigned)e2, 0u));
                    s1 = f1 || (c1 && (u1[k] > pre[k] || (u1[k] == pre[k] && er1 < rem)));
                    s2 = f2 || (c2 && (u2[k] > pre[k] || (u2[k] == pre[k] && er2 < rem)));
                }
                const unsigned long long m1 = __ballot(s1), m2 = __ballot(s2);
                if (ln2 == 0) { bm[q * 4 + 0] = (unsigned)m1; bm[q * 4 + 1] = (unsigned)(m1 >> 32); bm[q * 4 + 2] = (unsigned)m2; bm[q * 4 + 3] = (unsigned)(m2 >> 32); }
            }
        }
    }
    AT_BAR();
    {
        constexpr int MB_QL = 0, MB_QP = 528, MB_KV = 33792, MB_SLOT = MB_KV + 8 * AT_TILE, MB_SP = 144, MB_SLOTL = MB_SLOT + 8 * 32 * MB_SP, MB_PERM = MB_SLOTL + 1024;
        static_assert(64 * MB_QP <= MB_KV && MB_PERM + 512 <= LDS_BYTES - 256, "mbr LDS map");
        int ln3 = lane, td3 = tid; asm volatile("" : "+v"(ln3), "+v"(td3));
        const int r32 = ln3 & 31, hi = ln3 >> 5, qi = r32 >> 2, h = r32 & 3;
        const int prow = (r32 & 0x13) | ((r32 & 8) >> 1) | ((r32 & 4) << 1);
        const int oq = td3 >> 3, oh = (td3 >> 1) & 3, ohf = td3 & 1;
        LAS unsigned char* ql = lds + MB_QL;
        LAS unsigned char* kvl = lds + MB_KV;
        LAS unsigned char* slots = lds + MB_SLOT;
        LAS float* slotl = (LAS float*)(lds + MB_SLOTL);
        LAS unsigned char* permw = lds + MB_PERM + wave * 64;
        {
            const u16* qsrc = (const u16*)(ws + WS_Q) + ((size_t)b * SEQ + 64 * qt) * 512 + 4 * g * 64;
#pragma unroll
            for (int i = 0; i < 4; ++i) { const int idx = td3 + NTHREADS * i, r = idx >> 5, pc = idx & 31; *(LAS u32x4*)(ql + r * MB_QP + pc * 16) = *(const u32x4*)(qsrc + (size_t)r * 512 + pc * 8); }
        }
        const int srow = td3 >> 3, sch = td3 & 7;
        const u16* ksrc = (const u16*)(ws + WS_KS) + (size_t)bg * SEQ * 64 + (size_t)srow * 64 + 8 * sch;
        const u16* vsrc = (const u16*)(ws + WS_VST) + (size_t)bg * 64 * SEQ + (size_t)srow * 64 + 8 * sch;
        const int sdst = srow * AT_PITCH + sch * 16;
        const int nrnd = (qt + 4) >> 2;
        u32x4 kr[4], vr[4];
#define MB_LOAD(R_) do { _Pragma("unroll") for (int bi = 0; bi < 4; ++bi) { const int jb_ = 4 * (R_) + bi; const int jc_ = jb_ <= qt ? jb_ : qt; \
            kr[bi] = *(const u32x4*)(ksrc + (size_t)jc_ * 4096); vr[bi] = *(const u32x4*)(vsrc + (size_t)jc_ * 4096); } } while (0)
#define MB_STORE() do { _Pragma("unroll") for (int bi = 0; bi < 4; ++bi) { *(LAS u32x4*)(kvl + bi * AT_TILE + sdst) = kr[bi]; *(LAS u32x4*)(kvl + (4 + bi) * AT_TILE + sdst) = vr[bi]; } } while (0)
        MB_LOAD(0);
        const unsigned mybm0 = bm[ln3 * 4 + 0], mybm1 = bm[ln3 * 4 + 1], mybm2 = bm[ln3 * 4 + 2], mybm3 = bm[ln3 * 4 + 3];
        MB_STORE();
        h16x2 oa[16]; float la = 0.f;
#pragma unroll
        for (int e = 0; e < 16; ++e) oa[e] = (h16x2){(h16)0.f, (h16)0.f};
        const u32x4 onesw = {0x3c003c00u, 0x3c003c00u, 0x3c003c00u, 0x3c003c00u};
        const int koff = prow * AT_PITCH + hi * 16, voff = 4 * AT_TILE + r32 * AT_PITCH + hi * 16;
        const unsigned blo = oq >= 32 ? 0xffffffffu : ((1u << oq) - 1u), bhi = oq >= 32 ? ((1u << (oq - 32)) - 1u) : 0u;
        const unsigned obit = 1u << (oq & 31); const bool ohigh = oq >= 32;
        AT_BAR();
        for (int R = 0; R < nrnd; ++R) {
            if (R + 1 < nrnd) MB_LOAD(R + 1);
            unsigned long long mk[4]; int cb[4], base[4]; int NI = 0;
#pragma unroll
            for (int bi = 0; bi < 4; ++bi) {
                const int j = 4 * R + bi;
                const unsigned mw = j < 32 ? mybm0 : (j < 64 ? mybm1 : (j < 96 ? mybm2 : mybm3));
                const bool bit = (j <= qt) && ((mw >> (j & 31)) & 1u);
                mk[bi] = __ballot(bit); cb[bi] = __popcll(mk[bi]); base[bi] = NI; NI += (cb[bi] + 7) >> 3;
            }
            const int nsub = (NI + 7) >> 3;
            for (int sr = 0; sr < nsub; ++sr) {
                const int it = 8 * sr + wave;
                if (it < NI) {
                    int bi = 0;
                    if (it >= base[1]) bi = 1;
                    if (it >= base[2]) bi = 2;
                    if (it >= base[3]) bi = 3;
                    const unsigned long long mkb = bi == 0 ? mk[0] : (bi == 1 ? mk[1] : (bi == 2 ? mk[2] : mk[3]));
                    const int cbb = bi == 0 ? cb[0] : (bi == 1 ? cb[1] : (bi == 2 ? cb[2] : cb[3]));
                    const int sub = it - (bi == 0 ? base[0] : (bi == 1 ? base[1] : (bi == 2 ? base[2] : base[3])));
                    const int j = 4 * R + bi;
                    const unsigned mwj = j < 32 ? mybm0 : (j < 64 ? mybm1 : (j < 96 ? mybm2 : mybm3));
                    const bool bit = (mwj >> (j & 31)) & 1u;
                    const int rank = __builtin_amdgcn_mbcnt_hi((unsigned)(mkb >> 32), __builtin_amdgcn_mbcnt_lo((unsigned)mkb, 0u));
                    if (bit) permw[rank] = (unsigned char)ln3;
                    h16x8 qf[4], kf[8];
#pragma unroll
                    for (int kh = 0; kh < 2; ++kh)
#pragma unroll
                        for (int d0 = 0; d0 < 4; ++d0) kf[kh * 4 + d0] = *(const LAS h16x8*)(kvl + bi * AT_TILE + kh * 32 * AT_PITCH + koff + d0 * 32);
                    const int slotq = 8 * sub + qi;
                    const bool valid = slotq < cbb;
                    const int q = valid ? (int)permw[slotq] : 0;
#pragma unroll
                    for (int d0 = 0; d0 < 4; ++d0) qf[d0] = *(const LAS h16x8*)(ql + q * MB_QP + h * 128 + d0 * 32 + hi * 16);
                    __builtin_amdgcn_sched_barrier(0);
                    f32x16 sx[2];
#pragma unroll
                    for (int kh = 0; kh < 2; ++kh) {
#pragma unroll
                        for (int e = 0; e < 16; ++e) sx[kh][e] = -(OFF2 + 4.0f);
#pragma unroll
                        for (int d0 = 0; d0 < 4; ++d0) sx[kh] = MFMA32H(kf[kh * 4 + d0], qf[d0], sx[kh]);
                    }
                    h16x8 vfr[8];
#pragma unroll
                    for (int dt = 0; dt < 2; ++dt)
#pragma unroll
                        for (int kk = 0; kk < 4; ++kk) vfr[dt * 4 + kk] = *(const LAS h16x8*)(kvl + bi * AT_TILE + voff + dt * 32 * AT_PITCH + kk * 32);
                    __builtin_amdgcn_sched_barrier(0);
                    const bool diag = (j == qt);
                    const unsigned vmk = valid ? 0xffffffffu : 0u;
                    u32x4 pw[4];
#pragma unroll
                    for (int kk = 0; kk < 4; ++kk) {
                        float pv[8];
#pragma unroll
                        for (int e = 0; e < 8; ++e) {
                            float pe = __builtin_amdgcn_exp2f(sx[kk >> 1][8 * (kk & 1) + e]);
                            if (diag) pe = (16 * kk + 8 * hi + e <= q) ? pe : 0.f;
                            pv[e] = pe;
                        }
                        pw[kk] = (u32x4){pkh(pv[0], pv[1]) & vmk, pkh(pv[2], pv[3]) & vmk, pkh(pv[4], pv[5]) & vmk, pkh(pv[6], pv[7]) & vmk};
                    }
                    f32x16 o[2], ol;
#pragma unroll
                    for (int e = 0; e < 16; ++e) { o[0][e] = 0.f; o[1][e] = 0.f; ol[e] = 0.f; }
#pragma unroll
                    for (int kk = 0; kk < 4; ++kk) {
                        const h16x8 pb2 = __builtin_bit_cast(h16x8, pw[kk]);
#pragma unroll
                        for (int dt = 0; dt < 2; ++dt) o[dt] = MFMA32H(vfr[dt * 4 + kk], pb2, o[dt]);
                        ol = MFMA32H(__builtin_bit_cast(h16x8, onesw), pb2, ol);
                    }
                    LAS unsigned char* sp = slots + (wave * 32 + r32) * MB_SP + hi * 8;
#pragma unroll
                    for (int dt = 0; dt < 2; ++dt)
#pragma unroll
                        for (int r4 = 0; r4 < 4; ++r4) { u32x2 w; w.x = pkh(o[dt][4 * r4], o[dt][4 * r4 + 1]); w.y = pkh(o[dt][4 * r4 + 2], o[dt][4 * r4 + 3]); *(LAS u32x2*)(sp + dt * 64 + r4 * 16) = w; }
                    if (hi == 0) slotl[wave * 32 + r32] = ol[0];
                }
                AT_BAR();
                if (sr == nsub - 1 && R + 1 < nrnd) MB_STORE();
#pragma unroll
                for (int bi = 0; bi < 4; ++bi) {
                    const unsigned mlo = (unsigned)mk[bi], mhi = (unsigned)(mk[bi] >> 32);
                    if ((ohigh ? mhi : mlo) & obit) {
                        const int rk = __builtin_popcount(mlo & blo) + __builtin_popcount(mhi & bhi);
                        const int itb = base[bi] + (rk >> 3);
                        if ((itb >> 3) == sr) {
                            const int sl = itb & 7, col = 4 * (rk & 7) + oh;
                            const LAS unsigned char* sp = slots + (sl * 32 + col) * MB_SP + ohf * 64;
#pragma unroll
                            for (int c8 = 0; c8 < 4; ++c8) {
                                const h16x8 v = *(const LAS h16x8*)(sp + c8 * 16);
#pragma unroll
                                for (int e = 0; e < 4; ++e) oa[4 * c8 + e] += (h16x2){v[2 * e], v[2 * e + 1]};
                            }
                            la += slotl[sl * 32 + col];
                        }
                    }
                }
                AT_BAR();
            }
            if (nsub == 0 && R + 1 < nrnd) { MB_STORE(); AT_BAR(); }
        }
#undef MB_LOAD
#undef MB_STORE
        {
            const size_t row = (size_t)b * SEQ + 64 * qt + oq;
            const float g1 = gates[row * 24 + (4 * g + oh) * 3 + 1];
            const float sc = g1 / la;
            const u16* owp = (const u16*)(ws + WS_OWIN) + row * 512 + (4 * g + oh) * 64 + 32 * ohf;
            u16* yp = (u16*)(ws + WS_Y) + row * DM + (4 * g + oh) * 64 + 32 * ohf;
            float ssq = 0.f;
#pragma unroll
            for (int c8 = 0; c8 < 4; ++c8) {
                const h16x8 cw = *(const h16x8*)(yp + 8 * c8), ww = *(const h16x8*)(owp + 8 * c8);
                float y[8];
#pragma unroll
                for (int e = 0; e < 8; ++e) { y[e] = (float)oa[4 * c8 + (e >> 1)][e & 1] * sc + (float)cw[e] + (float)ww[e]; ssq += y[e] * y[e]; }
                const u32x4 w = {pkh(y[0], y[1]), pkh(y[2], y[3]), pkh(y[4], y[5]), pkh(y[6], y[7])};
                *(u32x4*)(yp + 8 * c8) = w;
            }
            ssq += __shfl_xor(ssq, 1); ssq += __shfl_xor(ssq, 2); ssq += __shfl_xor(ssq, 4);
            if ((td3 & 7) == 0) ((float*)(ws + WS_SSQ))[row * 2 + g] = ssq;
        }
    }
    __syncthreads();
}

__device__ __forceinline__ void nsa_finalize_unit(unsigned char* ws, const float* gain, int u, int wave, int lane) {
    const f32x4 g0 = *(const f32x4*)(gain + 8 * lane), g1 = *(const f32x4*)(gain + 8 * lane + 4);
#pragma unroll 1
    for (int i0 = 0; i0 < 16; i0 += 8) {
        f32x2 sq[8]; h16x8 v[8];
#pragma unroll
        for (int i = 0; i < 8; ++i) {
            const size_t row = (size_t)u * 128 + wave * 16 + i0 + i;
            sq[i] = *(const f32x2*)((const float*)(ws + WS_SSQ) + row * 2);
            v[i] = *(const h16x8*)((const u16*)(ws + WS_Y) + row * DM + 8 * lane);
        }
#pragma unroll
        for (int i = 0; i < 8; ++i) {
            const size_t row = (size_t)u * 128 + wave * 16 + i0 + i;
            const float rs = 1.0f / sqrtf((sq[i][0] + sq[i][1]) * (1.0f / 512.f) + EPS);
            u32x4 w;
            w.x = pkh((float)v[i][0] * rs * g0[0], (float)v[i][1] * rs * g0[1]); w.y = pkh((float)v[i][2] * rs * g0[2], (float)v[i][3] * rs * g0[3]);
            w.z = pkh((float)v[i][4] * rs * g1[0], (float)v[i][5] * rs * g1[1]); w.w = pkh((float)v[i][6] * rs * g1[2], (float)v[i][7] * rs * g1[3]);
            *(u32x4*)((u16*)(ws + WS_Y) + row * DM + 8 * lane) = w;
        }
    }
}
constexpr int HG_LFP = 129;
constexpr int HG_OFF_LF = 0, HG_OFF_SEG = 33024, HG_OFF_KT = 35072, HG_OFF_VT = 35072 + 18432;
constexpr int H3_OFF_QT = 35072, H3_OFF_KH = H3_OFF_QT + 17408, H3_OFF_VT = H3_OFF_KH + 17408, H3_OFF_SSQ = H3_OFF_VT + 18432;
static_assert(H3_OFF_SSQ + 256 <= LDS_BYTES, "hgrn LDS map");

__device__ __forceinline__ void hg_load_logf(const unsigned char* ws, LAS float* lf, size_t row0, int h, int tid) {
#pragma unroll
    for (int i = 0; i < 2; ++i) {
        const int idx = tid + NTHREADS * i, s = idx >> 4, ch = idx & 15;
        const h16x8 v = *(const h16x8*)((const u16*)(ws + WS_HLOGF) + (row0 + s) * 512 + h * 128 + 8 * ch);
#pragma unroll
        for (int e = 0; e < 8; ++e) lf[s * HG_LFP + 8 * ch + e] = (float)v[e];
    }
}
__device__ __forceinline__ void hg_stage_vt(const unsigned char* ws, LAS u16* vt, size_t row0, int h, int tid) {
#pragma unroll
    for (int i = 0; i < 2; ++i) {
        const int idx = tid + NTHREADS * i, s = idx & 63, ch = idx >> 6;
        const s16x8 v = *(const s16x8*)((const u16*)(ws + WS_HV) + (row0 + s) * 512 + h * 128 + 8 * ch);
#pragma unroll
        for (int e = 0; e < 8; ++e) vt[(8 * ch + e) * 72 + s] = (u16)v[e];
    }
}

__device__ __forceinline__ void hgrn_h1_units(unsigned char* ws, LAS unsigned char* lds, int u0, int stride, int nu, int wave, int lane) {
    if (u0 >= nu) return;
    const int tid = threadIdx.x, r32 = lane & 31, hi = lane >> 5;
    LAS float* lf = (LAS float*)(lds + HG_OFF_LF);
    LAS float* seg = (LAS float*)(lds + HG_OFF_SEG);
    LAS u16* kt = (LAS u16*)(lds + HG_OFF_KT);
    LAS u16* vt = (LAS u16*)(lds + HG_OFF_VT);
    h16x8 lfr[2]; s16x8 vvr[2];
#define H1_LOAD(uu) do { const int c_ = (uu) & 127, bh_ = (uu) >> 7; const size_t r0_ = (size_t)(bh_ >> 2) * SEQ + 64 * c_; const int h_ = bh_ & 3; \
        _Pragma("unroll") for (int i = 0; i < 2; ++i) { const int idx = tid + NTHREADS * i; \
            lfr[i] = *(const h16x8*)((const u16*)(ws + WS_HLOGF) + (r0_ + (idx >> 4)) * 512 + h_ * 128 + 8 * (idx & 15)); \
            vvr[i] = *(const s16x8*)((const u16*)(ws + WS_HV) + (r0_ + (idx & 63)) * 512 + h_ * 128 + 8 * (idx >> 6)); } } while (0)
    H1_LOAD(u0);
    for (int u = u0; u < nu; u += stride) {
        const int c = u & 127, bh = u >> 7;
#pragma unroll
        for (int i = 0; i < 2; ++i) {
            const int idx = tid + NTHREADS * i;
            { const int s = idx >> 4, ch = idx & 15;
#pragma unroll
              for (int e = 0; e < 8; ++e) lf[s * HG_LFP + 8 * ch + e] = (float)lfr[i][e]; }
            { const int s = idx & 63, ch = idx >> 6;
#pragma unroll
              for (int e = 0; e < 8; ++e) vt[(8 * ch + e) * 72 + s] = (u16)vvr[i][e]; }
        }
        if (u + stride < nu) H1_LOAD(u + stride);
        AT_BAR();
        const int d = tid & 127, sg = tid >> 7;
        float lg[16]; float tot = 0.f;
#pragma unroll
        for (int i = 0; i < 16; ++i) { lg[i] = lf[(16 * sg + i) * HG_LFP + d]; tot += lg[i]; }
        seg[sg * 128 + d] = tot;
        AT_BAR();
        {
            float R = 0.f;
            for (int s2 = sg + 1; s2 < 4; ++s2) R += seg[s2 * 128 + d];
#pragma unroll
            for (int i = 15; i >= 0; --i) {
                const float ke = (1.0f - __expf(lg[i])) * __expf(R);
                kt[d * 72 + 16 * sg + i] = f2b(ke);
                R += lg[i];
            }
            if (sg == 0) ((float*)(ws + WS_HD))[((size_t)bh * 128 + c) * 128 + d] = __expf(R);
        }
        AT_BAR();
        {
            const int vtile = wave & 3;
            s16x8 bfr[4];
#pragma unroll
            for (int ks = 0; ks < 4; ++ks) bfr[ks] = *(const LAS s16x8*)(vt + (32 * vtile + r32) * 72 + 16 * ks + 8 * hi);
            u16* dst = (u16*)(ws + WS_HL) + (((size_t)bh * 128 + c) * 128 + 32 * vtile + r32) * 128;
#pragma unroll
            for (int dd = 0; dd < 2; ++dd) {
                const int dtile = 2 * (wave >> 2) + dd;
                f32x16 acc;
#pragma unroll
                for (int i = 0; i < 16; ++i) acc[i] = 0.f;
                s16x8 afr[4];
#pragma unroll
                for (int ks = 0; ks < 4; ++ks) afr[ks] = *(const LAS s16x8*)(kt + (32 * dtile + r32) * 72 + 16 * ks + 8 * hi);
#pragma unroll
                for (int ks = 0; ks < 4; ++ks) acc = MFMA32B(afr[ks], bfr[ks], acc);
#pragma unroll
                for (int r4 = 0; r4 < 4; ++r4) {
                    u32x2 w; w.x = pkb(acc[4 * r4], acc[4 * r4 + 1]); w.y = pkb(acc[4 * r4 + 2], acc[4 * r4 + 3]);
                    *(u32x2*)(dst + 32 * dtile + 8 * r4 + 4 * hi) = w;
                }
            }
        }
        AT_BAR();
    }
#undef H1_LOAD
}

__device__ __forceinline__ void hgrn_h2_unit(unsigned char* ws, int u, int wave, int lane) {
    if (wave >= 2) return;
    const int gt = u * 128 + wave * 64 + lane;
    const int bh = gt >> 12, v = (gt >> 5) & 127, d0 = 4 * (gt & 31);
    const u16* lp = (const u16*)(ws + WS_HL) + ((size_t)bh * 128 * 128 + v) * 128 + d0;
    u16* sp = (u16*)(ws + WS_HS) + ((size_t)bh * 128 * 128 + v) * 128 + d0;
    const float* dp = (const float*)(ws + WS_HD) + (size_t)bh * 128 * 128 + d0;
    float S0 = 0.f, S1 = 0.f, S2 = 0.f, S3 = 0.f;
#pragma unroll 1
    for (int c0 = 0; c0 < 128; c0 += 16) {
        u32x2 lw[16]; f32x4 dv[16];
#pragma unroll
        for (int i = 0; i < 16; ++i) { lw[i] = *(const u32x2*)(lp + (size_t)(c0 + i) * 16384); dv[i] = *(const f32x4*)(dp + (c0 + i) * 128); }
#pragma unroll
        for (int i = 0; i < 16; ++i) {
            u32x2 w; w.x = pkb(S0, S1); w.y = pkb(S2, S3);
            *(u32x2*)(sp + (size_t)(c0 + i) * 16384) = w;
            S0 = dv[i][0] * S0 + __builtin_bit_cast(float, lw[i].x << 16); S1 = dv[i][1] * S1 + __builtin_bit_cast(float, lw[i].x & 0xffff0000u);
            S2 = dv[i][2] * S2 + __builtin_bit_cast(float, lw[i].y << 16); S3 = dv[i][3] * S3 + __builtin_bit_cast(float, lw[i].y & 0xffff0000u);
        }
    }
}

constexpr int H3_OFF_QR = H3_OFF_SSQ + 256;
static_assert(H3_OFF_QR + 64 * 136 * 2 <= LDS_BYTES - 256, "hgrn h3 LDS map");
__device__ __forceinline__ void hgrn_h3_units(unsigned char* ws, LAS unsigned char* lds, const float* ogain, int u0, int stride, int nu, int wave, int lane) {
    if (u0 >= nu) return;
    const int tid = threadIdx.x, r32 = lane & 31, hi = lane >> 5;
    LAS float* lf = (LAS float*)(lds + HG_OFF_LF);
    LAS float* seg = (LAS float*)(lds + HG_OFF_SEG);
    LAS u16* qt = (LAS u16*)(lds + H3_OFF_QT);
    LAS u16* kh = (LAS u16*)(lds + H3_OFF_KH);
    LAS u16* vt = (LAS u16*)(lds + H3_OFF_VT);
    LAS float* ssq = (LAS float*)(lds + H3_OFF_SSQ);
    LAS u16* qr = (LAS u16*)(lds + H3_OFF_QR);
    h16x8 lfr[2]; s16x8 vvr[2], qqr[2];
#define H3_LOAD(uu) do { const int c_ = (uu) & 127, bh_ = (uu) >> 7; const size_t r0_ = (size_t)(bh_ >> 2) * SEQ + 64 * c_; const int h_ = bh_ & 3; \
        _Pragma("unroll") for (int i = 0; i < 2; ++i) { const int idx = tid + NTHREADS * i; \
            lfr[i] = *(const h16x8*)((const u16*)(ws + WS_HLOGF) + (r0_ + (idx >> 4)) * 512 + h_ * 128 + 8 * (idx & 15)); \
            qqr[i] = *(const s16x8*)((const u16*)(ws + WS_HQ) + (r0_ + (idx >> 4)) * 512 + h_ * 128 + 8 * (idx & 15)); \
            vvr[i] = *(const s16x8*)((const u16*)(ws + WS_HV) + (r0_ + (idx & 63)) * 512 + h_ * 128 + 8 * (idx >> 6)); } } while (0)
    H3_LOAD(u0);
    for (int u = u0; u < nu; u += stride) {
        const int c = u & 127, bh = u >> 7, b = bh >> 2, h = bh & 3;
        const size_t row0 = (size_t)b * SEQ + 64 * c;
#pragma unroll
        for (int i = 0; i < 2; ++i) {
            const int idx = tid + NTHREADS * i;
            { const int s = idx >> 4, ch = idx & 15;
#pragma unroll
              for (int e = 0; e < 8; ++e) lf[s * HG_LFP + 8 * ch + e] = (float)lfr[i][e];
              *(LAS s16x8*)(qr + s * 136 + 8 * ch) = qqr[i]; }
            { const int s = idx & 63, ch = idx >> 6;
#pragma unroll
              for (int e = 0; e < 8; ++e) vt[(8 * ch + e) * 72 + s] = (u16)vvr[i][e]; }
        }
        if (tid < 64) ssq[tid] = 0.f;
        if (u + stride < nu) H3_LOAD(u + stride);
        s16x8 sfr[8];
        {
            const u16* sp = (const u16*)(ws + WS_HS) + (((size_t)bh * 128 + c) * 128 + 32 * (wave >> 1) + r32) * 128 + 8 * hi;
#pragma unroll
            for (int ks = 0; ks < 8; ++ks) sfr[ks] = *(const s16x8*)(sp + 16 * ks);
        }
        AT_BAR();
        const int d = tid & 127, sg = tid >> 7;
        float lg[16]; float tot = 0.f;
#pragma unroll
        for (int i = 0; i < 16; ++i) { lg[i] = lf[(16 * sg + i) * HG_LFP + d]; tot += lg[i]; }
        seg[sg * 128 + d] = tot;
        AT_BAR();
        {
            float Bc = 0.f;
            for (int s2 = 0; s2 < sg; ++s2) Bc += seg[s2 * 128 + d];
#pragma unroll
            for (int i = 0; i < 16; ++i) {
                Bc += lg[i];
                const float qv = b2f(qr[(16 * sg + i) * 136 + d]);
                qt[(16 * sg + i) * 136 + d] = f2b(qv * __expf(Bc));
                kh[(16 * sg + i) * 136 + d] = f2b((1.0f - __expf(lg[i])) * __expf(fminf(-Bc, 80.f)));
            }
        }
        AT_BAR();
        {
            const int th = wave & 1, vtile = wave >> 1;
            s16x8 qf[8];
#pragma unroll
            for (int ks = 0; ks < 8; ++ks) qf[ks] = *(const LAS s16x8*)(qt + (32 * th + r32) * 136 + 16 * ks + 8 * hi);
            f32x16 acc;
#pragma unroll
            for (int i = 0; i < 16; ++i) acc[i] = 0.f;
            {
#pragma unroll
                for (int ks = 0; ks < 8; ++ks) acc = MFMA32B(sfr[ks], qf[ks], acc);
            }
            const int prow = (r32 & 0x13) | ((r32 & 8) >> 1) | ((r32 & 4) << 1);
            for (int sh = 0; sh <= th; ++sh) {
                f32x16 x;
#pragma unroll
                for (int i = 0; i < 16; ++i) x[i] = 0.f;
                s16x8 kfr[8], vfr2[2];
#pragma unroll
                for (int ks = 0; ks < 8; ++ks) kfr[ks] = *(const LAS s16x8*)(kh + (32 * sh + prow) * 136 + 16 * ks + 8 * hi);
#pragma unroll
                for (int sp2 = 0; sp2 < 2; ++sp2) vfr2[sp2] = *(const LAS s16x8*)(vt + (32 * vtile + r32) * 72 + 32 * sh + 16 * sp2 + 8 * hi);
#pragma unroll
                for (int ks = 0; ks < 8; ++ks) x = MFMA32B(kfr[ks], qf[ks], x);
                u32x4 pw[2];
#pragma unroll
                for (int sp2 = 0; sp2 < 2; ++sp2) {
                    float xv[8];
#pragma unroll
                    for (int e = 0; e < 8; ++e) { const int sin_ = 16 * sp2 + 8 * hi + e; const bool ok = (sh < th) || (sin_ <= r32); xv[e] = ok ? x[8 * sp2 + e] : 0.f; }
                    pw[sp2] = (u32x4){pkb(xv[0], xv[1]), pkb(xv[2], xv[3]), pkb(xv[4], xv[5]), pkb(xv[6], xv[7])};
                }
#pragma unroll
                for (int sp2 = 0; sp2 < 2; ++sp2) acc = MFMA32B(vfr2[sp2], __builtin_bit_cast(s16x8, pw[sp2]), acc);
            }
            const int t = 32 * th + r32;
            const u16* gp = (const u16*)(ws + WS_HG) + (row0 + t) * 512 + h * 128 + 32 * vtile + 4 * hi;
            u32x2 gw4[4];
#pragma unroll
            for (int r4 = 0; r4 < 4; ++r4) gw4[r4] = *(const u32x2*)(gp + 8 * r4);
            float sq = 0.f;
#pragma unroll
            for (int i = 0; i < 16; ++i) sq += acc[i] * acc[i];
            sq += __shfl_xor(sq, 32);
            if (hi == 0) (void)__hip_atomic_fetch_add(ssq + t, sq, __ATOMIC_RELAXED, __HIP_MEMORY_SCOPE_WORKGROUP);
            AT_BAR();
            const float rs = 1.0f / sqrtf(ssq[t] * (1.0f / 128.f) + EPS);
            u16* yp = (u16*)(ws + WS_Y) + (row0 + t) * DM + 512 + h * 128 + 32 * vtile + 4 * hi;
            const float* gn = ogain + 32 * vtile + 4 * hi;
#pragma unroll
            for (int r4 = 0; r4 < 4; ++r4) {
                const h16x4 gv = __builtin_bit_cast(h16x4, gw4[r4]);
                const f32x4 gg = *(const f32x4*)(gn + 8 * r4);
                u32x2 w;
                w.x = pkh(acc[4 * r4] * rs * gg[0] * (float)gv[0], acc[4 * r4 + 1] * rs * gg[1] * (float)gv[1]);
                w.y = pkh(acc[4 * r4 + 2] * rs * gg[2] * (float)gv[2], acc[4 * r4 + 3] * rs * gg[3] * (float)gv[3]);
                *(u32x2*)(yp + 8 * r4) = w;
            }
        }
        AT_BAR();
    }
#undef H3_LOAD
}
__global__ void __launch_bounds__(NTHREADS, 2) mk_fwd(Params p) {
    extern __shared__ __attribute__((aligned(16))) unsigned char lds_raw[];
    LAS unsigned char* lds = (LAS unsigned char*)lds_raw;
    const int tid = threadIdx.x, lane = tid & 63, wave = __builtin_amdgcn_readfirstlane(tid >> 6);
    const int G = gridDim.x, bx = blockIdx.x;
    const int vcu = (G % 8 == 0) ? (bx % 8) * (G / 8) + bx / 8 : bx;
    const int gw = vcu * NWAVES + wave, NGW = G * NWAVES;
    unsigned char* ws = p.ws;
#define IN(k) (p.ph_lo <= (k) && (k) < p.ph_hi)
    volatile LAS unsigned* xst = (volatile LAS unsigned*)(lds + LDS_BYTES - 256);
    unsigned* barw = (unsigned*)(ws + WS_CTL);
    XcdBarrier xbar; xbar.bar = barw; xbar.x = 0; xbar.st = xst;
    const bool fused = (p.ph_hi - p.ph_lo) > 1;
    if (fused) {
        if (tid < 2) xst[tid] = 0u;
        __syncthreads();
        xbar = xcd_barrier_post(barw, xst);
    }
#define SEAM(k) do { if (IN(k) && IN((k) + 1)) xcd_barrier(xbar); } while (0)

    if (IN(0)) { p0_prologue(p, lds, gw, NGW, wave, lane); }
    SEAM(0);
    if (IN(1)) {
        pg8::Gemm g{(const u16*)(ws + WS_XH), (const u16*)(ws + WS_WIN_T), MT, DINP, DM}; pg8::StaticOrder S; S.init(MT, DINP, G, bx);
        pg8::EpiInProj E{ws, p.in[3], p.in[4]};
        pg8::gemm_phase<pg8::EpiInProj, pg8::StaticOrder, true, true>(lds, g, S, E, wave);
        const int nfull = (MT / 256) * (DINP / 256) - 3 * G;
        if (nfull < 0 || nfull >= G) p0_late_transposes(p, lds, gw, NGW, wave, lane);
        else if (bx >= nfull) p0_late_transposes(p, lds, (bx - nfull) * NWAVES + wave, (G - nfull) * NWAVES, wave, lane);
    }
    SEAM(1);
    if (IN(2)) {
        constexpr int NU_WIN = 512, NU_CMP = 256, NU_H1 = 1024;
        for (int u = bx; u < NU_WIN + NU_CMP + NU_H1; u += G) {
            if (u < NU_WIN) win_unit(ws, lds, u, wave, lane);
            else if (u < NU_WIN + NU_CMP) cmp_mlp_unit(ws, lds, u - NU_WIN, wave, lane);
            else { hgrn_h1_units(ws, lds, u - NU_WIN - NU_CMP, G, NU_H1, wave, lane); break; }
        }
    }
    SEAM(2);
    if (IN(3)) {
        for (int v = bx; v < 512 + 256; v += G) {
            if (v < 512) {
                int bg, qt;
                if (G == 256) { const int c = v & 255, mem = (c & 1) * 32 + (c >> 3); bg = (c & 7) >> 1; qt = (v < 256) ? mem : 127 - mem; }
                else { const int vv = v & 255; bg = vv >> 6; qt = (v < 256) ? (vv & 63) : 127 - (vv & 63); }
                nsa_unit(ws, lds, bg, qt, wave, lane);
            }
            else hgrn_h2_unit(ws, v - 512, wave, lane);
        }
    }
    SEAM(3);
    if (IN(4)) {
        for (int u = bx; u < 128 + 1024; u += G) {
            if (u < 128) nsa_finalize_unit(ws, p.in[11], u, wave, lane);
            else { hgrn_h3_units(ws, lds, p.in[13], u - 128, G, 1024, wave, lane); break; }
        }
    }
    SEAM(4);
    if (IN(5)) {
        pg8::Gemm g{(const u16*)(ws + WS_Y), (const u16*)(ws + WS_WOUT_T), MT, DM, DM}; pg8::StaticOrder S; S.init(MT, DM, G, bx);
        pg8::EpiOutProj E{p.in[0], (u16*)(ws + WS_X1H), (float*)(ws + WS_SSQ1)};
        pg8::gemm_phase<pg8::EpiOutProj, pg8::StaticOrder, true, true>(lds, g, S, E, wave);
    }
    SEAM(5);
    if (IN(6)) {
        pg8::Gemm g{(const u16*)(ws + WS_X1H), (const u16*)(ws + WS_W1_T), MT, FF, DM}; pg8::StaticOrder S; S.init(MT, FF, G, bx);
        pg8::EpiUp E{(unsigned char*)(ws + WS_HID), (const float*)(ws + WS_SSQ1)};
        pg8::gemm_phase<pg8::EpiUp, pg8::StaticOrder, true, true>(lds, g, S, E, wave);
    }
    SEAM(6);
    if (IN(7)) {
        pg8::Gemm g{(const u16*)(ws + WS_HID), (const u16*)(ws + WS_W2_T), MT, DM, FF / 2}; pg8::StaticOrder S; S.init(MT, DM, G, bx);
        pg8::EpiDown E{p.out, (const u16*)(ws + WS_X1H)};
        pg8::gemm_phase<pg8::EpiDown, pg8::StaticOrder, true, true, true>(lds, g, S, E, wave);
    }
#undef IN
#undef SEAM
}
static int g_grid = 0;
extern "C" void kernel_launch(void* const* d_in, const int* in_sizes, int n_in, void* d_out, int out_size, void* d_ws, size_t ws_size, hipStream_t stream) {
    if (g_grid == 0) {
        int dev = 0, cus = 0, per_cu = 0;
        (void)hipGetDevice(&dev); (void)hipDeviceGetAttribute(&cus, hipDeviceAttributeMultiprocessorCount, dev);
        (void)hipFuncSetAttribute((const void*)mk_fwd, hipFuncAttributeMaxDynamicSharedMemorySize, LDS_BYTES);
        if (hipOccupancyMaxActiveBlocksPerMultiprocessor(&per_cu, (const void*)mk_fwd, NTHREADS, LDS_BYTES) != hipSuccess || per_cu < 1) { per_cu = 1; (void)hipGetLastError(); }
        if (cus <= 0) cus = 256;
        g_grid = cus;
    }
    Params P{};
    for (int i = 0; i < 18; ++i) P.in[i] = (const float*)d_in[i];
    P.out = (float*)d_out; P.ws = (unsigned char*)d_ws;
    for (int i = 0; i < 8; ++i) P.invf[i] = (float)pow(500000.0, -(double)(2 * i) / 16.0);
    P.ph_lo = 0; P.ph_hi = 8;
    (void)hipMemsetAsync((char*)d_ws + WS_CTL, 0, XCD_BAR_WORDS * sizeof(unsigned), stream);
    void* args[] = {&P};
    hipError_t e = hipLaunchCooperativeKernel((const void*)mk_fwd, dim3(g_grid), dim3(NTHREADS), args, LDS_BYTES, stream);
    if (e != hipSuccess) fprintf(stderr, "cooperative launch failed: %s (grid %d)\n", hipGetErrorString(e), g_grid);
}
```

```cpp
#include <hip/hip_runtime.h>
#include <hip/hip_cooperative_groups.h>
#include <cstdio>
#include <cstdint>
#include <cmath>
namespace cg = cooperative_groups;

#define LAS __attribute__((address_space(3)))
typedef _Float16 h16;
typedef _Float16 h16x2 __attribute__((ext_vector_type(2)));
typedef _Float16 h16x4 __attribute__((ext_vector_type(4)));
typedef _Float16 h16x8 __attribute__((ext_vector_type(8)));
typedef __bf16 b16x2 __attribute__((ext_vector_type(2)));
typedef __bf16 b16x8 __attribute__((ext_vector_type(8)));
typedef short s16x8 __attribute__((ext_vector_type(8)));
typedef short s16x4 __attribute__((ext_vector_type(4)));
typedef float f32x2 __attribute__((ext_vector_type(2)));
typedef float f32x4 __attribute__((ext_vector_type(4)));
typedef float f32x16 __attribute__((ext_vector_type(16)));
typedef unsigned u32x2 __attribute__((ext_vector_type(2)));
typedef unsigned u32x4 __attribute__((ext_vector_type(4)));
typedef unsigned short u16;

__device__ __forceinline__ unsigned pkh(float lo, float hi) { f32x2 v = {lo, hi}; h16x2 h = __builtin_convertvector(v, h16x2); return __builtin_bit_cast(unsigned, h); }
__device__ __forceinline__ unsigned pkb(float lo, float hi) { f32x2 v = {lo, hi}; b16x2 h = __builtin_convertvector(v, b16x2); return __builtin_bit_cast(unsigned, h); }
__device__ __forceinline__ float h2f(u16 v) { return (float)__builtin_bit_cast(h16, v); }
__device__ __forceinline__ float b2f(u16 v) { return __builtin_bit_cast(float, (unsigned)v << 16); }
__device__ __forceinline__ u16 f2h(float f) { return __builtin_bit_cast(u16, (h16)f); }
__device__ __forceinline__ u16 f2b(float f) { return (u16)(pkb(f, 0.f) & 0xffffu); }
__device__ __forceinline__ float wave_sum(float v) {
#pragma unroll
    for (int o = 1; o < 64; o <<= 1) v += __shfl_xor(v, o);
    return v;
}
typedef int i32x2 __attribute__((ext_vector_type(2)));
typedef int i32x4 __attribute__((ext_vector_type(4)));
typedef int i32x8 __attribute__((ext_vector_type(8)));
constexpr float F8_MAX = 448.f, HID_SCALE = 8.f, W2_SCALE = 1024.f;
__device__ __forceinline__ float clamp8(float x) { return fminf(fmaxf(x, -F8_MAX), F8_MAX); }
__device__ __forceinline__ unsigned pkf8x4(float a, float b, float c, float d) { int p = 0; p = __builtin_amdgcn_cvt_pk_fp8_f32(a, b, p, false); p = __builtin_amdgcn_cvt_pk_fp8_f32(c, d, p, true); return (unsigned)p; }
__device__ __forceinline__ float sigmoid_f(float x) { return __builtin_amdgcn_rcpf(1.f + __expf(-x)); }

constexpr int BATCH = 2, SEQ = 8192, DM = 1024, MT = BATCH * SEQ, DIN = 3352, DINP = 3584, FF = 4096;
constexpr int NG = 2, HPG = 4, HD = 64, NQH = 8;
constexpr int NCMP = 511, NSLC = 128, NTOP = 16, WINDOW = 512;
constexpr int HGH = 4, HGD = 128;
constexpr float EPS = 1e-6f;
constexpr int C_Q = 0, C_KC = 512, C_VC = 640, C_KS = 768, C_VS = 896, C_KW = 1024, C_VW = 1152, C_GATE = 1280,
              C_HQ = 1304, C_HF = 1816, C_HI = 2328, C_HG = 2840;

constexpr size_t MiB = 1u << 20;
constexpr size_t WS_CTL = 0;
constexpr size_t WS_WIN_T = 1 * MiB;
constexpr size_t WS_WOUT_T = 8 * MiB;
constexpr size_t WS_W1_T = 10 * MiB;
constexpr size_t WS_W2_T = 18 * MiB;
constexpr size_t WS_CW1K_T = 26 * MiB;
constexpr size_t WS_CW1V_T = 26 * MiB + 512 * 1024;
constexpr size_t WS_CW2K_T = 27 * MiB;
constexpr size_t WS_CW2V_T = 27 * MiB + 16 * 1024;
constexpr size_t WS_PEK = 27 * MiB + 32 * 1024;
constexpr size_t WS_PEV = 27 * MiB + 40 * 1024;
constexpr size_t WS_LB = 27 * MiB + 48 * 1024;
constexpr size_t WS_ROPE = 27 * MiB + 256 * 1024;
constexpr size_t WS_XH = 28 * MiB;
constexpr size_t WS_HL = 28 * MiB;
constexpr size_t WS_X1H = 28 * MiB;
constexpr size_t WS_Q = 60 * MiB;
constexpr size_t WS_KC = 76 * MiB;
constexpr size_t WS_KS = 80 * MiB;
constexpr size_t WS_KW = 84 * MiB;
constexpr size_t WS_VC = 88 * MiB;
constexpr size_t WS_VST = 92 * MiB;
constexpr size_t WS_VWT = 96 * MiB;
constexpr size_t WS_GATES = 100 * MiB;
constexpr size_t WS_KCMP = 101 * MiB + 512 * 1024;
constexpr size_t WS_VCMPT = 101 * MiB + 768 * 1024;
constexpr size_t WS_HD = 102 * MiB;
constexpr size_t WS_SSQ = 102 * MiB + 512 * 1024;
constexpr size_t WS_SSQ1 = 103 * MiB;
constexpr size_t WS_HQ = 104 * MiB;
constexpr size_t WS_HLOGF = 120 * MiB;
constexpr size_t WS_HV = 136 * MiB;
constexpr size_t WS_HG = 152 * MiB;
constexpr size_t WS_OWIN = 168 * MiB;
constexpr size_t WS_HS = 184 * MiB;
constexpr size_t WS_Y = 216 * MiB;
constexpr size_t WS_HID = 104 * MiB;
constexpr size_t WS_X1Q = 60 * MiB;
constexpr size_t WS_W1Q = 248 * MiB;
constexpr size_t WS_T1COL = 252 * MiB;
constexpr size_t WS_ROWFAC = 252 * MiB + 128 * 1024;
constexpr size_t WS_END = 256 * MiB;

constexpr int NWAVES = 8, NTHREADS = 512;
constexpr int LDS_BYTES = 147456;

#define MK_LANE() ((int)__builtin_amdgcn_mbcnt_hi(~0u, __builtin_amdgcn_mbcnt_lo(~0u, 0u)))
namespace pg8 {
#define PG8_LAS __attribute__((address_space(3)))
typedef unsigned short bf16_t;
typedef short bf16x8 __attribute__((ext_vector_type(8)));
typedef float f32x4 __attribute__((ext_vector_type(4)));
typedef unsigned u32x4 __attribute__((ext_vector_type(4)));
constexpr int BM = 256, BK = 64, HALF = 128, HTB = HALF * BK * 2  , STAGE_BYTES = 8 * HTB, NXCD = 8, WGM = 8;

__host__ __device__ __forceinline__ int lds_byte(int r, int c) { const int st = (r >> 4) * 2 + (c >> 5), rr = r & 15, cc = c & 31, ob = rr * 64 + cc * 2; return st * 1024 + (ob ^ (((ob >> 9) & 1) << 5)); }
__host__ __device__ __forceinline__ void stage_rc(int b, int& R, int& C) { const int st = b / 1024, sb = b % 1024, swz = sb ^ (((sb >> 9) & 1) << 5); R = (st >> 1) * 16 + swz / 64; C = (st & 1) * 32 + (swz % 64) / 2; }
__host__ __device__ __forceinline__ int perm32(int rho) { const int n = rho >> 4, i = rho & 15; return 8 * (i >> 2) + 4 * n + (i & 3); }

struct Unit { int pm, pn; };
struct Gemm { const bf16_t* A; const bf16_t* Bt; int M, N, K; };

struct StaticOrder {
    int nM, nN, nwg, G, c;
    __host__ __device__ void init(int M, int N, int G_, int c_) { nM = M / BM; nN = N / BM; nwg = nM * nN; G = G_; c = c_; }
    __host__ __device__ bool next(int i, Unit& u) const {
        const long L = (long)i * G + c; if (L >= nwg) return false;
        int wgid = (int)L; { const int q = nwg / NXCD, r = nwg % NXCD, xcd = wgid % NXCD, off = wgid / NXCD; wgid = (xcd < r ? xcd * (q + 1) : r * (q + 1) + (xcd - r) * q) + off; }
        const int nig = WGM * nN, gid = wgid / nig, fm = gid * WGM, gsz = (nM - fm) < WGM ? (nM - fm) : WGM;
        u.pm = fm + ((wgid % nig) % gsz); u.pn = (wgid % nig) / gsz; return true;
    }
    __device__ __forceinline__ void a_ready(const Unit&) const {}
    __device__ __forceinline__ void done(const Unit&) const {}
};

#define PG8_MFMA(a, b, c) __builtin_amdgcn_mfma_f32_16x16x32_f16(__builtin_bit_cast(h16x8, (a)), __builtin_bit_cast(h16x8, (b)), (c), 0, 0, 0)
struct EpiOutProj {
    static constexpr bool PERM = false, AFTER_DRAIN = false;
    const float* x; u16* x1h;
    __device__ __forceinline__ void operator()(const f32x4 (&acc)[2][2][4][2], const Unit& u, int wr, int wc, int fr, int fq) const {
        const int col0 = u.pn * BM + wc * 32 + 4 * fq;
#pragma unroll
        for (int ai = 0; ai < 2; ++ai) {
            f32x4 xr[4][2][2];
#pragma unroll
            for (int m = 0; m < 4; ++m) {
                const size_t off = (size_t)(u.pm * BM + ai * HALF + wr * 64 + m * 16 + fr) * DM + col0;
#pragma unroll
                for (int bj = 0; bj < 2; ++bj)
#pragma unroll
                    for (int n = 0; n < 2; ++n) xr[m][bj][n] = *(const f32x4*)(x + off + bj * HALF + n * 16);
            }
#pragma unroll
            for (int m = 0; m < 4; ++m) {
                const int row = u.pm * BM + ai * HALF + wr * 64 + m * 16 + fr;
                const size_t off = (size_t)row * DM + col0;
#pragma unroll
                for (int bj = 0; bj < 2; ++bj)
#pragma unroll
                    for (int n = 0; n < 2; ++n) {
                        const f32x4 v = acc[ai][bj][m][n] + xr[m][bj][n];
                        u32x2 w; w.x = pkh(v[0], v[1]); w.y = pkh(v[2], v[3]);
                        *(u32x2*)(x1h + off + bj * HALF + n * 16) = w;
                    }
            }
        }
    }
};
struct EpiUp {
    static constexpr bool PERM = true, AFTER_DRAIN = false;
    unsigned char* hid; const float* rowfac; const float* t1col;
    __device__ __forceinline__ void operator()(const f32x4 (&acc)[2][2][4][2], const Unit& u, int wr, int wc, int fr, int fq) const {
        const int col0 = u.pn * BM + wc * 32 + 8 * fq;
        float rf[2][4]; f32x4 tc[2][2];
#pragma unroll
        for (int ai = 0; ai < 2; ++ai)
#pragma unroll
            for (int m = 0; m < 4; ++m) rf[ai][m] = rowfac[u.pm * BM + ai * HALF + wr * 64 + m * 16 + fr];
#pragma unroll
        for (int bj = 0; bj < 2; ++bj) { tc[bj][0] = *(const f32x4*)(t1col + col0 + bj * HALF); tc[bj][1] = *(const f32x4*)(t1col + col0 + bj * HALF + 4); }
#pragma unroll
        for (int ai = 0; ai < 2; ++ai)
#pragma unroll
            for (int m = 0; m < 4; ++m) {
                const int row = u.pm * BM + ai * HALF + wr * 64 + m * 16 + fr;
                const float rs = rf[ai][m];
                unsigned char* rowp = hid + (size_t)row * FF + col0;
#pragma unroll
                for (int bj = 0; bj < 2; ++bj) {
                    const i32x4 i0 = __builtin_bit_cast(i32x4, acc[ai][bj][m][0]), i1 = __builtin_bit_cast(i32x4, acc[ai][bj][m][1]);
                    f32x4 v0, v1;
#pragma unroll
                    for (int e = 0; e < 4; ++e) {
                        const float a = fmaxf((float)i0[e] * (rs * tc[bj][0][e]), 0.f), b = fmaxf((float)i1[e] * (rs * tc[bj][1][e]), 0.f);
                        v0[e] = fminf(a * a, F8_MAX); v1[e] = fminf(b * b, F8_MAX);
                    }
                    u32x2 w; w.x = pkf8x4(v0[0], v0[1], v0[2], v0[3]); w.y = pkf8x4(v1[0], v1[1], v1[2], v1[3]);
                    *(u32x2*)(rowp + bj * HALF) = w;
                }
            }
    }
};
struct EpiDown {
    static constexpr bool PERM = false, AFTER_DRAIN = false;
    float* out; const u16* x1h;
    __device__ __forceinline__ void operator()(const f32x4 (&acc)[2][2][4][2], const Unit& u, int wr, int wc, int fr, int fq) const {
        const int col0 = u.pn * BM + wc * 32 + 4 * fq;
        constexpr float DS = 1.0f / (HID_SCALE * W2_SCALE);
#pragma unroll
        for (int ai = 0; ai < 2; ++ai) {
            u32x2 xr[4][2][2];
#pragma unroll
            for (int m = 0; m < 4; ++m) {
                const size_t off = (size_t)(u.pm * BM + ai * HALF + wr * 64 + m * 16 + fr) * DM + col0;
#pragma unroll
                for (int bj = 0; bj < 2; ++bj)
#pragma unroll
                    for (int n = 0; n < 2; ++n) xr[m][bj][n] = *(const u32x2*)(x1h + off + bj * HALF + n * 16);
            }
#pragma unroll
            for (int m = 0; m < 4; ++m) {
                const size_t off = (size_t)(u.pm * BM + ai * HALF + wr * 64 + m * 16 + fr) * DM + col0;
#pragma unroll
                for (int bj = 0; bj < 2; ++bj)
#pragma unroll
                    for (int n = 0; n < 2; ++n) {
                        const h16x4 r = __builtin_bit_cast(h16x4, xr[m][bj][n]);
                        f32x4 o = acc[ai][bj][m][n]; o[0] = o[0] * DS + (float)r[0]; o[1] = o[1] * DS + (float)r[1]; o[2] = o[2] * DS + (float)r[2]; o[3] = o[3] * DS + (float)r[3];
                        *(f32x4*)(out + off + bj * HALF + n * 16) = o;
                    }
            }
        }
    }
};
struct EpiInProj {
    static constexpr bool PERM = true, AFTER_DRAIN = false;
    unsigned char* ws; const float* qg; const float* kg;
    __device__ __forceinline__ void operator()(const f32x4 (&acc)[2][2][4][2], const Unit& u, int wr, int wc, int fr, int fq) const {
        const int pn = u.pn;
        const bool normed = (pn < 2) || (pn < 5 && wc < 2);
        float gn[2][8];
        if (normed) {
            const float* gp = pn < 2 ? qg : kg;
#pragma unroll
            for (int bj = 0; bj < 2; ++bj) { const f32x4 a = *(const f32x4*)(gp + 32 * bj + 8 * fq), b = *(const f32x4*)(gp + 32 * bj + 8 * fq + 4);
#pragma unroll
                for (int e = 0; e < 4; ++e) { gn[bj][e] = a[e]; gn[bj][4 + e] = b[e]; } }
        }
        float lbv[2][8];
        if (pn == 7 || pn == 8) {
            const float* lp = (const float*)(ws + WS_LB) + 256 * (pn - 7) + 64 * wc + 8 * fq;
#pragma unroll
            for (int bj = 0; bj < 2; ++bj) { const f32x4 a = *(const f32x4*)(lp + 32 * bj), b = *(const f32x4*)(lp + 32 * bj + 4);
#pragma unroll
                for (int e = 0; e < 4; ++e) { lbv[bj][e] = a[e]; lbv[bj][4 + e] = b[e]; } }
        }
#pragma unroll
        for (int ai = 0; ai < 2; ++ai) {
            f32x4 rpv[4][4];
#pragma unroll
            for (int m = 0; m < 4; ++m) {
                if (normed && (m & 1) == 0) {
#pragma unroll
                    for (int mm = m; mm < m + 2; ++mm) { const int t_ = (u.pm * BM + ai * HALF + wr * 64 + mm * 16 + fr) & (SEQ - 1); const f32x4* rp_ = (const f32x4*)((const float*)(ws + WS_ROPE) + (size_t)t_ * 16);
#pragma unroll
                        for (int q4 = 0; q4 < 4; ++q4) rpv[mm][q4] = rp_[q4]; }
                }
                const int row = u.pm * BM + ai * HALF + wr * 64 + m * 16 + fr;
                const int b = row >> 13, t = row & (SEQ - 1);
                float v[2][8];
#pragma unroll
                for (int bj = 0; bj < 2; ++bj)
#pragma unroll
                    for (int e = 0; e < 4; ++e) { v[bj][e] = acc[ai][bj][m][0][e]; v[bj][4 + e] = acc[ai][bj][m][1][e]; }
                if (normed) {
                    float ss = 0.f;
#pragma unroll
                    for (int bj = 0; bj < 2; ++bj)
#pragma unroll
                        for (int e = 0; e < 8; ++e) ss += v[bj][e] * v[bj][e];
                    ss += __shfl_xor(ss, 16); ss += __shfl_xor(ss, 32);
                    const float rstd = 1.0f / sqrtf(ss * (1.0f / 64.f) + EPS);
#pragma unroll
                    for (int bj = 0; bj < 2; ++bj)
#pragma unroll
                        for (int e = 0; e < 8; ++e) v[bj][e] = v[bj][e] * rstd * gn[bj][e];
                    const f32x4 r0 = rpv[m][0], r1 = rpv[m][1], r2 = rpv[m][2], r3 = rpv[m][3];
                    const float cs[8] = {r0[0], r0[2], r1[0], r1[2], r2[0], r2[2], r3[0], r3[2]};
                    const float sn[8] = {r0[1], r0[3], r1[1], r1[3], r2[1], r2[3], r3[1], r3[3]};
#pragma unroll
                    for (int e = 0; e < 8; ++e) {
                        const float other = __shfl_xor(v[0][e], 16);
                        const float r1v = v[0][e] * cs[e] - other * sn[e];
                        const float r2v = v[0][e] * cs[e] + other * sn[e];
                        v[0][e] = fq == 0 ? r1v : (fq == 1 ? r2v : v[0][e]);
                    }
                    const float sc = pn < 2 ? 0.125f * 1.4426950408889634f : 1.0f;
                    u16* dst;
                    if (pn < 2) dst = (u16*)(ws + WS_Q) + (size_t)row * 512 + (4 * pn + wc) * 64 + 8 * fq;
                    else dst = (u16*)(ws + (pn == 2 ? WS_KC : pn == 3 ? WS_KS : WS_KW)) + ((size_t)(b * NG + wc) * SEQ + t) * 64 + 8 * fq;
#pragma unroll
                    for (int bj = 0; bj < 2; ++bj) {
                        u32x4 w; w.x = pkh(v[bj][0] * sc, v[bj][1] * sc); w.y = pkh(v[bj][2] * sc, v[bj][3] * sc); w.z = pkh(v[bj][4] * sc, v[bj][5] * sc); w.w = pkh(v[bj][6] * sc, v[bj][7] * sc);
                        *(u32x4*)(dst + 32 * bj) = w;
                    }
                } else if (pn < 5) {
                    const int g = wc - 2;
                    if (pn == 2) {
                        u16* dst = (u16*)(ws + WS_VC) + ((size_t)(b * NG + g) * SEQ + t) * 64 + 8 * fq;
#pragma unroll
                        for (int bj = 0; bj < 2; ++bj) {
                            u32x4 w; w.x = pkh(v[bj][0], v[bj][1]); w.y = pkh(v[bj][2], v[bj][3]); w.z = pkh(v[bj][4], v[bj][5]); w.w = pkh(v[bj][6], v[bj][7]);
                            *(u32x4*)(dst + 32 * bj) = w;
                        }
                    } else {
                        u16* dst = (u16*)(ws + (pn == 3 ? WS_VST : WS_VWT)) + (((size_t)(b * NG + g) * 128 + (t >> 6)) * 64 + 8 * fq) * 64 + (t & 63);
#pragma unroll
                        for (int bj = 0; bj < 2; ++bj)
#pragma unroll
                            for (int e = 0; e < 8; ++e) dst[(32 * bj + e) * 64] = f2h(v[bj][e]);
                    }
                } else if (pn < 13) {
                    const int kind = (pn - 5) >> 1;
                    const int col = 256 * ((pn - 5) & 1) + 64 * wc + 8 * fq;
                    u16* dst = (u16*)(ws + (kind == 0 ? WS_HQ : kind == 1 ? WS_HLOGF : kind == 2 ? WS_HV : WS_HG)) + (size_t)row * 512 + col;
#pragma unroll
                    for (int bj = 0; bj < 2; ++bj) {
                        float o[8];
#pragma unroll
                        for (int e = 0; e < 8; ++e) {
                            const float x = v[bj][e];
                            if (kind == 0 || kind == 3) o[e] = x * sigmoid_f(x);
                            else if (kind == 1) { const float l = lbv[bj][e]; o[e] = __logf(l + (1.f - l) * sigmoid_f(x)); }
                            else o[e] = x;
                        }
                        u32x4 w;
                        if (kind == 0 || kind == 2) { w.x = pkb(o[0], o[1]); w.y = pkb(o[2], o[3]); w.z = pkb(o[4], o[5]); w.w = pkb(o[6], o[7]); }
                        else { w.x = pkh(o[0], o[1]); w.y = pkh(o[2], o[3]); w.z = pkh(o[4], o[5]); w.w = pkh(o[6], o[7]); }
                        *(u32x4*)(dst + 32 * bj) = w;
                    }
                } else {
                    if (wc == 0 && fq < 3) {
                        float* dst = (float*)(ws + WS_GATES) + (size_t)row * 24 + 8 * fq;
                        f32x4 a, c;
#pragma unroll
                        for (int e = 0; e < 4; ++e) { a[e] = sigmoid_f(v[0][e]); c[e] = sigmoid_f(v[0][4 + e]); }
                        *(f32x4*)dst = a; *(f32x4*)(dst + 4) = c;
                    }
                }
            }
        }
    }
};
template <class Epi, class Sched, bool ALIGN_EPI = false, bool SP2 = false, int MODE = 0>
__device__ __forceinline__ void gemm_phase(PG8_LAS unsigned char* lds, const Gemm g, const Sched& S, const Epi& E, int wave_in) {
    const int tid = threadIdx.x, wid = __builtin_amdgcn_readfirstlane(tid >> 6), lane = tid & 63, wr = wid >> 2, wc = wid & 3, fr = lane & 15, fq = lane >> 4;
    const int K = g.K, nt = K / BK;
    unsigned voffA[2], voffB[2];
#pragma unroll
    for (int i = 0; i < 2; ++i) { int R, C; stage_rc(tid * 16 + i * 8192, R, C); const int Rb = Epi::PERM ? ((R & ~31) + perm32(R & 31)) : R;
        voffA[i] = (unsigned)(R * K + C) * 2u; voffB[i] = (unsigned)(Rb * K + C) * 2u; }
    const size_t kstep = (size_t)(BK * 2);
    const size_t hstep = (size_t)HALF * K * 2;
    const size_t tstep = 2 * hstep;
    const unsigned ldsw = (unsigned)wid * 1024u;
    const int aoff = lds_byte(wr * 64 + fr, fq * 8), boff = lds_byte(wc * 32 + fr, fq * 8);
#define PG8_SA(b, h) (((b) * 2 + (h)) * HTB)
#define PG8_SB(b, h) ((4 + (b) * 2 + (h)) * HTB)
#define PG8_STAGE(bufoff, gbase, voff) do { _Pragma("unroll") for (int _i = 0; _i < 2; ++_i) \
        __builtin_amdgcn_global_load_lds((const unsigned*)((const char*)(gbase) + (voff)[_i]), (PG8_LAS unsigned*)(lds + (bufoff) + ldsw + _i * 8192), 16, 0, 0); } while (0)
#define PG8_LDA(dst, b, h) do { _Pragma("unroll") for (int m = 0; m < 4; ++m) _Pragma("unroll") for (int k = 0; k < 2; ++k) dst[m][k] = *(const PG8_LAS bf16x8*)(lds + PG8_SA(b, h) + aoff + m * 2048 + k * 1024); } while (0)
#define PG8_LDB(dst, b, h) do { _Pragma("unroll") for (int n = 0; n < 2; ++n) _Pragma("unroll") for (int k = 0; k < 2; ++k) dst[n][k] = *(const PG8_LAS bf16x8*)(lds + PG8_SB(b, h) + boff + n * 2048 + k * 1024); } while (0)
#define PG8_CAT(x0, x1) __builtin_shufflevector(__builtin_bit_cast(i32x4, (x0)), __builtin_bit_cast(i32x4, (x1)), 0, 1, 2, 3, 4, 5, 6, 7)
#define PG8_MMA(ai, bj, At, Bt) do { __builtin_amdgcn_s_setprio(1); _Pragma("unroll") for (int m = 0; m < 4; ++m) _Pragma("unroll") for (int n = 0; n < 2; ++n) { \
        if constexpr (MODE == 1) asm volatile("v_mfma_scale_f32_16x16x128_f8f6f4 %0, %1, %2, %0, %3, %3 op_sel_hi:[0,0,0]" : "+v"(acc[ai][bj][m][n]) : "v"(PG8_CAT(Bt[n][0], Bt[n][1])), "v"(PG8_CAT(At[m][0], At[m][1])), "v"(mxs)); \
        else if constexpr (MODE == 2) { _Pragma("unroll") for (int k = 0; k < 2; ++k) acc[ai][bj][m][n] = __builtin_bit_cast(f32x4, __builtin_amdgcn_mfma_i32_16x16x64_i8(__builtin_bit_cast(i32x4, Bt[n][k]), __builtin_bit_cast(i32x4, At[m][k]), __builtin_bit_cast(i32x4, acc[ai][bj][m][n]), 0, 0, 0)); } \
        else { _Pragma("unroll") for (int k = 0; k < 2; ++k) acc[ai][bj][m][n] = PG8_MFMA(Bt[n][k], At[m][k], acc[ai][bj][m][n]); } } __builtin_amdgcn_s_setprio(0); } while (0)
#define PG8_WAIT_V(n) asm volatile("s_waitcnt vmcnt(" #n ")" ::: "memory")
#define PG8_WAIT_L(n) asm volatile("s_waitcnt lgkmcnt(" #n ")" ::: "memory")
#define PG8_BAR __builtin_amdgcn_s_barrier()
#define PG8_SCHED __builtin_amdgcn_sched_barrier(0)
    const int mxs = 0x7F7F7F7F;
    Unit cur, nxt; int ui = 0;
    if (!S.next(0, cur)) return;
    f32x4 acc[2][2][4][2];
#pragma unroll
    for (int a = 0; a < 2; ++a)
#pragma unroll
        for (int b = 0; b < 2; ++b)
#pragma unroll
            for (int m = 0; m < 4; ++m)
#pragma unroll
                for (int n = 0; n < 2; ++n) acc[a][b][m][n] = (f32x4){0.f, 0.f, 0.f, 0.f};
    bf16x8 At[4][2], B0[2][2], B1[2][2];
    const char* cA = (const char*)g.A + (size_t)cur.pm * tstep; const char* cB = (const char*)g.Bt + (size_t)cur.pn * tstep;
    S.a_ready(cur);
    if constexpr (SP2) {
        PG8_STAGE(PG8_SB(0, 0), cB, voffB); PG8_STAGE(PG8_SB(0, 1), cB + hstep, voffB); PG8_STAGE(PG8_SA(0, 0), cA, voffA); PG8_STAGE(PG8_SA(0, 1), cA + hstep, voffA);
        if (wr == 1) PG8_BAR;
        PG8_WAIT_V(2); PG8_BAR;
        PG8_STAGE(PG8_SB(1, 0), cB + kstep, voffB); PG8_STAGE(PG8_SA(1, 0), cA + kstep, voffA); PG8_STAGE(PG8_SB(1, 1), cB + hstep + kstep, voffB);
        PG8_WAIT_V(6); PG8_BAR;
    } else {
        PG8_STAGE(PG8_SB(0, 0), cB, voffB); PG8_STAGE(PG8_SA(0, 0), cA, voffA); PG8_STAGE(PG8_SB(0, 1), cB + hstep, voffB); PG8_STAGE(PG8_SA(0, 1), cA + hstep, voffA);
        if (wr == 1) PG8_BAR;
        PG8_WAIT_V(4); PG8_BAR;
        PG8_STAGE(PG8_SB(1, 0), cB + kstep, voffB); PG8_STAGE(PG8_SA(1, 0), cA + kstep, voffA); PG8_STAGE(PG8_SB(1, 1), cB + hstep + kstep, voffB);
        PG8_WAIT_V(6); PG8_BAR;
    }
    for (;;) {
        const bool has_next = S.next(ui + 1, nxt);
        const char* nA = has_next ? (const char*)g.A + (size_t)nxt.pm * tstep : cA; const char* nB = has_next ? (const char*)g.Bt + (size_t)nxt.pn * tstep : cB;
        for (int t = 0; t < nt; t += 2) {
            const bool last = (t == nt - 2);
            const char* a1 = cA + (size_t)(t + 1) * kstep;
            const char* a2 = last ? nA : cA + (size_t)(t + 2) * kstep; const char* b2 = last ? nB : cB + (size_t)(t + 2) * kstep;
            const char* a3 = a2 + kstep; const char* b3 = b2 + kstep;
            if (last && has_next) S.a_ready(nxt);
            if constexpr (SP2) {
            PG8_LDB(B0, 0, 0); PG8_LDB(B1, 0, 1); PG8_SCHED; PG8_LDA(At, 0, 0); PG8_STAGE(PG8_SA(1, 1), a1 + hstep, voffA);
            PG8_WAIT_V(8); PG8_WAIT_L(0); PG8_BAR; PG8_MMA(0, 0, At, B0); PG8_MMA(0, 1, At, B1); PG8_BAR; PG8_SCHED;
            PG8_LDA(At, 0, 1); PG8_STAGE(PG8_SB(0, 0), b2, voffB); PG8_STAGE(PG8_SB(0, 1), b2 + hstep, voffB); PG8_STAGE(PG8_SA(0, 0), a2, voffA);
            PG8_WAIT_V(8); PG8_WAIT_L(0); PG8_BAR; PG8_MMA(1, 0, At, B0); PG8_MMA(1, 1, At, B1); PG8_BAR; PG8_SCHED;
            PG8_LDB(B0, 1, 0); PG8_LDB(B1, 1, 1); PG8_SCHED; PG8_LDA(At, 1, 0); PG8_STAGE(PG8_SA(0, 1), a2 + hstep, voffA);
            PG8_WAIT_V(8); PG8_WAIT_L(0); PG8_BAR; PG8_MMA(0, 0, At, B0); PG8_MMA(0, 1, At, B1); PG8_BAR; PG8_SCHED;
            PG8_LDA(At, 1, 1); PG8_STAGE(PG8_SB(1, 0), b3, voffB); PG8_STAGE(PG8_SB(1, 1), b3 + hstep, voffB); PG8_STAGE(PG8_SA(1, 0), a3, voffA);
            PG8_WAIT_V(8); PG8_WAIT_L(0); PG8_BAR; PG8_MMA(1, 0, At, B0); PG8_MMA(1, 1, At, B1); PG8_BAR; PG8_SCHED;
            } else {
            PG8_LDB(B0, 0, 0); PG8_SCHED; PG8_LDA(At, 0, 0); PG8_STAGE(PG8_SA(1, 1), a1 + hstep, voffA);
            PG8_WAIT_L(8); PG8_BAR; PG8_WAIT_L(0); PG8_MMA(0, 0, At, B0); PG8_BAR; PG8_SCHED;
            PG8_LDB(B1, 0, 1); PG8_STAGE(PG8_SB(0, 0), b2, voffB);
            PG8_BAR; PG8_WAIT_L(0); PG8_MMA(0, 1, At, B1); PG8_BAR;
            PG8_LDA(At, 0, 1); PG8_STAGE(PG8_SA(0, 0), a2, voffA);
            PG8_BAR; PG8_WAIT_L(0); PG8_MMA(1, 0, At, B0); PG8_BAR; PG8_SCHED;
            PG8_STAGE(PG8_SB(0, 1), b2 + hstep, voffB);
            PG8_WAIT_V(6); PG8_BAR; PG8_MMA(1, 1, At, B1); PG8_BAR;
            PG8_LDB(B0, 1, 0); PG8_SCHED; PG8_LDA(At, 1, 0); PG8_STAGE(PG8_SA(0, 1), a2 + hstep, voffA);
            PG8_WAIT_L(8); PG8_BAR; PG8_WAIT_L(0); PG8_MMA(0, 0, At, B0); PG8_BAR; PG8_SCHED;
            PG8_LDB(B1, 1, 1); PG8_STAGE(PG8_SB(1, 0), b3, voffB);
            PG8_BAR; PG8_WAIT_L(0); PG8_MMA(0, 1, At, B1); PG8_BAR;
            PG8_LDA(At, 1, 1); PG8_STAGE(PG8_SA(1, 0), a3, voffA);
            PG8_BAR; PG8_WAIT_L(0); PG8_MMA(1, 0, At, B0); PG8_BAR; PG8_SCHED;
            PG8_STAGE(PG8_SB(1, 1), b3 + hstep, voffB);
            PG8_WAIT_V(6); PG8_BAR; PG8_MMA(1, 1, At, B1); PG8_BAR;
            }
        }
        if constexpr (MODE == 1) asm volatile("s_nop 15\n\ts_nop 15" ::: "memory");
        if constexpr (ALIGN_EPI) { if (wr == 0) PG8_BAR; }
        if constexpr (!Epi::AFTER_DRAIN) { E(acc, cur, wr, wc, fr, fq); S.done(cur); }
        if (!has_next) break;
#pragma unroll
        for (int a = 0; a < 2; ++a)
#pragma unroll
            for (int b = 0; b < 2; ++b)
#pragma unroll
                for (int m = 0; m < 4; ++m)
#pragma unroll
                    for (int n = 0; n < 2; ++n) acc[a][b][m][n] = (f32x4){0.f, 0.f, 0.f, 0.f};
        cur = nxt; cA = nA; cB = nB; ++ui;
        if constexpr (ALIGN_EPI) { if (wr == 1) PG8_BAR; }
    }
    PG8_WAIT_V(0);
    if constexpr (!ALIGN_EPI) { if (wr == 0) PG8_BAR; }
    PG8_BAR;
    if constexpr (Epi::AFTER_DRAIN) { E.fused(acc, cur, wr, wc, fr, fq, lds, wid, lane); S.done(cur); }
#undef PG8_SA
#undef PG8_SB
#undef PG8_STAGE
#undef PG8_LDA
#undef PG8_LDB
#undef PG8_MMA
#undef PG8_CAT
#undef PG8_WAIT_V
#undef PG8_WAIT_L
#undef PG8_BAR
#undef PG8_SCHED
}
}
#define LDS_WAIT() asm volatile("s_waitcnt lgkmcnt(0)" ::: "memory")
#define VM_WAIT() asm volatile("s_waitcnt vmcnt(0)" ::: "memory")

struct Params {
    const float* in[18];
    float* out;
    unsigned char* ws;
    float invf[8];
    int ph_lo, ph_hi;
};

__device__ __forceinline__ void sincos_acc(float ang, float& s, float& c) {
    const double x = (double)ang;
    const double k = rint(x * 0.6366197723675814);
    double r = fma(-k, 1.5707963267948966, x); r = fma(-k, 6.123233995736766e-17, r);
    const int q = ((int)k) & 3;
    const double r2 = r * r;
    const double sp = r * (1.0 + r2 * (-1.0 / 6 + r2 * (1.0 / 120 + r2 * (-1.0 / 5040 + r2 * (1.0 / 362880 + r2 * (-1.0 / 39916800 + r2 * (1.0 / 6227020800.0)))))));
    const double cp = 1.0 + r2 * (-0.5 + r2 * (1.0 / 24 + r2 * (-1.0 / 720 + r2 * (1.0 / 40320 + r2 * (-1.0 / 3628800 + r2 * (1.0 / 479001600.0 + r2 * (-1.0 / 87178291200.0)))))));
    double ss, cc;
    if (q == 0) { ss = sp; cc = cp; } else if (q == 1) { ss = cp; cc = -sp; } else if (q == 2) { ss = -sp; cc = -cp; } else { ss = -cp; cc = sp; }
    s = (float)ss; c = (float)cc;
}

struct ColId { __device__ __forceinline__ int operator()(int n) const { return n; } };
struct ColWin {
    __device__ __forceinline__ int operator()(int P) const {
        const int pn = P >> 8, p = P & 255, bj = p >> 7, wc = (p >> 5) & 3, j = p & 31;
        const int Lp = 256 * pn + 64 * wc + 32 * bj + j;
        return Lp < 1280 ? Lp : (Lp < 3328 ? Lp + 24 : (Lp < 3352 ? Lp - 3328 + 1280 : -1));
    }
};
template <class SrcCol, bool F8 = false>
__device__ __forceinline__ void p0_transpose_item(const float* __restrict__ W, int K, int Nsrc, u16* WT, const float* rowscale, SrcCol sc, LAS float* scr, int kb, int nb, int lane) {
    const int k0 = 64 * kb, n0 = 32 * nb;
    const int scol = sc(n0 + (lane & 31));
#pragma unroll
    for (int i = 0; i < 32; ++i) {
        const int kk = 2 * i + (lane >> 5);
        float v = scol >= 0 ? W[(size_t)(k0 + kk) * Nsrc + scol] : 0.f;
        if (rowscale) v *= rowscale[k0 + kk];
        scr[kk * 33 + (lane & 31)] = v;
    }
    LDS_WAIT(); asm volatile("" ::: "memory");
    const int c = lane & 7;
#pragma unroll
    for (int j = 0; j < 4; ++j) {
        const int n = (lane >> 3) + 8 * j; const LAS float* s = scr + (8 * c) * 33 + n;
        if constexpr (F8) {
            u32x2 o; o.x = pkf8x4(clamp8(s[0 * 33] * W2_SCALE), clamp8(s[1 * 33] * W2_SCALE), clamp8(s[2 * 33] * W2_SCALE), clamp8(s[3 * 33] * W2_SCALE));
            o.y = pkf8x4(clamp8(s[4 * 33] * W2_SCALE), clamp8(s[5 * 33] * W2_SCALE), clamp8(s[6 * 33] * W2_SCALE), clamp8(s[7 * 33] * W2_SCALE));
            *(u32x2*)((unsigned char*)WT + (size_t)(n0 + n) * K + k0 + 8 * c) = o;
        } else {
        u32x4 o; o.x = pkh(s[0 * 33], s[1 * 33]); o.y = pkh(s[2 * 33], s[3 * 33]); o.z = pkh(s[4 * 33], s[5 * 33]); o.w = pkh(s[6 * 33], s[7 * 33]);
        *(u32x4*)(WT + (size_t)(n0 + n) * K + k0 + 8 * c) = o;
        }
    }
    LDS_WAIT(); asm volatile("" ::: "memory");
}

__device__ __forceinline__ void p0_late_transposes(const Params& p, LAS unsigned char* lds, int gw, int NGW, int wave, int lane) {
    unsigned char* ws = p.ws;
    LAS float* scr = (LAS float*)(lds + wave * 16384);
    constexpr int I_WOUT = 16 * 32, I_W1 = 16 * (FF / 32), I_W2 = (FF / 64) * 32, I_C1 = 32 * 4, I_C2 = 2 * 2;
    constexpr int NITEMS = I_WOUT + I_W1 + I_W2 + 2 * I_C1 + 2 * I_C2;
    for (int it = gw; it < NITEMS; it += NGW) {
        int r = it;
        if (r < I_C1) { p0_transpose_item(p.in[6], 2048, 128, (u16*)(ws + WS_CW1K_T), nullptr, ColId(), scr, r / 4, r % 4, lane); continue; } r -= I_C1;
        if (r < I_C1) { p0_transpose_item(p.in[9], 2048, 128, (u16*)(ws + WS_CW1V_T), nullptr, ColId(), scr, r / 4, r % 4, lane); continue; } r -= I_C1;
        if (r < I_C2) { p0_transpose_item(p.in[7], 128, 64, (u16*)(ws + WS_CW2K_T), nullptr, ColId(), scr, r / 2, r % 2, lane); continue; } r -= I_C2;
        if (r < I_C2) { p0_transpose_item(p.in[10], 128, 64, (u16*)(ws + WS_CW2V_T), nullptr, ColId(), scr, r / 2, r % 2, lane); continue; } r -= I_C2;
        if (r < I_WOUT) { p0_transpose_item(p.in[14], DM, DM, (u16*)(ws + WS_WOUT_T), nullptr, ColId(), scr, r / 32, r % 32, lane); continue; } r -= I_WOUT;
        if (r < I_W1) { p0_transpose_item(p.in[16], DM, FF, (u16*)(ws + WS_W1_T), p.in[15], ColId(), scr, r / (FF / 32), r % (FF / 32), lane); continue; } r -= I_W1;
        p0_transpose_item<ColId, true>(p.in[17], FF, DM, (u16*)(ws + WS_W2_T), nullptr, ColId(), scr, r / 32, r % 32, lane);
    }
}
__device__ __forceinline__ void p0_prologue(const Params& p, LAS unsigned char* lds, int gw, int NGW, int wave, int lane) {
    unsigned char* ws = p.ws;
    LAS float* scr = (LAS float*)(lds + wave * 16384);
    constexpr int I_WIN = 16 * (DINP / 32);
    for (int it = gw; it < I_WIN; it += NGW) p0_transpose_item(p.in[2], DM, DIN, (u16*)(ws + WS_WIN_T), nullptr, ColWin(), scr, it / (DINP / 32), it % (DINP / 32), lane);
    {
        const float* gn = p.in[1];
        f32x4 gv[4];
#pragma unroll
        for (int j = 0; j < 4; ++j) gv[j] = ((const f32x4*)gn)[lane + 64 * j];
        for (int m = gw; m < MT; m += 4 * NGW) {
            f32x4 v[4][4]; float s[4];
#pragma unroll
            for (int r = 0; r < 4; ++r) {
                const int mr = m + r * NGW; const f32x4* xr = (const f32x4*)(p.in[0] + (size_t)(mr < MT ? mr : m) * DM) + lane;
#pragma unroll
                for (int j = 0; j < 4; ++j) v[r][j] = __builtin_nontemporal_load(xr + 64 * j);
            }
#pragma unroll
            for (int r = 0; r < 4; ++r) {
                float a = 0.f;
#pragma unroll
                for (int j = 0; j < 4; ++j) a += (v[r][j][0] * v[r][j][0] + v[r][j][1] * v[r][j][1]) + (v[r][j][2] * v[r][j][2] + v[r][j][3] * v[r][j][3]);
                s[r] = a;
            }
#pragma unroll
            for (int o = 1; o < 64; o <<= 1) {
#pragma unroll
                for (int r = 0; r < 4; ++r) s[r] += __shfl_xor(s[r], o);
            }
#pragma unroll
            for (int r = 0; r < 4; ++r) {
                const int mr = m + r * NGW;
                if (mr < MT) {
                    const float rstd = 1.0f / sqrtf(s[r] * (1.f / DM) + EPS);
                    u32x2* o8 = (u32x2*)((u16*)(ws + WS_XH) + (size_t)mr * DM) + lane;
#pragma unroll
                    for (int j = 0; j < 4; ++j) { u32x2 ww; ww.x = pkh(v[r][j][0] * rstd * gv[j][0], v[r][j][1] * rstd * gv[j][1]); ww.y = pkh(v[r][j][2] * rstd * gv[j][2], v[r][j][3] * rstd * gv[j][3]); o8[64 * j] = ww; }
                }
            }
        }
    }
    const int gt = gw * 64 + lane, NGT = NGW * 64;
    for (int i = gt; i < SEQ * 8; i += NGT) {
        const int pos = i >> 3, f = i & 7; float s, c; sincos_acc((float)pos * p.invf[f], s, c);
        ((f32x2*)(ws + WS_ROPE))[i] = (f32x2){c, s};
    }
    for (int i = gt; i < 512; i += NGT) {
        const float a = p.in[12][i], c = p.in[12][512 + i]; const float m = fmaxf(a, c); const float ea = expf(a - m), ec = expf(c - m);
        ((float*)(ws + WS_LB))[i] = ea / (ea + ec);
    }
    for (int i = gt; i < 2048; i += NGT) { ((u16*)(ws + WS_PEK))[i] = f2h(p.in[5][i]); ((u16*)(ws + WS_PEV))[i] = f2h(p.in[8][i]); }
}

#define XB_TMO      128
#define XB_XCNT(j)  (256  + 64 * (j))
#define XB_XSUB(j)  (1280 + 64 * (j))
#define XB_XGEN(j)  (2304 + 64 * (j))
#define XB_TOP      3328
#define XB_TOPGEN   3392
#define XCD_BAR_WORDS 3456
#define XB_SPIN_CAP (1u << 18)

__device__ __forceinline__ unsigned xb_ld(unsigned* p)              { return __hip_atomic_load(p, __ATOMIC_RELAXED, __HIP_MEMORY_SCOPE_AGENT); }
__device__ __forceinline__ unsigned xb_add(unsigned* p, unsigned v) { return __hip_atomic_fetch_add(p, v, __ATOMIC_RELAXED, __HIP_MEMORY_SCOPE_AGENT); }
__device__ __forceinline__ unsigned xb_xcc_id() { return (unsigned)__builtin_amdgcn_s_getreg((3 << 11) | 20) & 0xFu; }
#define XB_SPIN(cond, bar) do { unsigned _sp = 0; while (cond) { __builtin_amdgcn_s_sleep(1); \
    if ((++_sp & 255u) == 0u) { if (xb_ld(&(bar)[XB_TMO])) break; if (_sp > XB_SPIN_CAP) { atomicAdd(&(bar)[XB_TMO], 1u); break; } } } } while (0)

struct XcdBarrier {
    unsigned* bar; unsigned x;
    volatile LAS unsigned* st;
};

__device__ __forceinline__ XcdBarrier xcd_barrier_post(unsigned* bar, volatile LAS unsigned* st) {
    XcdBarrier b; b.bar = bar; b.x = xb_xcc_id(); b.st = st;
    if (threadIdx.x == 0) (void)xb_add(&bar[XB_XCNT(b.x)], 1u);
    return b;
}
__device__ __forceinline__ void xcd_barrier_complete(unsigned* bar, unsigned x, unsigned& nloc, unsigned& nx) {
    const unsigned G = gridDim.x * gridDim.y * gridDim.z;
    unsigned sum, cnt, mine, sp = 0u;
    for (;;) {
        sum = 0u; cnt = 0u; mine = 0u;
#pragma unroll
        for (unsigned j = 0; j < 16; ++j) { const unsigned c = xb_ld(&bar[XB_XCNT(j)]); sum += c; cnt += (c > 0u) ? 1u : 0u; mine = (j == x) ? c : mine; }
        if (sum == G) break;
        __builtin_amdgcn_s_sleep(1);
        if ((++sp & 255u) == 0u) { if (xb_ld(&bar[XB_TMO])) break; if (sp > XB_SPIN_CAP) { atomicAdd(&bar[XB_TMO], 1u); break; } }
    }
    nloc = mine > 0u ? mine : 1u; nx = cnt > 0u ? cnt : 1u;
}

__device__ __forceinline__ void xcd_barrier(const XcdBarrier& b) {
    asm volatile("s_waitcnt vmcnt(0)" ::: "memory");
    __syncthreads();
    if (threadIdx.x == 0) {
        unsigned* bar = b.bar;
        __builtin_amdgcn_s_waitcnt(0);
        unsigned nloc = b.st[0], nx = b.st[1];
        if (nloc == 0u) { xcd_barrier_complete(bar, b.x, nloc, nx); b.st[0] = nloc; b.st[1] = nx; }
        const unsigned old = xb_add(&bar[XB_XSUB(b.x)], 1u);
        const unsigned gen = old / nloc;
        if (old + 1u == (gen + 1u) * nloc) {
            __builtin_amdgcn_fence(__ATOMIC_RELEASE, "agent");
            asm volatile("s_waitcnt vmcnt(0)" ::: "memory");
            const unsigned og = xb_add(&bar[XB_TOP], 1u);
            const unsigned tg = og / nx;
            if (og + 1u == (tg + 1u) * nx) xb_add(&bar[XB_TOPGEN], 1u);
            else XB_SPIN(xb_ld(&bar[XB_TOPGEN]) == tg, bar);
            __builtin_amdgcn_fence(__ATOMIC_ACQUIRE, "agent");
            xb_add(&bar[XB_XGEN(b.x)], 1u);
            asm volatile("s_waitcnt vmcnt(0)" ::: "memory");
        } else {
            XB_SPIN(xb_ld(&bar[XB_XGEN(b.x)]) == gen, bar);
            __builtin_amdgcn_fence(__ATOMIC_ACQUIRE, "agent");
            asm volatile("s_waitcnt vmcnt(0)" ::: "memory");
        }
    }
    __syncthreads();
}

__device__ __forceinline__ unsigned q8x4(float a, float b, float c, float d) {
    const int ia = (int)rintf(a), ib = (int)rintf(b), ic = (int)rintf(c), id = (int)rintf(d);
    return (unsigned)(ia & 255) | ((unsigned)(ib & 255) << 8) | ((unsigned)(ic & 255) << 16) | ((unsigned)id << 24);
}
template <int NR, bool WITH_RSTD>
__device__ __forceinline__ void quant_rows(const u16* __restrict__ src, unsigned char* __restrict__ dst, float* __restrict__ fac, int r0, int rstride, int lane) {
    u32x4 v[NR][2];
#pragma unroll
    for (int i = 0; i < NR; ++i) { const u32x4* sp = (const u32x4*)(src + (size_t)(r0 + i * rstride) * 1024 + lane * 16); v[i][0] = sp[0]; v[i][1] = sp[1]; }
#pragma unroll
    for (int i = 0; i < NR; ++i) {
        float f[16];
#pragma unroll
        for (int h = 0; h < 2; ++h)
#pragma unroll
            for (int e = 0; e < 4; ++e) { const unsigned w_ = v[i][h][e]; const h16x2 t = __builtin_bit_cast(h16x2, w_);
                f[8 * h + 2 * e] = (float)t[0]; f[8 * h + 2 * e + 1] = (float)t[1]; }
        float mx = 0.f, ss = 0.f;
#pragma unroll
        for (int e = 0; e < 16; ++e) { mx = fmaxf(mx, fabsf(f[e])); ss += f[e] * f[e]; }
#pragma unroll
        for (int o = 1; o < 64; o <<= 1) { mx = fmaxf(mx, __shfl_xor(mx, o)); if (WITH_RSTD) ss += __shfl_xor(ss, o); }
        const float inv = mx > 0.f ? 127.f / mx : 0.f;
        u32x4 q;
        q.x = q8x4(f[0] * inv, f[1] * inv, f[2] * inv, f[3] * inv); q.y = q8x4(f[4] * inv, f[5] * inv, f[6] * inv, f[7] * inv);
        q.z = q8x4(f[8] * inv, f[9] * inv, f[10] * inv, f[11] * inv); q.w = q8x4(f[12] * inv, f[13] * inv, f[14] * inv, f[15] * inv);
        const int r = r0 + i * rstride;
        *(u32x4*)(dst + (size_t)r * 1024 + lane * 16) = q;
        if (lane == 0) fac[r] = WITH_RSTD ? mx * (1.0f / 127.f) * __builtin_amdgcn_rsqf(ss * (1.0f / DM) + EPS) * 2.8284271247461903f : mx * (1.0f / 127.f);
    }
}
constexpr float LOG2E = 1.4426950408889634f;
constexpr float OFF2 = 4.0f * LOG2E;
constexpr int AT_PITCH = 144;
constexpr int AT_TILE = 64 * AT_PITCH;
constexpr int AT_LDS = 4 * AT_TILE;
#define MFMA32H(a, b, c) __builtin_amdgcn_mfma_f32_32x32x16_f16((a), (b), (c), 0, 0, 0)
#define MFMA16H(a, b, c) __builtin_amdgcn_mfma_f32_16x16x32_f16((a), (b), (c), 0, 0, 0)
#define MFMA32B(a, b, c) __builtin_amdgcn_mfma_f32_32x32x16_bf16((a), (b), (c), 0, 0, 0)

#define AT_BAR() do { asm volatile("s_waitcnt lgkmcnt(0)" ::: "memory"); __builtin_amdgcn_s_barrier(); asm volatile("" ::: "memory"); } while (0)
template <int MODE>
__device__ __forceinline__ void attn_tiles(LAS unsigned char* lds, const u16* __restrict__ Kbg, const u16* __restrict__ VTbg, const h16x8 (&qf)[4], int qt, int j0, int qh, int wave, int lane,
                                           unsigned sw0, unsigned sw1, unsigned sw2, unsigned sw3, f32x16 (&o)[2], float& lsum) {
    const int tid = threadIdx.x, r32 = lane & 31, hi = lane >> 5;
    const int srow = tid >> 3, sch = tid & 7;
    const u16* ksrc = Kbg + (size_t)srow * 64 + 8 * sch;
    const u16* vsrc = VTbg + (size_t)srow * 64 + 8 * sch;
    const int sdst = srow * AT_PITCH + sch * 16;
    const int prow = (r32 & 0x13) | ((r32 & 8) >> 1) | ((r32 & 4) << 1);
    const int koff = prow * AT_PITCH + hi * 16;
    const int voff = r32 * AT_PITCH + hi * 16;
    const int qrel = 32 * qh + r32;
    u32x4 kA = *(const u32x4*)(ksrc + (size_t)j0 * 4096), vA = *(const u32x4*)(vsrc + (size_t)j0 * 4096);
    u32x4 kB = kA, vB = vA;
    if (j0 + 1 <= qt) { kB = *(const u32x4*)(ksrc + (size_t)(j0 + 1) * 4096); vB = *(const u32x4*)(vsrc + (size_t)(j0 + 1) * 4096); }
    *(LAS u32x4*)(lds + sdst) = kA; *(LAS u32x4*)(lds + 2 * AT_TILE + sdst) = vA;
    h16x8 qg0 = qf[0], qg1 = qf[1], qg2 = qf[2], qg3 = qf[3];
    asm volatile("" : "+v"(qg0), "+v"(qg1), "+v"(qg2), "+v"(qg3));
    const u32x4 onesw = {0x3c003c00u, 0x3c003c00u, 0x3c003c00u, 0x3c003c00u};
    f32x16 negoff;
#pragma unroll
    for (int i = 0; i < 16; ++i) negoff[i] = -OFF2;
    asm volatile("" : "+v"(negoff));
    f32x16 ol;
#pragma unroll
    for (int i = 0; i < 16; ++i) ol[i] = 0.f;
    AT_BAR();
    for (int j = j0; j <= qt; ++j) {
        const int buf = (j - j0) & 1;
        if (j + 2 <= qt) { kA = *(const u32x4*)(ksrc + (size_t)(j + 2) * 4096); vA = *(const u32x4*)(vsrc + (size_t)(j + 2) * 4096); }
        LAS unsigned char* kb = lds + buf * AT_TILE; LAS unsigned char* vb = lds + (2 + buf) * AT_TILE;
        bool sel = true;
        if (MODE == 1) { const unsigned w = j < 32 ? sw0 : (j < 64 ? sw1 : (j < 96 ? sw2 : sw3)); sel = (w >> (j & 31)) & 1u; }
        if (MODE == 0 || __any(sel)) {
            h16x8 kf[8];
#pragma unroll
            for (int kh = 0; kh < 2; ++kh)
#pragma unroll
                for (int d0 = 0; d0 < 4; ++d0) kf[kh * 4 + d0] = *(const LAS h16x8*)(kb + kh * 32 * AT_PITCH + koff + d0 * 32);
            __builtin_amdgcn_sched_barrier(0);
            f32x16 s[2];
#pragma unroll
            for (int kh = 0; kh < 2; ++kh) {
#pragma unroll
                for (int d0 = 0; d0 < 4; ++d0) s[kh] = MFMA32H(kf[kh * 4 + d0], (d0 == 0 ? qg0 : d0 == 1 ? qg1 : d0 == 2 ? qg2 : qg3), (d0 == 0 ? negoff : s[kh]));
            }
            h16x8 vfr[8];
#pragma unroll
            for (int dt = 0; dt < 2; ++dt)
#pragma unroll
                for (int kk = 0; kk < 4; ++kk) vfr[dt * 4 + kk] = *(const LAS h16x8*)(vb + dt * 32 * AT_PITCH + voff + kk * 32);
            __builtin_amdgcn_sched_barrier(0);
            const int dj = qt - j;
            const bool edge_hi = (dj == 0), edge_lo = (MODE == 0) && (dj == 8);
            u32x4 pw[2][2];
            if (edge_hi || edge_lo) {
#pragma unroll
                for (int kh = 0; kh < 2; ++kh)
#pragma unroll
                    for (int sp = 0; sp < 2; ++sp) {
                        float pv[8];
#pragma unroll
                        for (int e = 0; e < 8; ++e) {
                            const int kin = 32 * kh + 16 * sp + 8 * hi + e;
                            float pe = __builtin_amdgcn_exp2f(s[kh][8 * sp + e]);
                            if (edge_hi) pe = (kin <= qrel) ? pe : 0.f;
                            if (edge_lo) pe = (kin > qrel) ? pe : 0.f;
                            pv[e] = pe;
                        }
                        pw[kh][sp] = (u32x4){pkh(pv[0], pv[1]), pkh(pv[2], pv[3]), pkh(pv[4], pv[5]), pkh(pv[6], pv[7])};
                    }
            } else {
#pragma unroll
                for (int kh = 0; kh < 2; ++kh)
#pragma unroll
                    for (int sp = 0; sp < 2; ++sp) {
                        float pv[8];
#pragma unroll
                        for (int e = 0; e < 8; ++e) pv[e] = __builtin_amdgcn_exp2f(s[kh][8 * sp + e]);
                        pw[kh][sp] = (u32x4){pkh(pv[0], pv[1]), pkh(pv[2], pv[3]), pkh(pv[4], pv[5]), pkh(pv[6], pv[7])};
                    }
            }
            if (MODE == 1) {
                const unsigned mk = sel ? 0xffffffffu : 0u;
#pragma unroll
                for (int kh = 0; kh < 2; ++kh)
#pragma unroll
                    for (int sp = 0; sp < 2; ++sp) { pw[kh][sp].x &= mk; pw[kh][sp].y &= mk; pw[kh][sp].z &= mk; pw[kh][sp].w &= mk; }
            }
#pragma unroll
            for (int kh = 0; kh < 2; ++kh)
#pragma unroll
                for (int sp = 0; sp < 2; ++sp) {
                    const h16x8 pb = __builtin_bit_cast(h16x8, pw[kh][sp]);
#pragma unroll
                    for (int dt = 0; dt < 2; ++dt) o[dt] = MFMA32H(vfr[dt * 4 + 2 * kh + sp], pb, o[dt]);
                    ol = MFMA32H(__builtin_bit_cast(h16x8, onesw), pb, ol);
                }
        }
        if (j < qt) { *(LAS u32x4*)(lds + (buf ^ 1) * AT_TILE + sdst) = kB; *(LAS u32x4*)(lds + (2 + (buf ^ 1)) * AT_TILE + sdst) = vB; }
        kB = kA; vB = vA;
        AT_BAR();
    }
    lsum = 0.5f * ol[0];
}

__device__ __forceinline__ void win_unit(unsigned char* ws, LAS unsigned char* lds, int u, int wave, int lane) {
    const int qt = u & 127, bg = u >> 7, b = bg >> 1, g = bg & 1;
    const int h = wave >> 1, qh = wave & 1, r32 = lane & 31, hi = lane >> 5;
    const int t = 64 * qt + 32 * qh + r32;
    const size_t row = (size_t)b * SEQ + t;
    const u16* qp = (const u16*)(ws + WS_Q) + row * 512 + (4 * g + h) * 64 + 8 * hi;
    h16x8 qf[4];
#pragma unroll
    for (int d0 = 0; d0 < 4; ++d0) qf[d0] = *(const h16x8*)(qp + 16 * d0);
    f32x16 o[2]; float l = 0.f;
#pragma unroll
    for (int i = 0; i < 16; ++i) { o[0][i] = 0.f; o[1][i] = 0.f; }
    const int j0 = qt > 8 ? qt - 8 : 0;
    attn_tiles<0>(lds, (const u16*)(ws + WS_KW) + (size_t)bg * SEQ * 64, (const u16*)(ws + WS_VWT) + (size_t)bg * 64 * SEQ, qf, qt, j0, qh, wave, lane, 0u, 0u, 0u, 0u, o, l);
    l += __shfl_xor(l, 32);
    const float sc = ((const float*)(ws + WS_GATES))[row * 24 + (4 * g + h) * 3 + 2] / l;
    u16* dst = (u16*)(ws + WS_OWIN) + row * 512 + (4 * g + h) * 64 + 4 * hi;
#pragma unroll
    for (int dt = 0; dt < 2; ++dt)
#pragma unroll
        for (int r4 = 0; r4 < 4; ++r4) {
            u32x2 w; w.x = pkh(o[dt][4 * r4] * sc, o[dt][4 * r4 + 1] * sc); w.y = pkh(o[dt][4 * r4 + 2] * sc, o[dt][4 * r4 + 3] * sc);
            *(u32x2*)(dst + 32 * dt + 8 * r4) = w;
        }
}

constexpr int CM_SP = 132, CM_HP = 136;
__device__ __forceinline__ void cmp_mlp_unit(unsigned char* ws, LAS unsigned char* lds, int u, int wave, int lane) {
    const int mt = u & 31, bg = (u >> 5) & 3, kv = u >> 7;
    const int tid = threadIdx.x, r = lane & 15, quad = lane >> 4;
    LAS float* slab = (LAS float*)lds;
    LAS u16* hb = (LAS u16*)(lds + 8 * 16 * CM_SP * 4);
    const u16* src = (const u16*)(ws + (kv ? WS_VC : WS_KC)) + (size_t)bg * SEQ * 64;
    const u16* pe = (const u16*)(ws + (kv ? WS_PEV : WS_PEK));
    const u16* w1t = (const u16*)(ws + (kv ? WS_CW1V_T : WS_CW1K_T));
    const int n = 16 * mt + r;
    const int nc = n < NCMP ? n : NCMP - 1;
    const u16* arow = src + (size_t)nc * 1024 + 8 * quad;
    const u16* brow = w1t + (size_t)r * 2048 + 8 * quad;
    f32x4 acc[8];
#pragma unroll
    for (int c = 0; c < 8; ++c) acc[c] = (f32x4){0.f, 0.f, 0.f, 0.f};
    const int kbase = 256 * wave;
#pragma unroll 1
    for (int hf = 0; hf < 2; ++hf) {
#pragma unroll
        for (int st = 0; st < 4; ++st) {
            const int k0 = kbase + 32 * (4 * hf + st);
            const h16x8 av = *(const h16x8*)(arow + k0) + *(const h16x8*)(pe + k0 + 8 * quad);
#pragma unroll
            for (int c = 0; c < 8; ++c) { const h16x8 bf = *(const h16x8*)(brow + (size_t)(16 * c) * 2048 + k0); acc[c] = MFMA16H(av, bf, acc[c]); }
        }
    }
#pragma unroll
    for (int c = 0; c < 8; ++c)
#pragma unroll
        for (int i = 0; i < 4; ++i) slab[(wave * 16 + 4 * quad + i) * CM_SP + 16 * c + r] = acc[c][i];
    AT_BAR();
#pragma unroll
    for (int jj = 0; jj < 4; ++jj) {
        const int idx = tid + NTHREADS * jj, row = idx >> 7, col = idx & 127;
        float x = 0.f;
#pragma unroll
        for (int w8 = 0; w8 < 8; ++w8) x += slab[(w8 * 16 + row) * CM_SP + col];
        hb[row * CM_HP + col] = f2h(x * sigmoid_f(x));
    }
    AT_BAR();
    if (wave < 4) {
        const u16* w2t = (const u16*)(ws + (kv ? WS_CW2V_T : WS_CW2K_T)) + (size_t)(16 * wave + r) * 128 + 8 * quad;
        f32x4 oc = {0.f, 0.f, 0.f, 0.f};
#pragma unroll
        for (int ks = 0; ks < 4; ++ks) {
            const h16x8 af = *(const LAS h16x8*)(hb + r * CM_HP + 32 * ks + 8 * quad);
            const h16x8 bf = *(const h16x8*)(w2t + 32 * ks);
            oc = MFMA16H(af, bf, oc);
        }
        const int d = 16 * wave + r, n0 = 16 * mt + 4 * quad;
        if (kv == 0) {
            u16* dst = (u16*)(ws + WS_KCMP) + (size_t)bg * 512 * 64 + d;
#pragma unroll
            for (int i = 0; i < 4; ++i) dst[(size_t)(n0 + i) * 64] = (n0 + i) < NCMP ? f2h(oc[i]) : (u16)0;
        } else {
            u32x2 w; w.x = pkh(oc[0], oc[1]); w.y = pkh(oc[2], (n0 + 3) < NCMP ? oc[3] : 0.f);
            *(u32x2*)((u16*)(ws + WS_VCMPT) + ((size_t)bg * 64 + d) * 512 + n0) = w;
        }
    }
    AT_BAR();
}
constexpr int NS_IMP_P = 132, NS_MAXIT = 288, NS_SLOT = 32 * 144;
constexpr int NS_OFF_IMP = 0, NS_OFF_KC = 67584;
constexpr int NS_OFF_SLOT = 0, NS_OFF_SLOTL = 2 * 8 * NS_SLOT, NS_OFF_OA = NS_OFF_SLOTL + 2048;
constexpr int NS_OFF_BM = 141312, NS_OFF_ITEMS = 142336, NS_OFF_CNT = 145792;
static_assert(2 * 64 * NS_IMP_P * 4 <= NS_OFF_KC && NS_OFF_KC + 512 * 144 <= NS_OFF_BM && NS_OFF_OA + 4 * 512 * 16 <= NS_OFF_BM &&
              NS_OFF_ITEMS + NS_MAXIT * 12 <= NS_OFF_CNT && NS_OFF_CNT + 16 + 1024 <= LDS_BYTES - 256 && AT_LDS <= NS_OFF_BM, "nsa LDS map");
#define NS_BAR() do { asm volatile("s_waitcnt lgkmcnt(0)" ::: "memory"); __builtin_amdgcn_s_barrier(); asm volatile("" ::: "memory"); } while (0)

__device__ __forceinline__ void nsa_unit(unsigned char* ws, LAS unsigned char* lds, int bg, int qt, int wave, int lane) {
    const int tid = threadIdx.x; const int b = bg >> 1, g = bg & 1;
    LAS float* imp = (LAS float*)(lds + NS_OFF_IMP);
    LAS unsigned* bm = (LAS unsigned*)(lds + NS_OFF_BM);
    LAS unsigned char* kcl = lds + NS_OFF_KC;
    LAS unsigned* items = (LAS unsigned*)(lds + NS_OFF_ITEMS);
    LAS unsigned* cnt = (LAS unsigned*)(lds + NS_OFF_CNT);
    const float* gates = (const float*)(ws + WS_GATES);
    for (int i = tid; i < 2 * 64 * NS_IMP_P; i += NTHREADS) imp[i] = 0.f;
    if (tid == 0) cnt[0] = 0u;
    {
        const int amax = 4 * qt + 3;
        int nrows = 32 * ((amax + 31) >> 5); nrows = nrows > 512 ? 512 : nrows;
        const u16* kcg = (const u16*)(ws + WS_KCMP) + (size_t)bg * 512 * 64;
        u32x4 tmp[8];
#pragma unroll
        for (int ii = 0; ii < 8; ++ii) { const int i = tid + NTHREADS * ii; if (i < nrows * 8) tmp[ii] = *(const u32x4*)(kcg + (size_t)i * 8); }
#pragma unroll
        for (int ii = 0; ii < 8; ++ii) { const int i = tid + NTHREADS * ii; if (i < nrows * 8) *(LAS u32x4*)(kcl + (i >> 3) * 144 + (i & 7) * 16) = tmp[ii]; }
    }
    AT_BAR();
    {
        int ln1 = lane; asm volatile("" : "+v"(ln1));
        const int qg = wave & 3, hp = wave >> 2, qi = ln1 & 15, quad = ln1 >> 4;
        const int a = 4 * qt + qg;
        const int nlim = (qi == 15) ? a - 1 : a - 2;
        const int nT = (a + 15) >> 4, nP = (nT + 1) >> 1;
        const int q = 16 * qg + qi; const size_t row = (size_t)b * SEQ + 64 * qt + q;
        const u16* vtg = (const u16*)(ws + WS_VCMPT) + (size_t)bg * 64 * 512;
        const LAS unsigned char* kl = kcl + qi * 144 + quad * 16;
        LAS float* ir = imp + (hp * 64 + q) * NS_IMP_P + quad;
        h16x8 qf2[2][2];
#pragma unroll
        for (int hh = 0; hh < 2; ++hh)
#pragma unroll
            for (int ks = 0; ks < 2; ++ks) qf2[hh][ks] = *(const h16x8*)((const u16*)(ws + WS_Q) + row * 512 + (4 * g + 2 * hp + hh) * 64 + 32 * ks + 8 * quad);
        float m[2] = {-1e30f, -1e30f}, l[2] = {0.f, 0.f};
        for (int P = 0; P < nP; ++P) {
            h16x8 kp[2][2];
#pragma unroll
            for (int tt = 0; tt < 2; ++tt) { kp[tt][0] = *(const LAS h16x8*)(kl + (2 * P + tt) * 16 * 144); kp[tt][1] = *(const LAS h16x8*)(kl + (2 * P + tt) * 16 * 144 + 64); }
            f32x4 sv[2][2];
#pragma unroll
            for (int tt = 0; tt < 2; ++tt)
#pragma unroll
                for (int hh = 0; hh < 2; ++hh) { f32x4 z = {0.f, 0.f, 0.f, 0.f}; z = MFMA16H(kp[tt][0], qf2[hh][0], z); sv[tt][hh] = MFMA16H(kp[tt][1], qf2[hh][1], z); }
#pragma unroll
            for (int hh = 0; hh < 2; ++hh) {
                float mx = m[hh];
#pragma unroll
                for (int tt = 0; tt < 2; ++tt)
#pragma unroll
                    for (int i = 0; i < 4; ++i) mx = (16 * (2 * P + tt) + 4 * quad + i <= nlim) ? fmaxf(mx, sv[tt][hh][i]) : mx;
                float add = 0.f;
#pragma unroll
                for (int tt = 0; tt < 2; ++tt)
#pragma unroll
                    for (int i = 0; i < 4; ++i) add += (16 * (2 * P + tt) + 4 * quad + i <= nlim) ? __builtin_amdgcn_exp2f(sv[tt][hh][i] - mx) : 0.f;
                l[hh] = l[hh] * __builtin_amdgcn_exp2f(m[hh] - mx) + add; m[hh] = mx;
            }
        }
        float mall[2], inv[2];
#pragma unroll
        for (int hh = 0; hh < 2; ++hh) {
            float ma = fmaxf(m[hh], __shfl_xor(m[hh], 16)); ma = fmaxf(ma, __shfl_xor(ma, 32));
            float lw = l[hh] * __builtin_amdgcn_exp2f(m[hh] - ma); lw += __shfl_xor(lw, 16); lw += __shfl_xor(lw, 32);
            mall[hh] = ma; inv[hh] = lw > 0.f ? 1.0f / lw : 0.f;
        }
        f32x4 oc[2][4];
#pragma unroll
        for (int hh = 0; hh < 2; ++hh)
#pragma unroll
            for (int dt = 0; dt < 4; ++dt) oc[hh][dt] = (f32x4){0.f, 0.f, 0.f, 0.f};
        float cwrap = 0.f;
        u32x2 vn[4][2];
#pragma unroll
        for (int dt = 0; dt < 4; ++dt) { const u16* vp = vtg + (size_t)(16 * dt + qi) * 512 + 4 * quad; vn[dt][0] = *(const u32x2*)vp; vn[dt][1] = *(const u32x2*)(vp + 16); }
        for (int P = 0; P < nP; ++P) {
            u32x4 va4[4];
#pragma unroll
            for (int dt = 0; dt < 4; ++dt) va4[dt] = (u32x4){vn[dt][0].x, vn[dt][0].y, vn[dt][1].x, vn[dt][1].y};
            if (P + 1 < nP) {
#pragma unroll
                for (int dt = 0; dt < 4; ++dt) { const u16* vp = vtg + (size_t)(16 * dt + qi) * 512 + 32 * (P + 1) + 4 * quad; vn[dt][0] = *(const u32x2*)vp; vn[dt][1] = *(const u32x2*)(vp + 16); }
            }
            h16x8 kp[2][2];
#pragma unroll
            for (int tt = 0; tt < 2; ++tt) { kp[tt][0] = *(const LAS h16x8*)(kl + (2 * P + tt) * 16 * 144); kp[tt][1] = *(const LAS h16x8*)(kl + (2 * P + tt) * 16 * 144 + 64); }
            f32x4 sv[2][2];
#pragma unroll
            for (int tt = 0; tt < 2; ++tt)
#pragma unroll
                for (int hh = 0; hh < 2; ++hh) { f32x4 z = {0.f, 0.f, 0.f, 0.f}; z = MFMA16H(kp[tt][0], qf2[hh][0], z); sv[tt][hh] = MFMA16H(kp[tt][1], qf2[hh][1], z); }
            u32x4 pw[2];
            float A2[2], C2[2];
#pragma unroll
            for (int tt = 0; tt < 2; ++tt) {
                const int n0 = 16 * (2 * P + tt) + 4 * quad;
                float A = 0.f, C = 0.f;
#pragma unroll
                for (int hh = 0; hh < 2; ++hh) {
                    float pv[4];
#pragma unroll
                    for (int i = 0; i < 4; ++i) pv[i] = (n0 + i <= nlim) ? __builtin_amdgcn_exp2f(sv[tt][hh][i] - mall[hh]) * inv[hh] : 0.f;
                    A += (pv[0] + pv[1]) + (pv[2] + 0.5f * pv[3]); C += 0.5f * pv[3];
                    if (tt == 0) { pw[hh].x = pkh(pv[0], pv[1]); pw[hh].y = pkh(pv[2], pv[3]); } else { pw[hh].z = pkh(pv[0], pv[1]); pw[hh].w = pkh(pv[2], pv[3]); }
                }
                A2[tt] = A; C2[tt] = C;
            }
            const float cup0 = __shfl_up(C2[0], 16), cup1 = __shfl_up(C2[1], 16);
            const float cw0 = __shfl(C2[0], qi + 48), cw1 = __shfl(C2[1], qi + 48);
            ir[4 * (2 * P)] = A2[0] + (quad > 0 ? cup0 : cwrap);
            ir[4 * (2 * P + 1)] = A2[1] + (quad > 0 ? cup1 : cw0);
            cwrap = cw1;
#pragma unroll
            for (int dt = 0; dt < 4; ++dt) {
#pragma unroll
                for (int hh = 0; hh < 2; ++hh) oc[hh][dt] = MFMA16H(__builtin_bit_cast(h16x8, va4[dt]), __builtin_bit_cast(h16x8, pw[hh]), oc[hh][dt]);
            }
        }
        if (quad == 0 && 2 * nP < 32) ir[4 * (2 * nP)] = cwrap;
#pragma unroll
        for (int hh = 0; hh < 2; ++hh) {
            const int h = 2 * hp + hh;
            const float g0 = gates[row * 24 + (4 * g + h) * 3 + 0];
#pragma unroll
            for (int dt = 0; dt < 4; ++dt) {
                u32x2 w; w.x = pkh(oc[hh][dt][0] * g0, oc[hh][dt][1] * g0); w.y = pkh(oc[hh][dt][2] * g0, oc[hh][dt][3] * g0);
                *(u32x2*)((u16*)(ws + WS_Y) + row * DM + (4 * g + h) * 64 + 16 * dt + 4 * quad) = w;
            }
        }
    }
    __syncthreads();
    {
        const int cur = qt, nf = cur == 0 ? 1 : (cur == 1 ? 2 : 3), need = NTOP - nf, jhi = cur - 2;
        int ln2 = lane; asm volatile("" : "+v"(ln2));
        const int j1 = ln2, j2 = ln2 + 64;
        const bool c1 = (j1 >= 1 && j1 <= jhi), c2 = (j2 <= jhi);
        const bool f1 = (j1 == 0) || (j1 == cur) || (j1 == cur - 1), f2 = (j2 == cur) || (j2 == cur - 1);
#pragma unroll 1
        for (int q0 = 0; q0 < 8; q0 += 4) {
            unsigned u1[4], u2[4];
#pragma unroll
            for (int k = 0; k < 4; ++k) {
                const int q = 8 * wave + q0 + k;
                const LAS float* ir0 = imp + q * NS_IMP_P; const LAS float* ir1 = imp + (64 + q) * NS_IMP_P;
                u1[k] = __float_as_uint(ir0[j1] + ir1[j1]); u2[k] = __float_as_uint(ir0[j2] + ir1[j2]);
                u1[k] = c1 ? u1[k] : 0u; u2[k] = c2 ? u2[k] : 0u;
            }
            unsigned pre[4] = {0u, 0u, 0u, 0u};
            if (jhi > need) {
                for (int bit = 30; bit >= 0; --bit) {
#pragma unroll
                    for (int k = 0; k < 4; ++k) {
                        const unsigned tr = pre[k] | (1u << bit);
                        const int cge = __popcll(__ballot(u1[k] >= tr)) + __popcll(__ballot(u2[k] >= tr));
                        pre[k] = cge >= need ? tr : pre[k];
                    }
                }
            }
#pragma unroll
            for (int k = 0; k < 4; ++k) {
                const int q = 8 * wave + q0 + k;
                bool s1 = f1 || c1, s2 = f2 || c2;
                if (jhi > need) {
                    const unsigned long long g1 = __ballot(c1 && u1[k] > pre[k]), g2 = __ballot(c2 && u2[k] > pre[k]);
                    const unsigned long long e1 = __ballot(c1 && u1[k] == pre[k]), e2 = __ballot(c2 && u2[k] == pre[k]);
                    const int rem = need - (__popcll(g1) + __popcll(g2));
                    const int er1 = __builtin_amdgcn_mbcnt_hi((unsigned)(e1 >> 32), __builtin_amdgcn_mbcnt_lo((unsigned)e1, 0u));
                    const int er2 = __popcll(e1) + __builtin_amdgcn_mbcnt_hi((unsigned)(e2 >> 32), __builtin_amdgcn_mbcnt_lo((unsigned)e2, 0u));
                    s1 = f1 || (c1 && (u1[k] > pre[k] || (u1[k] == pre[k] && er1 < rem)));
                    s2 = f2 || (c2 && (u2[k] > pre[k] || (u2[k] == pre[k] && er2 < rem)));
                }
                const unsigned long long m1 = __ballot(s1), m2 = __ballot(s2);
                if (ln2 == 0) { bm[q * 4 + 0] = (unsigned)m1; bm[q * 4 + 1] = (unsigned)(m1 >> 32); bm[q * 4 + 2] = (unsigned)m2; bm[q * 4 + 3] = (unsigned)(m2 >> 32); }
            }
        }
    }
    AT_BAR();
    {
        constexpr int MB_QL = 0, MB_QP = 528, MB_KV = 33792, MB_SLOT = MB_KV + 8 * AT_TILE, MB_SP = 144, MB_SLOTL = MB_SLOT + 8 * 32 * MB_SP, MB_PERM = MB_SLOTL + 1024;
        static_assert(64 * MB_QP <= MB_KV && MB_PERM + 512 <= LDS_BYTES - 256, "mbr LDS map");
        int ln3 = lane, td3 = tid; asm volatile("" : "+v"(ln3), "+v"(td3));
        const int r32 = ln3 & 31, hi = ln3 >> 5, qi = r32 >> 2, h = r32 & 3;
        const int prow = (r32 & 0x13) | ((r32 & 8) >> 1) | ((r32 & 4) << 1);
        const int oq = td3 >> 3, oh = (td3 >> 1) & 3, ohf = td3 & 1;
        LAS unsigned char* ql = lds + MB_QL;
        LAS unsigned char* kvl = lds + MB_KV;
        LAS unsigned char* slots = lds + MB_SLOT;
        LAS float* slotl = (LAS float*)(lds + MB_SLOTL);
        LAS unsigned char* permw = lds + MB_PERM + wave * 64;
        {
            const u16* qsrc = (const u16*)(ws + WS_Q) + ((size_t)b * SEQ + 64 * qt) * 512 + 4 * g * 64;
#pragma unroll
            for (int i = 0; i < 4; ++i) { const int idx = td3 + NTHREADS * i, r = idx >> 5, pc = idx & 31; *(LAS u32x4*)(ql + r * MB_QP + pc * 16) = *(const u32x4*)(qsrc + (size_t)r * 512 + pc * 8); }
        }
        const int srow = td3 >> 3, sch = td3 & 7;
        const u16* ksrc = (const u16*)(ws + WS_KS) + (size_t)bg * SEQ * 64 + (size_t)srow * 64 + 8 * sch;
        const u16* vsrc = (const u16*)(ws + WS_VST) + (size_t)bg * 64 * SEQ + (size_t)srow * 64 + 8 * sch;
        const int sdst = srow * AT_PITCH + sch * 16;
        const int nrnd = (qt + 4) >> 2;
        u32x4 kr[4], vr[4];
#define MB_LOAD(R_) do { _Pragma("unroll") for (int bi = 0; bi < 4; ++bi) { const int jb_ = 4 * (R_) + bi; const int jc_ = jb_ <= qt ? jb_ : qt; \
            kr[bi] = *(const u32x4*)(ksrc + (size_t)jc_ * 4096); vr[bi] = *(const u32x4*)(vsrc + (size_t)jc_ * 4096); } } while (0)
#define MB_STORE() do { _Pragma("unroll") for (int bi = 0; bi < 4; ++bi) { *(LAS u32x4*)(kvl + bi * AT_TILE + sdst) = kr[bi]; *(LAS u32x4*)(kvl + (4 + bi) * AT_TILE + sdst) = vr[bi]; } } while (0)
        MB_LOAD(0);
        const unsigned mybm0 = bm[ln3 * 4 + 0], mybm1 = bm[ln3 * 4 + 1], mybm2 = bm[ln3 * 4 + 2], mybm3 = bm[ln3 * 4 + 3];
        MB_STORE();
        h16x2 oa[16]; float la = 0.f;
#pragma unroll
        for (int e = 0; e < 16; ++e) oa[e] = (h16x2){(h16)0.f, (h16)0.f};
        const u32x4 onesw = {0x3c003c00u, 0x3c003c00u, 0x3c003c00u, 0x3c003c00u};
        const int koff = prow * AT_PITCH + hi * 16, voff = 4 * AT_TILE + r32 * AT_PITCH + hi * 16;
        const unsigned blo = oq >= 32 ? 0xffffffffu : ((1u << oq) - 1u), bhi = oq >= 32 ? ((1u << (oq - 32)) - 1u) : 0u;
        const unsigned obit = 1u << (oq & 31); const bool ohigh = oq >= 32;
        AT_BAR();
        for (int R = 0; R < nrnd; ++R) {
            if (R + 1 < nrnd) MB_LOAD(R + 1);
            unsigned long long mk[4]; int cb[4], base[4]; int NI = 0;
#pragma unroll
            for (int bi = 0; bi < 4; ++bi) {
                const int j = 4 * R + bi;
                const unsigned mw = j < 32 ? mybm0 : (j < 64 ? mybm1 : (j < 96 ? mybm2 : mybm3));
                const bool bit = (j <= qt) && ((mw >> (j & 31)) & 1u);
                mk[bi] = __ballot(bit); cb[bi] = __popcll(mk[bi]); base[bi] = NI; NI += (cb[bi] + 7) >> 3;
            }
            const int nsub = (NI + 7) >> 3;
            for (int sr = 0; sr < nsub; ++sr) {
                const int it = 8 * sr + wave;
                if (it < NI) {
                    int bi = 0;
                    if (it >= base[1]) bi = 1;
                    if (it >= base[2]) bi = 2;
                    if (it >= base[3]) bi = 3;
                    const unsigned long long mkb = bi == 0 ? mk[0] : (bi == 1 ? mk[1] : (bi == 2 ? mk[2] : mk[3]));
                    const int cbb = bi == 0 ? cb[0] : (bi == 1 ? cb[1] : (bi == 2 ? cb[2] : cb[3]));
                    const int sub = it - (bi == 0 ? base[0] : (bi == 1 ? base[1] : (bi == 2 ? base[2] : base[3])));
                    const int j = 4 * R + bi;
                    const unsigned mwj = j < 32 ? mybm0 : (j < 64 ? mybm1 : (j < 96 ? mybm2 : mybm3));
                    const bool bit = (mwj >> (j & 31)) & 1u;
                    const int rank = __builtin_amdgcn_mbcnt_hi((unsigned)(mkb >> 32), __builtin_amdgcn_mbcnt_lo((unsigned)mkb, 0u));
                    if (bit) permw[rank] = (unsigned char)ln3;
                    h16x8 qf[4], kf[8];
#pragma unroll
                    for (int kh = 0; kh < 2; ++kh)
#pragma unroll
                        for (int d0 = 0; d0 < 4; ++d0) kf[kh * 4 + d0] = *(const LAS h16x8*)(kvl + bi * AT_TILE + kh * 32 * AT_PITCH + koff + d0 * 32);
                    const int slotq = 8 * sub + qi;
                    const bool valid = slotq < cbb;
                    const int q = valid ? (int)permw[slotq] : 0;
#pragma unroll
                    for (int d0 = 0; d0 < 4; ++d0) qf[d0] = *(const LAS h16x8*)(ql + q * MB_QP + h * 128 + d0 * 32 + hi * 16);
                    __builtin_amdgcn_sched_barrier(0);
                    f32x16 sx[2];
#pragma unroll
                    for (int kh = 0; kh < 2; ++kh) {
#pragma unroll
                        for (int e = 0; e < 16; ++e) sx[kh][e] = -(OFF2 + 4.0f);
#pragma unroll
                        for (int d0 = 0; d0 < 4; ++d0) sx[kh] = MFMA32H(kf[kh * 4 + d0], qf[d0], sx[kh]);
                    }
                    h16x8 vfr[8];
#pragma unroll
                    for (int dt = 0; dt < 2; ++dt)
#pragma unroll
                        for (int kk = 0; kk < 4; ++kk) vfr[dt * 4 + kk] = *(const LAS h16x8*)(kvl + bi * AT_TILE + voff + dt * 32 * AT_PITCH + kk * 32);
                    __builtin_amdgcn_sched_barrier(0);
                    const bool diag = (j == qt);
                    const unsigned vmk = valid ? 0xffffffffu : 0u;
                    u32x4 pw[4];
#pragma unroll
                    for (int kk = 0; kk < 4; ++kk) {
                        float pv[8];
#pragma unroll
                        for (int e = 0; e < 8; ++e) {
                            float pe = __builtin_amdgcn_exp2f(sx[kk >> 1][8 * (kk & 1) + e]);
                            if (diag) pe = (16 * kk + 8 * hi + e <= q) ? pe : 0.f;
                            pv[e] = pe;
                        }
                        pw[kk] = (u32x4){pkh(pv[0], pv[1]) & vmk, pkh(pv[2], pv[3]) & vmk, pkh(pv[4], pv[5]) & vmk, pkh(pv[6], pv[7]) & vmk};
                    }
                    f32x16 o[2], ol;
#pragma unroll
                    for (int e = 0; e < 16; ++e) { o[0][e] = 0.f; o[1][e] = 0.f; ol[e] = 0.f; }
#pragma unroll
                    for (int kk = 0; kk < 4; ++kk) {
                        const h16x8 pb2 = __builtin_bit_cast(h16x8, pw[kk]);
#pragma unroll
                        for (int dt = 0; dt < 2; ++dt) o[dt] = MFMA32H(vfr[dt * 4 + kk], pb2, o[dt]);
                        ol = MFMA32H(__builtin_bit_cast(h16x8, onesw), pb2, ol);
                    }
                    LAS unsigned char* sp = slots + (wave * 32 + r32) * MB_SP + hi * 8;
#pragma unroll
                    for (int dt = 0; dt < 2; ++dt)
#pragma unroll
                        for (int r4 = 0; r4 < 4; ++r4) { u32x2 w; w.x = pkh(o[dt][4 * r4], o[dt][4 * r4 + 1]); w.y = pkh(o[dt][4 * r4 + 2], o[dt][4 * r4 + 3]); *(LAS u32x2*)(sp + dt * 64 + r4 * 16) = w; }
                    if (hi == 0) slotl[wave * 32 + r32] = ol[0];
                }
                AT_BAR();
                if (sr == nsub - 1 && R + 1 < nrnd) MB_STORE();
#pragma unroll
                for (int bi = 0; bi < 4; ++bi) {
                    const unsigned mlo = (unsigned)mk[bi], mhi = (unsigned)(mk[bi] >> 32);
                    if ((ohigh ? mhi : mlo) & obit) {
                        const int rk = __builtin_popcount(mlo & blo) + __builtin_popcount(mhi & bhi);
                        const int itb = base[bi] + (rk >> 3);
                        if ((itb >> 3) == sr) {
                            const int sl = itb & 7, col = 4 * (rk & 7) + oh;
                            const LAS unsigned char* sp = slots + (sl * 32 + col) * MB_SP + ohf * 64;
#pragma unroll
                            for (int c8 = 0; c8 < 4; ++c8) {
                                const h16x8 v = *(const LAS h16x8*)(sp + c8 * 16);
#pragma unroll
                                for (int e = 0; e < 4; ++e) oa[4 * c8 + e] += (h16x2){v[2 * e], v[2 * e + 1]};
                            }
                            la += slotl[sl * 32 + col];
                        }
                    }
                }
                AT_BAR();
            }
            if (nsub == 0 && R + 1 < nrnd) { MB_STORE(); AT_BAR(); }
        }
#undef MB_LOAD
#undef MB_STORE
        {
            const size_t row = (size_t)b * SEQ + 64 * qt + oq;
            const float g1 = gates[row * 24 + (4 * g + oh) * 3 + 1];
            const float sc = g1 / la;
            const u16* owp = (const u16*)(ws + WS_OWIN) + row * 512 + (4 * g + oh) * 64 + 32 * ohf;
            u16* yp = (u16*)(ws + WS_Y) + row * DM + (4 * g + oh) * 64 + 32 * ohf;
            float ssq = 0.f;
#pragma unroll
            for (int c8 = 0; c8 < 4; ++c8) {
                const h16x8 cw = *(const h16x8*)(yp + 8 * c8), ww = *(const h16x8*)(owp + 8 * c8);
                float y[8];
#pragma unroll
                for (int e = 0; e < 8; ++e) { y[e] = (float)oa[4 * c8 + (e >> 1)][e & 1] * sc + (float)cw[e] + (float)ww[e]; ssq += y[e] * y[e]; }
                const u32x4 w = {pkh(y[0], y[1]), pkh(y[2], y[3]), pkh(y[4], y[5]), pkh(y[6], y[7])};
                *(u32x4*)(yp + 8 * c8) = w;
            }
            ssq += __shfl_xor(ssq, 1); ssq += __shfl_xor(ssq, 2); ssq += __shfl_xor(ssq, 4);
            if ((td3 & 7) == 0) ((float*)(ws + WS_SSQ))[row * 2 + g] = ssq;
        }
    }
    __syncthreads();
}

__device__ __forceinline__ void nsa_finalize_unit(unsigned char* ws, const float* gain, int u, int wave, int lane) {
    const f32x4 g0 = *(const f32x4*)(gain + 8 * lane), g1 = *(const f32x4*)(gain + 8 * lane + 4);
#pragma unroll 1
    for (int i0 = 0; i0 < 16; i0 += 8) {
        f32x2 sq[8]; h16x8 v[8];
#pragma unroll
        for (int i = 0; i < 8; ++i) {
            const size_t row = (size_t)u * 128 + wave * 16 + i0 + i;
            sq[i] = *(const f32x2*)((const float*)(ws + WS_SSQ) + row * 2);
            v[i] = *(const h16x8*)((const u16*)(ws + WS_Y) + row * DM + 8 * lane);
        }
#pragma unroll
        for (int i = 0; i < 8; ++i) {
            const size_t row = (size_t)u * 128 + wave * 16 + i0 + i;
            const float rs = 1.0f / sqrtf((sq[i][0] + sq[i][1]) * (1.0f / 512.f) + EPS);
            u32x4 w;
            w.x = pkh((float)v[i][0] * rs * g0[0], (float)v[i][1] * rs * g0[1]); w.y = pkh((float)v[i][2] * rs * g0[2], (float)v[i][3] * rs * g0[3]);
            w.z = pkh((float)v[i][4] * rs * g1[0], (float)v[i][5] * rs * g1[1]); w.w = pkh((float)v[i][6] * rs * g1[2], (float)v[i][7] * rs * g1[3]);
            *(u32x4*)((u16*)(ws + WS_Y) + row * DM + 8 * lane) = w;
        }
    }
}
constexpr int HG_LFP = 129;
constexpr int HG_OFF_LF = 0, HG_OFF_SEG = 33024, HG_OFF_KT = 35072, HG_OFF_VT = 35072 + 18432;
constexpr int H3_OFF_QT = 35072, H3_OFF_KH = H3_OFF_QT + 17408, H3_OFF_VT = H3_OFF_KH + 17408, H3_OFF_SSQ = H3_OFF_VT + 18432;
static_assert(H3_OFF_SSQ + 256 <= LDS_BYTES, "hgrn LDS map");

__device__ __forceinline__ void hg_load_logf(const unsigned char* ws, LAS float* lf, size_t row0, int h, int tid) {
#pragma unroll
    for (int i = 0; i < 2; ++i) {
        const int idx = tid + NTHREADS * i, s = idx >> 4, ch = idx & 15;
        const h16x8 v = *(const h16x8*)((const u16*)(ws + WS_HLOGF) + (row0 + s) * 512 + h * 128 + 8 * ch);
#pragma unroll
        for (int e = 0; e < 8; ++e) lf[s * HG_LFP + 8 * ch + e] = (float)v[e];
    }
}
__device__ __forceinline__ void hg_stage_vt(const unsigned char* ws, LAS u16* vt, size_t row0, int h, int tid) {
#pragma unroll
    for (int i = 0; i < 2; ++i) {
        const int idx = tid + NTHREADS * i, s = idx & 63, ch = idx >> 6;
        const s16x8 v = *(const s16x8*)((const u16*)(ws + WS_HV) + (row0 + s) * 512 + h * 128 + 8 * ch);
#pragma unroll
        for (int e = 0; e < 8; ++e) vt[(8 * ch + e) * 72 + s] = (u16)v[e];
    }
}

__device__ __forceinline__ void hgrn_h1_units(unsigned char* ws, LAS unsigned char* lds, int u0, int stride, int nu, int wave, int lane) {
    if (u0 >= nu) return;
    const int tid = threadIdx.x, r32 = lane & 31, hi = lane >> 5;
    LAS float* lf = (LAS float*)(lds + HG_OFF_LF);
    LAS float* seg = (LAS float*)(lds + HG_OFF_SEG);
    LAS u16* kt = (LAS u16*)(lds + HG_OFF_KT);
    LAS u16* vt = (LAS u16*)(lds + HG_OFF_VT);
    h16x8 lfr[2]; s16x8 vvr[2];
#define H1_LOAD(uu) do { const int c_ = (uu) & 127, bh_ = (uu) >> 7; const size_t r0_ = (size_t)(bh_ >> 2) * SEQ + 64 * c_; const int h_ = bh_ & 3; \
        _Pragma("unroll") for (int i = 0; i < 2; ++i) { const int idx = tid + NTHREADS * i; \
            lfr[i] = *(const h16x8*)((const u16*)(ws + WS_HLOGF) + (r0_ + (idx >> 4)) * 512 + h_ * 128 + 8 * (idx & 15)); \
            vvr[i] = *(const s16x8*)((const u16*)(ws + WS_HV) + (r0_ + (idx & 63)) * 512 + h_ * 128 + 8 * (idx >> 6)); } } while (0)
    H1_LOAD(u0);
    for (int u = u0; u < nu; u += stride) {
        const int c = u & 127, bh = u >> 7;
#pragma unroll
        for (int i = 0; i < 2; ++i) {
            const int idx = tid + NTHREADS * i;
            { const int s = idx >> 4, ch = idx & 15;
#pragma unroll
              for (int e = 0; e < 8; ++e) lf[s * HG_LFP + 8 * ch + e] = (float)lfr[i][e]; }
            { const int s = idx & 63, ch = idx >> 6;
#pragma unroll
              for (int e = 0; e < 8; ++e) vt[(8 * ch + e) * 72 + s] = (u16)vvr[i][e]; }
        }
        if (u + stride < nu) H1_LOAD(u + stride);
        AT_BAR();
        const int d = tid & 127, sg = tid >> 7;
        float lg[16]; float tot = 0.f;
#pragma unroll
        for (int i = 0; i < 16; ++i) { lg[i] = lf[(16 * sg + i) * HG_LFP + d]; tot += lg[i]; }
        seg[sg * 128 + d] = tot;
        AT_BAR();
        {
            float R = 0.f;
            for (int s2 = sg + 1; s2 < 4; ++s2) R += seg[s2 * 128 + d];
#pragma unroll
            for (int i = 15; i >= 0; --i) {
                const float ke = (1.0f - __expf(lg[i])) * __expf(R);
                kt[d * 72 + 16 * sg + i] = f2b(ke);
                R += lg[i];
            }
            if (sg == 0) ((float*)(ws + WS_HD))[((size_t)bh * 128 + c) * 128 + d] = __expf(R);
        }
        AT_BAR();
        {
            const int vtile = wave & 3;
            s16x8 bfr[4];
#pragma unroll
            for (int ks = 0; ks < 4; ++ks) bfr[ks] = *(const LAS s16x8*)(vt + (32 * vtile + r32) * 72 + 16 * ks + 8 * hi);
            u16* dst = (u16*)(ws + WS_HL) + (((size_t)bh * 128 + c) * 128 + 32 * vtile + r32) * 128;
#pragma unroll
            for (int dd = 0; dd < 2; ++dd) {
                const int dtile = 2 * (wave >> 2) + dd;
                f32x16 acc;
#pragma unroll
                for (int i = 0; i < 16; ++i) acc[i] = 0.f;
                s16x8 afr[4];
#pragma unroll
                for (int ks = 0; ks < 4; ++ks) afr[ks] = *(const LAS s16x8*)(kt + (32 * dtile + r32) * 72 + 16 * ks + 8 * hi);
#pragma unroll
                for (int ks = 0; ks < 4; ++ks) acc = MFMA32B(afr[ks], bfr[ks], acc);
#pragma unroll
                for (int r4 = 0; r4 < 4; ++r4) {
                    u32x2 w; w.x = pkb(acc[4 * r4], acc[4 * r4 + 1]); w.y = pkb(acc[4 * r4 + 2], acc[4 * r4 + 3]);
                    *(u32x2*)(dst + 32 * dtile + 8 * r4 + 4 * hi) = w;
                }
            }
        }
        AT_BAR();
    }
#undef H1_LOAD
}

__device__ __forceinline__ void hgrn_h2_unit(unsigned char* ws, int u, int wave, int lane) {
    if (wave >= 2) return;
    const int gt = u * 128 + wave * 64 + lane;
    const int bh = gt >> 12, v = (gt >> 5) & 127, d0 = 4 * (gt & 31);
    const u16* lp = (const u16*)(ws + WS_HL) + ((size_t)bh * 128 * 128 + v) * 128 + d0;
    u16* sp = (u16*)(ws + WS_HS) + ((size_t)bh * 128 * 128 + v) * 128 + d0;
    const float* dp = (const float*)(ws + WS_HD) + (size_t)bh * 128 * 128 + d0;
    float S0 = 0.f, S1 = 0.f, S2 = 0.f, S3 = 0.f;
#pragma unroll 1
    for (int c0 = 0; c0 < 128; c0 += 16) {
        u32x2 lw[16]; f32x4 dv[16];
#pragma unroll
        for (int i = 0; i < 16; ++i) { lw[i] = *(const u32x2*)(lp + (size_t)(c0 + i) * 16384); dv[i] = *(const f32x4*)(dp + (c0 + i) * 128); }
#pragma unroll
        for (int i = 0; i < 16; ++i) {
            u32x2 w; w.x = pkb(S0, S1); w.y = pkb(S2, S3);
            *(u32x2*)(sp + (size_t)(c0 + i) * 16384) = w;
            S0 = dv[i][0] * S0 + __builtin_bit_cast(float, lw[i].x << 16); S1 = dv[i][1] * S1 + __builtin_bit_cast(float, lw[i].x & 0xffff0000u);
            S2 = dv[i][2] * S2 + __builtin_bit_cast(float, lw[i].y << 16); S3 = dv[i][3] * S3 + __builtin_bit_cast(float, lw[i].y & 0xffff0000u);
        }
    }
}

constexpr int H3_OFF_QR = H3_OFF_SSQ + 256;
static_assert(H3_OFF_QR + 64 * 136 * 2 <= LDS_BYTES - 256, "hgrn h3 LDS map");
__device__ __forceinline__ void hgrn_h3_units(unsigned char* ws, LAS unsigned char* lds, const float* ogain, int u0, int stride, int nu, int wave, int lane) {
    if (u0 >= nu) return;
    const int tid = threadIdx.x, r32 = lane & 31, hi = lane >> 5;
    LAS float* lf = (LAS float*)(lds + HG_OFF_LF);
    LAS float* seg = (LAS float*)(lds + HG_OFF_SEG);
    LAS u16* qt = (LAS u16*)(lds + H3_OFF_QT);
    LAS u16* kh = (LAS u16*)(lds + H3_OFF_KH);
    LAS u16* vt = (LAS u16*)(lds + H3_OFF_VT);
    LAS float* ssq = (LAS float*)(lds + H3_OFF_SSQ);
    LAS u16* qr = (LAS u16*)(lds + H3_OFF_QR);
    h16x8 lfr[2]; s16x8 vvr[2], qqr[2];
#define H3_LOAD(uu) do { const int c_ = (uu) & 127, bh_ = (uu) >> 7; const size_t r0_ = (size_t)(bh_ >> 2) * SEQ + 64 * c_; const int h_ = bh_ & 3; \
        _Pragma("unroll") for (int i = 0; i < 2; ++i) { const int idx = tid + NTHREADS * i; \
            lfr[i] = *(const h16x8*)((const u16*)(ws + WS_HLOGF) + (r0_ + (idx >> 4)) * 512 + h_ * 128 + 8 * (idx & 15)); \
            qqr[i] = *(const s16x8*)((const u16*)(ws + WS_HQ) + (r0_ + (idx >> 4)) * 512 + h_ * 128 + 8 * (idx & 15)); \
            vvr[i] = *(const s16x8*)((const u16*)(ws + WS_HV) + (r0_ + (idx & 63)) * 512 + h_ * 128 + 8 * (idx >> 6)); } } while (0)
    H3_LOAD(u0);
    for (int u = u0; u < nu; u += stride) {
        const int c = u & 127, bh = u >> 7, b = bh >> 2, h = bh & 3;
        const size_t row0 = (size_t)b * SEQ + 64 * c;
#pragma unroll
        for (int i = 0; i < 2; ++i) {
            const int idx = tid + NTHREADS * i;
            { const int s = idx >> 4, ch = idx & 15;
#pragma unroll
              for (int e = 0; e < 8; ++e) lf[s * HG_LFP + 8 * ch + e] = (float)lfr[i][e];
              *(LAS s16x8*)(qr + s * 136 + 8 * ch) = qqr[i]; }
            { const int s = idx & 63, ch = idx >> 6;
#pragma unroll
              for (int e = 0; e < 8; ++e) vt[(8 * ch + e) * 72 + s] = (u16)vvr[i][e]; }
        }
        if (tid < 64) ssq[tid] = 0.f;
        if (u + stride < nu) H3_LOAD(u + stride);
        s16x8 sfr[8];
        {
            const u16* sp = (const u16*)(ws + WS_HS) + (((size_t)bh * 128 + c) * 128 + 32 * (wave >> 1) + r32) * 128 + 8 * hi;
#pragma unroll
            for (int ks = 0; ks < 8; ++ks) sfr[ks] = *(const s16x8*)(sp + 16 * ks);
        }
        AT_BAR();
        const int d = tid & 127, sg = tid >> 7;
        float lg[16]; float tot = 0.f;
#pragma unroll
        for (int i = 0; i < 16; ++i) { lg[i] = lf[(16 * sg + i) * HG_LFP + d]; tot += lg[i]; }
        seg[sg * 128 + d] = tot;
        AT_BAR();
        {
            float Bc = 0.f;
            for (int s2 = 0; s2 < sg; ++s2) Bc += seg[s2 * 128 + d];
#pragma unroll
            for (int i = 0; i < 16; ++i) {
                Bc += lg[i];
                const float qv = b2f(qr[(16 * sg + i) * 136 + d]);
                qt[(16 * sg + i) * 136 + d] = f2b(qv * __expf(Bc));
                kh[(16 * sg + i) * 136 + d] = f2b((1.0f - __expf(lg[i])) * __expf(fminf(-Bc, 80.f)));
            }
        }
        AT_BAR();
        {
            const int th = wave & 1, vtile = wave >> 1;
            s16x8 qf[8];
#pragma unroll
            for (int ks = 0; ks < 8; ++ks) qf[ks] = *(const LAS s16x8*)(qt + (32 * th + r32) * 136 + 16 * ks + 8 * hi);
            f32x16 acc;
#pragma unroll
            for (int i = 0; i < 16; ++i) acc[i] = 0.f;
            {
#pragma unroll
                for (int ks = 0; ks < 8; ++ks) acc = MFMA32B(sfr[ks], qf[ks], acc);
            }
            const int prow = (r32 & 0x13) | ((r32 & 8) >> 1) | ((r32 & 4) << 1);
            for (int sh = 0; sh <= th; ++sh) {
                f32x16 x;
#pragma unroll
                for (int i = 0; i < 16; ++i) x[i] = 0.f;
                s16x8 kfr[8], vfr2[2];
#pragma unroll
                for (int ks = 0; ks < 8; ++ks) kfr[ks] = *(const LAS s16x8*)(kh + (32 * sh + prow) * 136 + 16 * ks + 8 * hi);
#pragma unroll
                for (int sp2 = 0; sp2 < 2; ++sp2) vfr2[sp2] = *(const LAS s16x8*)(vt + (32 * vtile + r32) * 72 + 32 * sh + 16 * sp2 + 8 * hi);
#pragma unroll
                for (int ks = 0; ks < 8; ++ks) x = MFMA32B(kfr[ks], qf[ks], x);
                u32x4 pw[2];
#pragma unroll
                for (int sp2 = 0; sp2 < 2; ++sp2) {
                    float xv[8];
#pragma unroll
                    for (int e = 0; e < 8; ++e) { const int sin_ = 16 * sp2 + 8 * hi + e; const bool ok = (sh < th) || (sin_ <= r32); xv[e] = ok ? x[8 * sp2 + e] : 0.f; }
                    pw[sp2] = (u32x4){pkb(xv[0], xv[1]), pkb(xv[2], xv[3]), pkb(xv[4], xv[5]), pkb(xv[6], xv[7])};
                }
#pragma unroll
                for (int sp2 = 0; sp2 < 2; ++sp2) acc = MFMA32B(vfr2[sp2], __builtin_bit_cast(s16x8, pw[sp2]), acc);
            }
            const int t = 32 * th + r32;
            const u16* gp = (const u16*)(ws + WS_HG) + (row0 + t) * 512 + h * 128 + 32 * vtile + 4 * hi;
            u32x2 gw4[4];
#pragma unroll
            for (int r4 = 0; r4 < 4; ++r4) gw4[r4] = *(const u32x2*)(gp + 8 * r4);
            float sq = 0.f;
#pragma unroll
            for (int i = 0; i < 16; ++i) sq += acc[i] * acc[i];
            sq += __shfl_xor(sq, 32);
            if (hi == 0) (void)__hip_atomic_fetch_add(ssq + t, sq, __ATOMIC_RELAXED, __HIP_MEMORY_SCOPE_WORKGROUP);
            AT_BAR();
            const float rs = 1.0f / sqrtf(ssq[t] * (1.0f / 128.f) + EPS);
            u16* yp = (u16*)(ws + WS_Y) + (row0 + t) * DM + 512 + h * 128 + 32 * vtile + 4 * hi;
            const float* gn = ogain + 32 * vtile + 4 * hi;
#pragma unroll
            for (int r4 = 0; r4 < 4; ++r4) {
                const h16x4 gv = __builtin_bit_cast(h16x4, gw4[r4]);
                const f32x4 gg = *(const f32x4*)(gn + 8 * r4);
                u32x2 w;
                w.x = pkh(acc[4 * r4] * rs * gg[0] * (float)gv[0], acc[4 * r4 + 1] * rs * gg[1] * (float)gv[1]);
                w.y = pkh(acc[4 * r4 + 2] * rs * gg[2] * (float)gv[2], acc[4 * r4 + 3] * rs * gg[3] * (float)gv[3]);
                *(u32x2*)(yp + 8 * r4) = w;
            }
        }
        AT_BAR();
    }
#undef H3_LOAD
}
__global__ void __launch_bounds__(NTHREADS, 2) mk_fwd(Params p) {
    extern __shared__ __attribute__((aligned(16))) unsigned char lds_raw[];
    LAS unsigned char* lds = (LAS unsigned char*)lds_raw;
    const int tid = threadIdx.x, lane = tid & 63, wave = __builtin_amdgcn_readfirstlane(tid >> 6);
    const int G = gridDim.x, bx = blockIdx.x;
    const int vcu = (G % 8 == 0) ? (bx % 8) * (G / 8) + bx / 8 : bx;
    const int gw = vcu * NWAVES + wave, NGW = G * NWAVES;
    unsigned char* ws = p.ws;
#define IN(k) (p.ph_lo <= (k) && (k) < p.ph_hi)
    volatile LAS unsigned* xst = (volatile LAS unsigned*)(lds + LDS_BYTES - 256);
    unsigned* barw = (unsigned*)(ws + WS_CTL);
    XcdBarrier xbar; xbar.bar = barw; xbar.x = 0; xbar.st = xst;
    const bool fused = (p.ph_hi - p.ph_lo) > 1;
    if (fused) {
        if (tid < 2) xst[tid] = 0u;
        __syncthreads();
        xbar = xcd_barrier_post(barw, xst);
    }
#define SEAM(k) do { if (IN(k) && IN((k) + 1)) xcd_barrier(xbar); } while (0)

    if (IN(0)) { p0_prologue(p, lds, gw, NGW, wave, lane); }
    SEAM(0);
    if (IN(1)) {
        pg8::Gemm g{(const u16*)(ws + WS_XH), (const u16*)(ws + WS_WIN_T), MT, DINP, DM}; pg8::StaticOrder S; S.init(MT, DINP, G, bx);
        pg8::EpiInProj E{ws, p.in[3], p.in[4]};
        pg8::gemm_phase<pg8::EpiInProj, pg8::StaticOrder, true, true>(lds, g, S, E, wave);
        const int nfull = (MT / 256) * (DINP / 256) - 3 * G;
        if (nfull < 0 || nfull >= G) p0_late_transposes(p, lds, gw, NGW, wave, lane);
        else if (bx >= nfull) p0_late_transposes(p, lds, (bx - nfull) * NWAVES + wave, (G - nfull) * NWAVES, wave, lane);
    }
    SEAM(1);
    if (IN(2)) {
        if (FF % (2 * NGW) == 0) for (int n = gw; n < FF; n += 2 * NGW) quant_rows<2, false>((const u16*)(ws + WS_W1_T), ws + WS_W1Q, (float*)(ws + WS_T1COL), n, NGW, lane);
        else for (int n = gw; n < FF; n += NGW) quant_rows<1, false>((const u16*)(ws + WS_W1_T), ws + WS_W1Q, (float*)(ws + WS_T1COL), n, NGW, lane);
        constexpr int NU_WIN = 512, NU_CMP = 256, NU_H1 = 1024;
        for (int u = bx; u < NU_WIN + NU_CMP + NU_H1; u += G) {
            if (u < NU_WIN) win_unit(ws, lds, u, wave, lane);
            else if (u < NU_WIN + NU_CMP) cmp_mlp_unit(ws, lds, u - NU_WIN, wave, lane);
            else { hgrn_h1_units(ws, lds, u - NU_WIN - NU_CMP, G, NU_H1, wave, lane); break; }
        }
    }
    SEAM(2);
    if (IN(3)) {
        for (int v = bx; v < 512 + 256; v += G) {
            if (v < 512) {
                int bg, qt;
                if (G == 256) { const int c = v & 255, mem = (c & 1) * 32 + (c >> 3); bg = (c & 7) >> 1; qt = (v < 256) ? mem : 127 - mem; }
                else { const int vv = v & 255; bg = vv >> 6; qt = (v < 256) ? (vv & 63) : 127 - (vv & 63); }
                nsa_unit(ws, lds, bg, qt, wave, lane);
            }
            else hgrn_h2_unit(ws, v - 512, wave, lane);
        }
    }
    SEAM(3);
    if (IN(4)) {
        for (int u = bx; u < 128 + 1024; u += G) {
            if (u < 128) nsa_finalize_unit(ws, p.in[11], u, wave, lane);
            else { hgrn_h3_units(ws, lds, p.in[13], u - 128, G, 1024, wave, lane); break; }
        }
    }
    SEAM(4);
    if (IN(5)) {
        pg8::Gemm g{(const u16*)(ws + WS_Y), (const u16*)(ws + WS_WOUT_T), MT, DM, DM}; pg8::StaticOrder S; S.init(MT, DM, G, bx);
        pg8::EpiOutProj E{p.in[0], (u16*)(ws + WS_X1H)};
        pg8::gemm_phase<pg8::EpiOutProj, pg8::StaticOrder, true, true>(lds, g, S, E, wave);
    }
    SEAM(5);
    if (IN(6)) {
        if (MT % (8 * NGW) == 0) for (int r = gw; r < MT; r += 8 * NGW) quant_rows<8, true>((const u16*)(ws + WS_X1H), ws + WS_X1Q, (float*)(ws + WS_ROWFAC), r, NGW, lane);
        else for (int r = gw; r < MT; r += NGW) quant_rows<1, true>((const u16*)(ws + WS_X1H), ws + WS_X1Q, (float*)(ws + WS_ROWFAC), r, NGW, lane);
        if (fused) xcd_barrier(xbar);
        pg8::Gemm g{(const u16*)(ws + WS_X1Q), (const u16*)(ws + WS_W1Q), MT, FF, DM / 2}; pg8::StaticOrder S; S.init(MT, FF, G, bx);
        pg8::EpiUp E{(unsigned char*)(ws + WS_HID), (const float*)(ws + WS_ROWFAC), (const float*)(ws + WS_T1COL)};
        pg8::gemm_phase<pg8::EpiUp, pg8::StaticOrder, true, true, 2>(lds, g, S, E, wave);
    }
    SEAM(6);
    if (IN(7)) {
        pg8::Gemm g{(const u16*)(ws + WS_HID), (const u16*)(ws + WS_W2_T), MT, DM, FF / 2}; pg8::StaticOrder S; S.init(MT, DM, G, bx);
        pg8::EpiDown E{p.out, (const u16*)(ws + WS_X1H)};
        pg8::gemm_phase<pg8::EpiDown, pg8::StaticOrder, true, true, 1>(lds, g, S, E, wave);
    }
#undef IN
#undef SEAM
}
static int g_grid = 0;
extern "C" void kernel_launch(void* const* d_in, const int* in_sizes, int n_in, void* d_out, int out_size, void* d_ws, size_t ws_size, hipStream_t stream) {
    if (g_grid == 0) {
        int dev = 0, cus = 0, per_cu = 0;
        (void)hipGetDevice(&dev); (void)hipDeviceGetAttribute(&cus, hipDeviceAttributeMultiprocessorCount, dev);
        (void)hipFuncSetAttribute((const void*)mk_fwd, hipFuncAttributeMaxDynamicSharedMemorySize, LDS_BYTES);
        if (hipOccupancyMaxActiveBlocksPerMultiprocessor(&per_cu, (const void*)mk_fwd, NTHREADS, LDS_BYTES) != hipSuccess || per_cu < 1) { per_cu = 1; (void)hipGetLastError(); }
        if (cus <= 0) cus = 256;
        g_grid = cus;
    }
    Params P{};
    for (int i = 0; i < 18; ++i) P.in[i] = (const float*)d_in[i];
    P.out = (float*)d_out; P.ws = (unsigned char*)d_ws;
    for (int i = 0; i < 8; ++i) P.invf[i] = (float)pow(500000.0, -(double)(2 * i) / 16.0);
    P.ph_lo = 0; P.ph_hi = 8;
    (void)hipMemsetAsync((char*)d_ws + WS_CTL, 0, XCD_BAR_WORDS * sizeof(unsigned), stream);
    void* args[] = {&P};
    hipError_t e = hipLaunchCooperativeKernel((const void*)mk_fwd, dim3(g_grid), dim3(NTHREADS), args, LDS_BYTES, stream);
    if (e != hipSuccess) fprintf(stderr, "cooperative launch failed: %s (grid %d)\n", hipGetErrorString(e), g_grid);
}
```

```cpp
#include <hip/hip_runtime.h>
#include <hip/hip_cooperative_groups.h>
#include <cstdio>
#include <cstdint>
#include <cmath>
namespace cg = cooperative_groups;

#define LAS __attribute__((address_space(3)))
typedef _Float16 h16;
typedef _Float16 h16x2 __attribute__((ext_vector_type(2)));
typedef _Float16 h16x4 __attribute__((ext_vector_type(4)));
typedef _Float16 h16x8 __attribute__((ext_vector_type(8)));
typedef __bf16 b16x2 __attribute__((ext_vector_type(2)));
typedef __bf16 b16x8 __attribute__((ext_vector_type(8)));
typedef short s16x8 __attribute__((ext_vector_type(8)));
typedef short s16x4 __attribute__((ext_vector_type(4)));
typedef float f32x2 __attribute__((ext_vector_type(2)));
typedef float f32x4 __attribute__((ext_vector_type(4)));
typedef float f32x16 __attribute__((ext_vector_type(16)));
typedef unsigned u32x2 __attribute__((ext_vector_type(2)));
typedef unsigned u32x4 __attribute__((ext_vector_type(4)));
typedef unsigned short u16;

__device__ __forceinline__ unsigned pkh(float lo, float hi) { f32x2 v = {lo, hi}; h16x2 h = __builtin_convertvector(v, h16x2); return __builtin_bit_cast(unsigned, h); }
__device__ __forceinline__ unsigned pkb(float lo, float hi) { f32x2 v = {lo, hi}; b16x2 h = __builtin_convertvector(v, b16x2); return __builtin_bit_cast(unsigned, h); }
__device__ __forceinline__ float h2f(u16 v) { return (float)__builtin_bit_cast(h16, v); }
__device__ __forceinline__ float b2f(u16 v) { return __builtin_bit_cast(float, (unsigned)v << 16); }
__device__ __forceinline__ u16 f2h(float f) { return __builtin_bit_cast(u16, (h16)f); }
__device__ __forceinline__ u16 f2b(float f) { return (u16)(pkb(f, 0.f) & 0xffffu); }
__device__ __forceinline__ float wave_sum(float v) {
#pragma unroll
    for (int o = 1; o < 64; o <<= 1) v += __shfl_xor(v, o);
    return v;
}
typedef int i32x2 __attribute__((ext_vector_type(2)));
typedef int i32x4 __attribute__((ext_vector_type(4)));
typedef int i32x8 __attribute__((ext_vector_type(8)));
constexpr float F8_MAX = 448.f, HID_SCALE = 8.f, W2_SCALE = 1024.f;
__device__ __forceinline__ float clamp8(float x) { return fminf(fmaxf(x, -F8_MAX), F8_MAX); }
__device__ __forceinline__ unsigned pkf8x4(float a, float b, float c, float d) { int p = 0; p = __builtin_amdgcn_cvt_pk_fp8_f32(a, b, p, false); p = __builtin_amdgcn_cvt_pk_fp8_f32(c, d, p, true); return (unsigned)p; }
__device__ __forceinline__ float sigmoid_f(float x) { return __builtin_amdgcn_rcpf(1.f + __expf(-x)); }

constexpr int BATCH = 2, SEQ = 8192, DM = 1024, MT = BATCH * SEQ, DIN = 3352, DINP = 3584, FF = 4096;
constexpr int NG = 2, HPG = 4, HD = 64, NQH = 8;
constexpr int NCMP = 511, NSLC = 128, NTOP = 16, WINDOW = 512;
constexpr int HGH = 4, HGD = 128;
constexpr float EPS = 1e-6f;
constexpr int C_Q = 0, C_KC = 512, C_VC = 640, C_KS = 768, C_VS = 896, C_KW = 1024, C_VW = 1152, C_GATE = 1280,
              C_HQ = 1304, C_HF = 1816, C_HI = 2328, C_HG = 2840;

constexpr size_t MiB = 1u << 20;
constexpr size_t WS_CTL = 0;
constexpr size_t WS_WIN_T = 1 * MiB;
constexpr size_t WS_WOUT_T = 8 * MiB;
constexpr size_t WS_W1_T = 10 * MiB;
constexpr size_t WS_W2_T = 18 * MiB;
constexpr size_t WS_CW1K_T = 26 * MiB;
constexpr size_t WS_CW1V_T = 26 * MiB + 512 * 1024;
constexpr size_t WS_CW2K_T = 27 * MiB;
constexpr size_t WS_CW2V_T = 27 * MiB + 16 * 1024;
constexpr size_t WS_PEK = 27 * MiB + 32 * 1024;
constexpr size_t WS_PEV = 27 * MiB + 40 * 1024;
constexpr size_t WS_LB = 27 * MiB + 48 * 1024;
constexpr size_t WS_ROPE = 27 * MiB + 256 * 1024;
constexpr size_t WS_XH = 28 * MiB;
constexpr size_t WS_HL = 28 * MiB;
constexpr size_t WS_X1H = 28 * MiB;
constexpr size_t WS_Q = 60 * MiB;
constexpr size_t WS_KC = 76 * MiB;
constexpr size_t WS_KS = 80 * MiB;
constexpr size_t WS_KW = 84 * MiB;
constexpr size_t WS_VC = 88 * MiB;
constexpr size_t WS_VST = 92 * MiB;
constexpr size_t WS_VWT = 96 * MiB;
constexpr size_t WS_GATES = 100 * MiB;
constexpr size_t WS_KCMP = 101 * MiB + 512 * 1024;
constexpr size_t WS_VCMPT = 101 * MiB + 768 * 1024;
constexpr size_t WS_HD = 102 * MiB;
constexpr size_t WS_SSQ = 102 * MiB + 512 * 1024;
constexpr size_t WS_SSQ1 = 103 * MiB;
constexpr size_t WS_HQ = 104 * MiB;
constexpr size_t WS_HLOGF = 120 * MiB;
constexpr size_t WS_HV = 136 * MiB;
constexpr size_t WS_HG = 152 * MiB;
constexpr size_t WS_OWIN = 168 * MiB;
constexpr size_t WS_HS = 184 * MiB;
constexpr size_t WS_Y = 216 * MiB;
constexpr size_t WS_HID = 104 * MiB;
constexpr size_t WS_X1Q = 60 * MiB;
constexpr size_t WS_W1Q = 248 * MiB;
constexpr size_t WS_T1COL = 252 * MiB;
constexpr size_t WS_ROWFAC = 252 * MiB + 128 * 1024;
constexpr size_t WS_WINQ = 1 * MiB;
constexpr size_t WS_XQ = 28 * MiB;
constexpr size_t WS_TIN = 252 * MiB + 256 * 1024;
constexpr size_t WS_SROW = 252 * MiB + 512 * 1024;
constexpr size_t WS_END = 256 * MiB;

constexpr int NWAVES = 8, NTHREADS = 512;
constexpr int LDS_BYTES = 147456;

#define MK_LANE() ((int)__builtin_amdgcn_mbcnt_hi(~0u, __builtin_amdgcn_mbcnt_lo(~0u, 0u)))
namespace pg8 {
#define PG8_LAS __attribute__((address_space(3)))
typedef unsigned short bf16_t;
typedef short bf16x8 __attribute__((ext_vector_type(8)));
typedef float f32x4 __attribute__((ext_vector_type(4)));
typedef unsigned u32x4 __attribute__((ext_vector_type(4)));
constexpr int BM = 256, BK = 64, HALF = 128, HTB = HALF * BK * 2  , STAGE_BYTES = 8 * HTB, NXCD = 8, WGM = 8;

__host__ __device__ __forceinline__ int lds_byte(int r, int c) { const int st = (r >> 4) * 2 + (c >> 5), rr = r & 15, cc = c & 31, ob = rr * 64 + cc * 2; return st * 1024 + (ob ^ (((ob >> 9) & 1) << 5)); }
__host__ __device__ __forceinline__ void stage_rc(int b, int& R, int& C) { const int st = b / 1024, sb = b % 1024, swz = sb ^ (((sb >> 9) & 1) << 5); R = (st >> 1) * 16 + swz / 64; C = (st & 1) * 32 + (swz % 64) / 2; }
__host__ __device__ __forceinline__ int perm32(int rho) { const int n = rho >> 4, i = rho & 15; return 8 * (i >> 2) + 4 * n + (i & 3); }

struct Unit { int pm, pn; };
struct Gemm { const bf16_t* A; const bf16_t* Bt; int M, N, K; };

struct StaticOrder {
    int nM, nN, nwg, G, c;
    __host__ __device__ void init(int M, int N, int G_, int c_) { nM = M / BM; nN = N / BM; nwg = nM * nN; G = G_; c = c_; }
    __host__ __device__ bool next(int i, Unit& u) const {
        const long L = (long)i * G + c; if (L >= nwg) return false;
        int wgid = (int)L; { const int q = nwg / NXCD, r = nwg % NXCD, xcd = wgid % NXCD, off = wgid / NXCD; wgid = (xcd < r ? xcd * (q + 1) : r * (q + 1) + (xcd - r) * q) + off; }
        const int nig = WGM * nN, gid = wgid / nig, fm = gid * WGM, gsz = (nM - fm) < WGM ? (nM - fm) : WGM;
        u.pm = fm + ((wgid % nig) % gsz); u.pn = (wgid % nig) / gsz; return true;
    }
    __device__ __forceinline__ void a_ready(const Unit&) const {}
    __device__ __forceinline__ void done(const Unit&) const {}
};

#define PG8_MFMA(a, b, c) __builtin_amdgcn_mfma_f32_16x16x32_f16(__builtin_bit_cast(h16x8, (a)), __builtin_bit_cast(h16x8, (b)), (c), 0, 0, 0)
struct EpiOutProj {
    static constexpr bool PERM = false, AFTER_DRAIN = false;
    const float* x; u16* x1h;
    __device__ __forceinline__ void operator()(const f32x4 (&acc)[2][2][4][2], const Unit& u, int wr, int wc, int fr, int fq) const {
        const int col0 = u.pn * BM + wc * 32 + 4 * fq;
#pragma unroll
        for (int ai = 0; ai < 2; ++ai) {
            f32x4 xr[4][2][2];
#pragma unroll
            for (int m = 0; m < 4; ++m) {
                const size_t off = (size_t)(u.pm * BM + ai * HALF + wr * 64 + m * 16 + fr) * DM + col0;
#pragma unroll
                for (int bj = 0; bj < 2; ++bj)
#pragma unroll
                    for (int n = 0; n < 2; ++n) xr[m][bj][n] = *(const f32x4*)(x + off + bj * HALF + n * 16);
            }
#pragma unroll
            for (int m = 0; m < 4; ++m) {
                const int row = u.pm * BM + ai * HALF + wr * 64 + m * 16 + fr;
                const size_t off = (size_t)row * DM + col0;
#pragma unroll
                for (int bj = 0; bj < 2; ++bj)
#pragma unroll
                    for (int n = 0; n < 2; ++n) {
                        const f32x4 v = acc[ai][bj][m][n] + xr[m][bj][n];
                        u32x2 w; w.x = pkh(v[0], v[1]); w.y = pkh(v[2], v[3]);
                        *(u32x2*)(x1h + off + bj * HALF + n * 16) = w;
                    }
            }
        }
    }
};
struct EpiUp {
    static constexpr bool PERM = true, AFTER_DRAIN = false;
    unsigned char* hid; const float* rowfac; const float* t1col;
    __device__ __forceinline__ void operator()(const f32x4 (&acc)[2][2][4][2], const Unit& u, int wr, int wc, int fr, int fq) const {
        const int col0 = u.pn * BM + wc * 32 + 8 * fq;
        float rf[2][4]; f32x4 tc[2][2];
#pragma unroll
        for (int ai = 0; ai < 2; ++ai)
#pragma unroll
            for (int m = 0; m < 4; ++m) rf[ai][m] = rowfac[u.pm * BM + ai * HALF + wr * 64 + m * 16 + fr];
#pragma unroll
        for (int bj = 0; bj < 2; ++bj) { tc[bj][0] = *(const f32x4*)(t1col + col0 + bj * HALF); tc[bj][1] = *(const f32x4*)(t1col + col0 + bj * HALF + 4); }
#pragma unroll
        for (int ai = 0; ai < 2; ++ai)
#pragma unroll
            for (int m = 0; m < 4; ++m) {
                const int row = u.pm * BM + ai * HALF + wr * 64 + m * 16 + fr;
                const float rs = rf[ai][m];
                unsigned char* rowp = hid + (size_t)row * FF + col0;
#pragma unroll
                for (int bj = 0; bj < 2; ++bj) {
                    const i32x4 i0 = __builtin_bit_cast(i32x4, acc[ai][bj][m][0]), i1 = __builtin_bit_cast(i32x4, acc[ai][bj][m][1]);
                    f32x4 v0, v1;
#pragma unroll
                    for (int e = 0; e < 4; ++e) {
                        const float a = fmaxf((float)i0[e] * (rs * tc[bj][0][e]), 0.f), b = fmaxf((float)i1[e] * (rs * tc[bj][1][e]), 0.f);
                        v0[e] = fminf(a * a, F8_MAX); v1[e] = fminf(b * b, F8_MAX);
                    }
                    u32x2 w; w.x = pkf8x4(v0[0], v0[1], v0[2], v0[3]); w.y = pkf8x4(v1[0], v1[1], v1[2], v1[3]);
                    *(u32x2*)(rowp + bj * HALF) = w;
                }
            }
    }
};
struct EpiDown {
    static constexpr bool PERM = false, AFTER_DRAIN = false;
    float* out; const u16* x1h;
    __device__ __forceinline__ void operator()(const f32x4 (&acc)[2][2][4][2], const Unit& u, int wr, int wc, int fr, int fq) const {
        const int col0 = u.pn * BM + wc * 32 + 4 * fq;
        constexpr float DS = 1.0f / (HID_SCALE * W2_SCALE);
#pragma unroll
        for (int ai = 0; ai < 2; ++ai) {
            u32x2 xr[4][2][2];
#pragma unroll
            for (int m = 0; m < 4; ++m) {
                const size_t off = (size_t)(u.pm * BM + ai * HALF + wr * 64 + m * 16 + fr) * DM + col0;
#pragma unroll
                for (int bj = 0; bj < 2; ++bj)
#pragma unroll
                    for (int n = 0; n < 2; ++n) xr[m][bj][n] = *(const u32x2*)(x1h + off + bj * HALF + n * 16);
            }
#pragma unroll
            for (int m = 0; m < 4; ++m) {
                const size_t off = (size_t)(u.pm * BM + ai * HALF + wr * 64 + m * 16 + fr) * DM + col0;
#pragma unroll
                for (int bj = 0; bj < 2; ++bj)
#pragma unroll
                    for (int n = 0; n < 2; ++n) {
                        const h16x4 r = __builtin_bit_cast(h16x4, xr[m][bj][n]);
                        f32x4 o = acc[ai][bj][m][n]; o[0] = o[0] * DS + (float)r[0]; o[1] = o[1] * DS + (float)r[1]; o[2] = o[2] * DS + (float)r[2]; o[3] = o[3] * DS + (float)r[3];
                        *(f32x4*)(out + off + bj * HALF + n * 16) = o;
                    }
            }
        }
    }
};
struct EpiInProj {
    static constexpr bool PERM = true, AFTER_DRAIN = false;
    unsigned char* ws; const float* qg; const float* kg;
    __device__ __forceinline__ void operator()(f32x4 (&acc)[2][2][4][2], const Unit& u, int wr, int wc, int fr, int fq) const {
        const int pn = u.pn;
        {
            f32x4 tcv[2][2]; float rsc[2][4];
            int fr_ = fr, fq_ = fq; asm volatile("" : "+v"(fr_), "+v"(fq_));
            const float* tp = (const float*)(ws + WS_TIN) + pn * BM + wc * 32 + 8 * fq_;
#pragma unroll
            for (int bj = 0; bj < 2; ++bj) { tcv[bj][0] = *(const f32x4*)(tp + bj * HALF); tcv[bj][1] = *(const f32x4*)(tp + bj * HALF + 4); }
#pragma unroll
            for (int ai = 0; ai < 2; ++ai)
#pragma unroll
                for (int m = 0; m < 4; ++m) rsc[ai][m] = ((const float*)(ws + WS_SROW))[u.pm * BM + ai * HALF + wr * 64 + m * 16 + fr_];
#pragma unroll
            for (int ai = 0; ai < 2; ++ai)
#pragma unroll
                for (int m = 0; m < 4; ++m)
#pragma unroll
                    for (int bj = 0; bj < 2; ++bj)
#pragma unroll
                        for (int n = 0; n < 2; ++n) {
                            const i32x4 iv = __builtin_bit_cast(i32x4, acc[ai][bj][m][n]); f32x4 o;
#pragma unroll
                            for (int e = 0; e < 4; ++e) o[e] = (float)iv[e] * (rsc[ai][m] * tcv[bj][n][e]);
                            asm volatile("" : "+v"(o));
                            acc[ai][bj][m][n] = o;
                        }
        }
        const bool normed = (pn < 2) || (pn < 5 && wc < 2);
        float gn[2][8];
        if (normed) {
            const float* gp = pn < 2 ? qg : kg;
#pragma unroll
            for (int bj = 0; bj < 2; ++bj) { const f32x4 a = *(const f32x4*)(gp + 32 * bj + 8 * fq), b = *(const f32x4*)(gp + 32 * bj + 8 * fq + 4);
#pragma unroll
                for (int e = 0; e < 4; ++e) { gn[bj][e] = a[e]; gn[bj][4 + e] = b[e]; } }
        }
        float lbv[2][8];
        if (pn == 7 || pn == 8) {
            const float* lp = (const float*)(ws + WS_LB) + 256 * (pn - 7) + 64 * wc + 8 * fq;
#pragma unroll
            for (int bj = 0; bj < 2; ++bj) { const f32x4 a = *(const f32x4*)(lp + 32 * bj), b = *(const f32x4*)(lp + 32 * bj + 4);
#pragma unroll
                for (int e = 0; e < 4; ++e) { lbv[bj][e] = a[e]; lbv[bj][4 + e] = b[e]; } }
        }
#pragma unroll
        for (int ai = 0; ai < 2; ++ai) {
            f32x4 rpv[4][4];
#pragma unroll
            for (int m = 0; m < 4; ++m) {
                if (normed && (m & 1) == 0) {
#pragma unroll
                    for (int mm = m; mm < m + 2; ++mm) { const int t_ = (u.pm * BM + ai * HALF + wr * 64 + mm * 16 + fr) & (SEQ - 1); const f32x4* rp_ = (const f32x4*)((const float*)(ws + WS_ROPE) + (size_t)t_ * 16);
#pragma unroll
                        for (int q4 = 0; q4 < 4; ++q4) rpv[mm][q4] = rp_[q4]; }
                }
                const int row = u.pm * BM + ai * HALF + wr * 64 + m * 16 + fr;
                const int b = row >> 13, t = row & (SEQ - 1);
                float v[2][8];
#pragma unroll
                for (int bj = 0; bj < 2; ++bj)
#pragma unroll
                    for (int e = 0; e < 4; ++e) { v[bj][e] = acc[ai][bj][m][0][e]; v[bj][4 + e] = acc[ai][bj][m][1][e]; }
                if (normed) {
                    float ss = 0.f;
#pragma unroll
                    for (int bj = 0; bj < 2; ++bj)
#pragma unroll
                        for (int e = 0; e < 8; ++e) ss += v[bj][e] * v[bj][e];
                    ss += __shfl_xor(ss, 16); ss += __shfl_xor(ss, 32);
                    const float rstd = 1.0f / sqrtf(ss * (1.0f / 64.f) + EPS);
#pragma unroll
                    for (int bj = 0; bj < 2; ++bj)
#pragma unroll
                        for (int e = 0; e < 8; ++e) v[bj][e] = v[bj][e] * rstd * gn[bj][e];
                    const f32x4 r0 = rpv[m][0], r1 = rpv[m][1], r2 = rpv[m][2], r3 = rpv[m][3];
                    const float cs[8] = {r0[0], r0[2], r1[0], r1[2], r2[0], r2[2], r3[0], r3[2]};
                    const float sn[8] = {r0[1], r0[3], r1[1], r1[3], r2[1], r2[3], r3[1], r3[3]};
#pragma unroll
                    for (int e = 0; e < 8; ++e) {
                        const float other = __shfl_xor(v[0][e], 16);
                        const float r1v = v[0][e] * cs[e] - other * sn[e];
                        const float r2v = v[0][e] * cs[e] + other * sn[e];
                        v[0][e] = fq == 0 ? r1v : (fq == 1 ? r2v : v[0][e]);
                    }
                    const float sc = pn < 2 ? 0.125f * 1.4426950408889634f : 1.0f;
                    u16* dst;
                    if (pn < 2) dst = (u16*)(ws + WS_Q) + (size_t)row * 512 + (4 * pn + wc) * 64 + 8 * fq;
                    else dst = (u16*)(ws + (pn == 2 ? WS_KC : pn == 3 ? WS_KS : WS_KW)) + ((size_t)(b * NG + wc) * SEQ + t) * 64 + 8 * fq;
#pragma unroll
                    for (int bj = 0; bj < 2; ++bj) {
                        u32x4 w; w.x = pkh(v[bj][0] * sc, v[bj][1] * sc); w.y = pkh(v[bj][2] * sc, v[bj][3] * sc); w.z = pkh(v[bj][4] * sc, v[bj][5] * sc); w.w = pkh(v[bj][6] * sc, v[bj][7] * sc);
                        *(u32x4*)(dst + 32 * bj) = w;
                    }
                } else if (pn < 5) {
                    const int g = wc - 2;
                    if (pn == 2) {
                        u16* dst = (u16*)(ws + WS_VC) + ((size_t)(b * NG + g) * SEQ + t) * 64 + 8 * fq;
#pragma unroll
                        for (int bj = 0; bj < 2; ++bj) {
                            u32x4 w; w.x = pkh(v[bj][0], v[bj][1]); w.y = pkh(v[bj][2], v[bj][3]); w.z = pkh(v[bj][4], v[bj][5]); w.w = pkh(v[bj][6], v[bj][7]);
                            *(u32x4*)(dst + 32 * bj) = w;
                        }
                    } else {
                        u16* dst = (u16*)(ws + (pn == 3 ? WS_VST : WS_VWT)) + (((size_t)(b * NG + g) * 128 + (t >> 6)) * 64 + 8 * fq) * 64 + (t & 63);
#pragma unroll
                        for (int bj = 0; bj < 2; ++bj)
#pragma unroll
                            for (int e = 0; e < 8; ++e) dst[(32 * bj + e) * 64] = f2h(v[bj][e]);
                    }
                } else if (pn < 13) {
                    const int kind = (pn - 5) >> 1;
                    const int col = 256 * ((pn - 5) & 1) + 64 * wc + 8 * fq;
                    u16* dst = (u16*)(ws + (kind == 0 ? WS_HQ : kind == 1 ? WS_HLOGF : kind == 2 ? WS_HV : WS_HG)) + (size_t)row * 512 + col;
#pragma unroll
                    for (int bj = 0; bj < 2; ++bj) {
                        float o[8];
#pragma unroll
                        for (int e = 0; e < 8; ++e) {
                            const float x = v[bj][e];
                            if (kind == 0 || kind == 3) o[e] = x * sigmoid_f(x);
                            else if (kind == 1) { const float l = lbv[bj][e]; o[e] = __logf(l + (1.f - l) * sigmoid_f(x)); }
                            else o[e] = x;
                        }
                        u32x4 w;
                        if (kind == 0 || kind == 2) { w.x = pkb(o[0], o[1]); w.y = pkb(o[2], o[3]); w.z = pkb(o[4], o[5]); w.w = pkb(o[6], o[7]); }
                        else { w.x = pkh(o[0], o[1]); w.y = pkh(o[2], o[3]); w.z = pkh(o[4], o[5]); w.w = pkh(o[6], o[7]); }
                        *(u32x4*)(dst + 32 * bj) = w;
                    }
                } else {
                    if (wc == 0 && fq < 3) {
                        float* dst = (float*)(ws + WS_GATES) + (size_t)row * 24 + 8 * fq;
                        f32x4 a, c;
#pragma unroll
                        for (int e = 0; e < 4; ++e) { a[e] = sigmoid_f(v[0][e]); c[e] = sigmoid_f(v[0][4 + e]); }
                        *(f32x4*)dst = a; *(f32x4*)(dst + 4) = c;
                    }
                }
            }
        }
    }
};
template <class Epi, class Sched, bool ALIGN_EPI = false, bool SP2 = false, int MODE = 0>
__device__ __forceinline__ void gemm_phase(PG8_LAS unsigned char* lds, const Gemm g, const Sched& S, const Epi& E, int wave_in) {
    const int tid = threadIdx.x, wid = __builtin_amdgcn_readfirstlane(tid >> 6), lane = tid & 63, wr = wid >> 2, wc = wid & 3, fr = lane & 15, fq = lane >> 4;
    const int K = g.K, nt = K / BK;
    unsigned voffA[2], voffB[2];
#pragma unroll
    for (int i = 0; i < 2; ++i) { int R, C; stage_rc(tid * 16 + i * 8192, R, C); const int Rb = Epi::PERM ? ((R & ~31) + perm32(R & 31)) : R;
        voffA[i] = (unsigned)(R * K + C) * 2u; voffB[i] = (unsigned)(Rb * K + C) * 2u; }
    const size_t kstep = (size_t)(BK * 2);
    const size_t hstep = (size_t)HALF * K * 2;
    const size_t tstep = 2 * hstep;
    const unsigned ldsw = (unsigned)wid * 1024u;
    const int aoff = lds_byte(wr * 64 + fr, fq * 8), boff = lds_byte(wc * 32 + fr, fq * 8);
#define PG8_SA(b, h) (((b) * 2 + (h)) * HTB)
#define PG8_SB(b, h) ((4 + (b) * 2 + (h)) * HTB)
#define PG8_STAGE(bufoff, gbase, voff) do { _Pragma("unroll") for (int _i = 0; _i < 2; ++_i) \
        __builtin_amdgcn_global_load_lds((const unsigned*)((const char*)(gbase) + (voff)[_i]), (PG8_LAS unsigned*)(lds + (bufoff) + ldsw + _i * 8192), 16, 0, 0); } while (0)
#define PG8_LDA(dst, b, h) do { _Pragma("unroll") for (int m = 0; m < 4; ++m) _Pragma("unroll") for (int k = 0; k < 2; ++k) dst[m][k] = *(const PG8_LAS bf16x8*)(lds + PG8_SA(b, h) + aoff + m * 2048 + k * 1024); } while (0)
#define PG8_LDB(dst, b, h) do { _Pragma("unroll") for (int n = 0; n < 2; ++n) _Pragma("unroll") for (int k = 0; k < 2; ++k) dst[n][k] = *(const PG8_LAS bf16x8*)(lds + PG8_SB(b, h) + boff + n * 2048 + k * 1024); } while (0)
#define PG8_CAT(x0, x1) __builtin_shufflevector(__builtin_bit_cast(i32x4, (x0)), __builtin_bit_cast(i32x4, (x1)), 0, 1, 2, 3, 4, 5, 6, 7)
#define PG8_MMA(ai, bj, At, Bt) do { __builtin_amdgcn_s_setprio(1); _Pragma("unroll") for (int m = 0; m < 4; ++m) _Pragma("unroll") for (int n = 0; n < 2; ++n) { \
        if constexpr (MODE == 1) asm volatile("v_mfma_scale_f32_16x16x128_f8f6f4 %0, %1, %2, %0, %3, %3 op_sel_hi:[0,0,0]" : "+v"(acc[ai][bj][m][n]) : "v"(PG8_CAT(Bt[n][0], Bt[n][1])), "v"(PG8_CAT(At[m][0], At[m][1])), "v"(mxs)); \
        else if constexpr (MODE == 2) { _Pragma("unroll") for (int k = 0; k < 2; ++k) acc[ai][bj][m][n] = __builtin_bit_cast(f32x4, __builtin_amdgcn_mfma_i32_16x16x64_i8(__builtin_bit_cast(i32x4, Bt[n][k]), __builtin_bit_cast(i32x4, At[m][k]), __builtin_bit_cast(i32x4, acc[ai][bj][m][n]), 0, 0, 0)); } \
        else { _Pragma("unroll") for (int k = 0; k < 2; ++k) acc[ai][bj][m][n] = PG8_MFMA(Bt[n][k], At[m][k], acc[ai][bj][m][n]); } } __builtin_amdgcn_s_setprio(0); } while (0)
#define PG8_WAIT_V(n) asm volatile("s_waitcnt vmcnt(" #n ")" ::: "memory")
#define PG8_WAIT_L(n) asm volatile("s_waitcnt lgkmcnt(" #n ")" ::: "memory")
#define PG8_BAR __builtin_amdgcn_s_barrier()
#define PG8_SCHED __builtin_amdgcn_sched_barrier(0)
    const int mxs = 0x7F7F7F7F;
    Unit cur, nxt; int ui = 0;
    if (!S.next(0, cur)) return;
    f32x4 acc[2][2][4][2];
#pragma unroll
    for (int a = 0; a < 2; ++a)
#pragma unroll
        for (int b = 0; b < 2; ++b)
#pragma unroll
            for (int m = 0; m < 4; ++m)
#pragma unroll
                for (int n = 0; n < 2; ++n) acc[a][b][m][n] = (f32x4){0.f, 0.f, 0.f, 0.f};
    bf16x8 At[4][2], B0[2][2], B1[2][2];
    const char* cA = (const char*)g.A + (size_t)cur.pm * tstep; const char* cB = (const char*)g.Bt + (size_t)cur.pn * tstep;
    S.a_ready(cur);
    if constexpr (SP2) {
        PG8_STAGE(PG8_SB(0, 0), cB, voffB); PG8_STAGE(PG8_SB(0, 1), cB + hstep, voffB); PG8_STAGE(PG8_SA(0, 0), cA, voffA); PG8_STAGE(PG8_SA(0, 1), cA + hstep, voffA);
        if (wr == 1) PG8_BAR;
        PG8_WAIT_V(2); PG8_BAR;
        PG8_STAGE(PG8_SB(1, 0), cB + kstep, voffB); PG8_STAGE(PG8_SA(1, 0), cA + kstep, voffA); PG8_STAGE(PG8_SB(1, 1), cB + hstep + kstep, voffB);
        PG8_WAIT_V(6); PG8_BAR;
    } else {
        PG8_STAGE(PG8_SB(0, 0), cB, voffB); PG8_STAGE(PG8_SA(0, 0), cA, voffA); PG8_STAGE(PG8_SB(0, 1), cB + hstep, voffB); PG8_STAGE(PG8_SA(0, 1), cA + hstep, voffA);
        if (wr == 1) PG8_BAR;
        PG8_WAIT_V(4); PG8_BAR;
        PG8_STAGE(PG8_SB(1, 0), cB + kstep, voffB); PG8_STAGE(PG8_SA(1, 0), cA + kstep, voffA); PG8_STAGE(PG8_SB(1, 1), cB + hstep + kstep, voffB);
        PG8_WAIT_V(6); PG8_BAR;
    }
    for (;;) {
        const bool has_next = S.next(ui + 1, nxt);
        const char* nA = has_next ? (const char*)g.A + (size_t)nxt.pm * tstep : cA; const char* nB = has_next ? (const char*)g.Bt + (size_t)nxt.pn * tstep : cB;
        for (int t = 0; t < nt; t += 2) {
            const bool last = (t == nt - 2);
            const char* a1 = cA + (size_t)(t + 1) * kstep;
            const char* a2 = last ? nA : cA + (size_t)(t + 2) * kstep; const char* b2 = last ? nB : cB + (size_t)(t + 2) * kstep;
            const char* a3 = a2 + kstep; const char* b3 = b2 + kstep;
            if (last && has_next) S.a_ready(nxt);
            if constexpr (SP2) {
            PG8_LDB(B0, 0, 0); PG8_LDB(B1, 0, 1); PG8_SCHED; PG8_LDA(At, 0, 0); PG8_STAGE(PG8_SA(1, 1), a1 + hstep, voffA);
            PG8_WAIT_V(8); PG8_WAIT_L(0); PG8_BAR; PG8_MMA(0, 0, At, B0); PG8_MMA(0, 1, At, B1); PG8_BAR; PG8_SCHED;
            PG8_LDA(At, 0, 1); PG8_STAGE(PG8_SB(0, 0), b2, voffB); PG8_STAGE(PG8_SB(0, 1), b2 + hstep, voffB); PG8_STAGE(PG8_SA(0, 0), a2, voffA);
            PG8_WAIT_V(8); PG8_WAIT_L(0); PG8_BAR; PG8_MMA(1, 0, At, B0); PG8_MMA(1, 1, At, B1); PG8_BAR; PG8_SCHED;
            PG8_LDB(B0, 1, 0); PG8_LDB(B1, 1, 1); PG8_SCHED; PG8_LDA(At, 1, 0); PG8_STAGE(PG8_SA(0, 1), a2 + hstep, voffA);
            PG8_WAIT_V(8); PG8_WAIT_L(0); PG8_BAR; PG8_MMA(0, 0, At, B0); PG8_MMA(0, 1, At, B1); PG8_BAR; PG8_SCHED;
            PG8_LDA(At, 1, 1); PG8_STAGE(PG8_SB(1, 0), b3, voffB); PG8_STAGE(PG8_SB(1, 1), b3 + hstep, voffB); PG8_STAGE(PG8_SA(1, 0), a3, voffA);
            PG8_WAIT_V(8); PG8_WAIT_L(0); PG8_BAR; PG8_MMA(1, 0, At, B0); PG8_MMA(1, 1, At, B1); PG8_BAR; PG8_SCHED;
            } else {
            PG8_LDB(B0, 0, 0); PG8_SCHED; PG8_LDA(At, 0, 0); PG8_STAGE(PG8_SA(1, 1), a1 + hstep, voffA);
            PG8_WAIT_L(8); PG8_BAR; PG8_WAIT_L(0); PG8_MMA(0, 0, At, B0); PG8_BAR; PG8_SCHED;
            PG8_LDB(B1, 0, 1); PG8_STAGE(PG8_SB(0, 0), b2, voffB);
            PG8_BAR; PG8_WAIT_L(0); PG8_MMA(0, 1, At, B1); PG8_BAR;
            PG8_LDA(At, 0, 1); PG8_STAGE(PG8_SA(0, 0), a2, voffA);
            PG8_BAR; PG8_WAIT_L(0); PG8_MMA(1, 0, At, B0); PG8_BAR; PG8_SCHED;
            PG8_STAGE(PG8_SB(0, 1), b2 + hstep, voffB);
            PG8_WAIT_V(6); PG8_BAR; PG8_MMA(1, 1, At, B1); PG8_BAR;
            PG8_LDB(B0, 1, 0); PG8_SCHED; PG8_LDA(At, 1, 0); PG8_STAGE(PG8_SA(0, 1), a2 + hstep, voffA);
            PG8_WAIT_L(8); PG8_BAR; PG8_WAIT_L(0); PG8_MMA(0, 0, At, B0); PG8_BAR; PG8_SCHED;
            PG8_LDB(B1, 1, 1); PG8_STAGE(PG8_SB(1, 0), b3, voffB);
            PG8_BAR; PG8_WAIT_L(0); PG8_MMA(0, 1, At, B1); PG8_BAR;
            PG8_LDA(At, 1, 1); PG8_STAGE(PG8_SA(1, 0), a3, voffA);
            PG8_BAR; PG8_WAIT_L(0); PG8_MMA(1, 0, At, B0); PG8_BAR; PG8_SCHED;
            PG8_STAGE(PG8_SB(1, 1), b3 + hstep, voffB);
            PG8_WAIT_V(6); PG8_BAR; PG8_MMA(1, 1, At, B1); PG8_BAR;
            }
        }
        if constexpr (MODE == 1) asm volatile("s_nop 15\n\ts_nop 15" ::: "memory");
        if constexpr (ALIGN_EPI) { if (wr == 0) PG8_BAR; }
        if constexpr (!Epi::AFTER_DRAIN) { E(acc, cur, wr, wc, fr, fq); S.done(cur); }
        if (!has_next) break;
#pragma unroll
        for (int a = 0; a < 2; ++a)
#pragma unroll
            for (int b = 0; b < 2; ++b)
#pragma unroll
                for (int m = 0; m < 4; ++m)
#pragma unroll
                    for (int n = 0; n < 2; ++n) acc[a][b][m][n] = (f32x4){0.f, 0.f, 0.f, 0.f};
        cur = nxt; cA = nA; cB = nB; ++ui;
        if constexpr (ALIGN_EPI) { if (wr == 1) PG8_BAR; }
    }
    PG8_WAIT_V(0);
    if constexpr (!ALIGN_EPI) { if (wr == 0) PG8_BAR; }
    PG8_BAR;
    if constexpr (Epi::AFTER_DRAIN) { E.fused(acc, cur, wr, wc, fr, fq, lds, wid, lane); S.done(cur); }
#undef PG8_SA
#undef PG8_SB
#undef PG8_STAGE
#undef PG8_LDA
#undef PG8_LDB
#undef PG8_MMA
#undef PG8_CAT
#undef PG8_WAIT_V
#undef PG8_WAIT_L
#undef PG8_BAR
#undef PG8_SCHED
}
}
#define LDS_WAIT() asm volatile("s_waitcnt lgkmcnt(0)" ::: "memory")
#define VM_WAIT() asm volatile("s_waitcnt vmcnt(0)" ::: "memory")

struct Params {
    const float* in[18];
    float* out;
    unsigned char* ws;
    float invf[8];
    int ph_lo, ph_hi;
};

__device__ __forceinline__ void sincos_acc(float ang, float& s, float& c) {
    const double x = (double)ang;
    const double k = rint(x * 0.6366197723675814);
    double r = fma(-k, 1.5707963267948966, x); r = fma(-k, 6.123233995736766e-17, r);
    const int q = ((int)k) & 3;
    const double r2 = r * r;
    const double sp = r * (1.0 + r2 * (-1.0 / 6 + r2 * (1.0 / 120 + r2 * (-1.0 / 5040 + r2 * (1.0 / 362880 + r2 * (-1.0 / 39916800 + r2 * (1.0 / 6227020800.0)))))));
    const double cp = 1.0 + r2 * (-0.5 + r2 * (1.0 / 24 + r2 * (-1.0 / 720 + r2 * (1.0 / 40320 + r2 * (-1.0 / 3628800 + r2 * (1.0 / 479001600.0 + r2 * (-1.0 / 87178291200.0)))))));
    double ss, cc;
    if (q == 0) { ss = sp; cc = cp; } else if (q == 1) { ss = cp; cc = -sp; } else if (q == 2) { ss = -sp; cc = -cp; } else { ss = -cp; cc = sp; }
    s = (float)ss; c = (float)cc;
}

struct ColId { __device__ __forceinline__ int operator()(int n) const { return n; } };
struct ColWin {
    __device__ __forceinline__ int operator()(int P) const {
        const int pn = P >> 8, p = P & 255, bj = p >> 7, wc = (p >> 5) & 3, j = p & 31;
        const int Lp = 256 * pn + 64 * wc + 32 * bj + j;
        return Lp < 1280 ? Lp : (Lp < 3328 ? Lp + 24 : (Lp < 3352 ? Lp - 3328 + 1280 : -1));
    }
};
__device__ __forceinline__ unsigned q8x4(float a, float b, float c, float d) {
    const int ia = (int)rintf(a), ib = (int)rintf(b), ic = (int)rintf(c), id = (int)rintf(d);
    return (unsigned)(ia & 255) | ((unsigned)(ib & 255) << 8) | ((unsigned)(ic & 255) << 16) | ((unsigned)id << 24);
}
template <class SrcCol, bool F8 = false>
__device__ __forceinline__ void p0_transpose_item(const float* __restrict__ W, int K, int Nsrc, u16* WT, const float* rowscale, SrcCol sc, LAS float* scr, int kb, int nb, int lane) {
    const int k0 = 64 * kb, n0 = 32 * nb;
    const int scol = sc(n0 + (lane & 31));
#pragma unroll
    for (int i = 0; i < 32; ++i) {
        const int kk = 2 * i + (lane >> 5);
        float v = scol >= 0 ? W[(size_t)(k0 + kk) * Nsrc + scol] : 0.f;
        if (rowscale) v *= rowscale[k0 + kk];
        scr[kk * 33 + (lane & 31)] = v;
    }
    LDS_WAIT(); asm volatile("" ::: "memory");
    const int c = lane & 7;
#pragma unroll
    for (int j = 0; j < 4; ++j) {
        const int n = (lane >> 3) + 8 * j; const LAS float* s = scr + (8 * c) * 33 + n;
        if constexpr (F8) {
            u32x2 o; o.x = pkf8x4(clamp8(s[0 * 33] * W2_SCALE), clamp8(s[1 * 33] * W2_SCALE), clamp8(s[2 * 33] * W2_SCALE), clamp8(s[3 * 33] * W2_SCALE));
            o.y = pkf8x4(clamp8(s[4 * 33] * W2_SCALE), clamp8(s[5 * 33] * W2_SCALE), clamp8(s[6 * 33] * W2_SCALE), clamp8(s[7 * 33] * W2_SCALE));
            *(u32x2*)((unsigned char*)WT + (size_t)(n0 + n) * K + k0 + 8 * c) = o;
        } else {
        u32x4 o; o.x = pkh(s[0 * 33], s[1 * 33]); o.y = pkh(s[2 * 33], s[3 * 33]); o.z = pkh(s[4 * 33], s[5 * 33]); o.w = pkh(s[6 * 33], s[7 * 33]);
        *(u32x4*)(WT + (size_t)(n0 + n) * K + k0 + 8 * c) = o;
        }
    }
    LDS_WAIT(); asm volatile("" ::: "memory");
}

__device__ __forceinline__ void p0_late_transposes(const Params& p, LAS unsigned char* lds, int gw, int NGW, int wave, int lane) {
    unsigned char* ws = p.ws;
    LAS float* scr = (LAS float*)(lds + wave * 16384);
    constexpr int I_WOUT = 16 * 32, I_W1 = 16 * (FF / 32), I_W2 = (FF / 64) * 32, I_C1 = 32 * 4, I_C2 = 2 * 2;
    constexpr int NITEMS = I_WOUT + I_W1 + I_W2 + 2 * I_C1 + 2 * I_C2;
    for (int it = gw; it < NITEMS; it += NGW) {
        int r = it;
        if (r < I_C1) { p0_transpose_item(p.in[6], 2048, 128, (u16*)(ws + WS_CW1K_T), nullptr, ColId(), scr, r / 4, r % 4, lane); continue; } r -= I_C1;
        if (r < I_C1) { p0_transpose_item(p.in[9], 2048, 128, (u16*)(ws + WS_CW1V_T), nullptr, ColId(), scr, r / 4, r % 4, lane); continue; } r -= I_C1;
        if (r < I_C2) { p0_transpose_item(p.in[7], 128, 64, (u16*)(ws + WS_CW2K_T), nullptr, ColId(), scr, r / 2, r % 2, lane); continue; } r -= I_C2;
        if (r < I_C2) { p0_transpose_item(p.in[10], 128, 64, (u16*)(ws + WS_CW2V_T), nullptr, ColId(), scr, r / 2, r % 2, lane); continue; } r -= I_C2;
        if (r < I_WOUT) { p0_transpose_item(p.in[14], DM, DM, (u16*)(ws + WS_WOUT_T), nullptr, ColId(), scr, r / 32, r % 32, lane); continue; } r -= I_WOUT;
        if (r < I_W1) { p0_transpose_item(p.in[16], DM, FF, (u16*)(ws + WS_W1_T), p.in[15], ColId(), scr, r / (FF / 32), r % (FF / 32), lane); continue; } r -= I_W1;
        p0_transpose_item<ColId, true>(p.in[17], FF, DM, (u16*)(ws + WS_W2_T), nullptr, ColId(), scr, r / 32, r % 32, lane);
    }
}
__device__ __forceinline__ void p0_win_strip(const Params& p, LAS unsigned char* lds, int strip, int wave, int lane) {
    unsigned char* ws = p.ws;
    constexpr int BLK = 64 * 33;
    LAS float* scr = (LAS float*)(lds + wave * (2 * BLK * 4));
    LAS float* cmx = (LAS float*)(lds + NWAVES * (2 * BLK * 4));
    const float* __restrict__ W = p.in[2];
    const int n0 = 32 * strip, scol = ColWin()(n0 + (lane & 31));
    float mloc = 0.f;
#pragma unroll
    for (int b = 0; b < 2; ++b) {
        const int k0 = 64 * (wave + 8 * b);
        float t[32];
#pragma unroll
        for (int i = 0; i < 32; ++i) { const int kk = 2 * i + (lane >> 5); t[i] = scol >= 0 ? W[(size_t)(k0 + kk) * DIN + scol] : 0.f; }
#pragma unroll
        for (int i = 0; i < 32; ++i) { const int kk = 2 * i + (lane >> 5); scr[b * BLK + kk * 33 + (lane & 31)] = t[i]; mloc = fmaxf(mloc, fabsf(t[i])); }
    }
    mloc = fmaxf(mloc, __shfl_xor(mloc, 32));
    if (lane < 32) cmx[wave * 32 + lane] = mloc;
    __syncthreads();
    float inv[4];
#pragma unroll
    for (int j = 0; j < 4; ++j) {
        const int n = (lane >> 3) + 8 * j; float m = 0.f;
#pragma unroll
        for (int w = 0; w < NWAVES; ++w) m = fmaxf(m, cmx[w * 32 + n]);
        inv[j] = m > 0.f ? 127.f / m : 0.f;
        if (wave == 0 && (lane & 7) == 0) ((float*)(ws + WS_TIN))[n0 + n] = m * (1.0f / 127.f);
    }
    const int c = lane & 7;
#pragma unroll
    for (int b = 0; b < 2; ++b) {
        const int k0 = 64 * (wave + 8 * b);
#pragma unroll
        for (int j = 0; j < 4; ++j) {
            const int n = (lane >> 3) + 8 * j; const LAS float* s = scr + b * BLK + (8 * c) * 33 + n; const float iv = inv[j];
            u32x2 o; o.x = q8x4(s[0 * 33] * iv, s[1 * 33] * iv, s[2 * 33] * iv, s[3 * 33] * iv); o.y = q8x4(s[4 * 33] * iv, s[5 * 33] * iv, s[6 * 33] * iv, s[7 * 33] * iv);
            *(u32x2*)(ws + WS_WINQ + (size_t)(n0 + n) * DM + k0 + 8 * c) = o;
        }
    }
    __syncthreads();
}
__device__ __forceinline__ void p0_prologue(const Params& p, LAS unsigned char* lds, int gw, int NGW, int wave, int lane) {
    unsigned char* ws = p.ws;
    for (int st = gw / NWAVES; st < DINP / 32; st += NGW / NWAVES) p0_win_strip(p, lds, st, wave, lane);
    {
        const float* gn = p.in[1];
        f32x4 gv[4];
#pragma unroll
        for (int j = 0; j < 4; ++j) gv[j] = ((const f32x4*)gn)[lane + 64 * j];
        for (int m = gw; m < MT; m += 4 * NGW) {
            f32x4 v[4][4]; float s[4], mx[4];
#pragma unroll
            for (int r = 0; r < 4; ++r) {
                const int mr = m + r * NGW; const f32x4* xr = (const f32x4*)(p.in[0] + (size_t)(mr < MT ? mr : m) * DM) + lane;
#pragma unroll
                for (int j = 0; j < 4; ++j) v[r][j] = __builtin_nontemporal_load(xr + 64 * j);
            }
#pragma unroll
            for (int r = 0; r < 4; ++r) {
                float a = 0.f, b = 0.f;
#pragma unroll
                for (int j = 0; j < 4; ++j) {
                    a += (v[r][j][0] * v[r][j][0] + v[r][j][1] * v[r][j][1]) + (v[r][j][2] * v[r][j][2] + v[r][j][3] * v[r][j][3]);
                    v[r][j] = v[r][j] * gv[j];
                    b = fmaxf(fmaxf(b, fmaxf(fabsf(v[r][j][0]), fabsf(v[r][j][1]))), fmaxf(fabsf(v[r][j][2]), fabsf(v[r][j][3])));
                }
                s[r] = a; mx[r] = b;
            }
#pragma unroll
            for (int o = 1; o < 64; o <<= 1) {
#pragma unroll
                for (int r = 0; r < 4; ++r) { s[r] += __shfl_xor(s[r], o); mx[r] = fmaxf(mx[r], __shfl_xor(mx[r], o)); }
            }
#pragma unroll
            for (int r = 0; r < 4; ++r) {
                const int mr = m + r * NGW;
                if (mr < MT) {
                    const float rstd = 1.0f / sqrtf(s[r] * (1.f / DM) + EPS);
                    const float iv = mx[r] > 0.f ? 127.f / mx[r] : 0.f;
                    unsigned* o8 = (unsigned*)(ws + WS_XQ + (size_t)mr * DM) + lane;
#pragma unroll
                    for (int j = 0; j < 4; ++j) o8[64 * j] = q8x4(v[r][j][0] * iv, v[r][j][1] * iv, v[r][j][2] * iv, v[r][j][3] * iv);
                    if (lane == 0) ((float*)(ws + WS_SROW))[mr] = mx[r] * rstd * (1.0f / 127.f);
                }
            }
        }
    }
    const int gt = gw * 64 + lane, NGT = NGW * 64;
    for (int i = gt; i < SEQ * 8; i += NGT) {
        const int pos = i >> 3, f = i & 7; float s, c; sincos_acc((float)pos * p.invf[f], s, c);
        ((f32x2*)(ws + WS_ROPE))[i] = (f32x2){c, s};
    }
    for (int i = gt; i < 512; i += NGT) {
        const float a = p.in[12][i], c = p.in[12][512 + i]; const float m = fmaxf(a, c); const float ea = expf(a - m), ec = expf(c - m);
        ((float*)(ws + WS_LB))[i] = ea / (ea + ec);
    }
    for (int i = gt; i < 2048; i += NGT) { ((u16*)(ws + WS_PEK))[i] = f2h(p.in[5][i]); ((u16*)(ws + WS_PEV))[i] = f2h(p.in[8][i]); }
}

#define XB_TMO      128
#define XB_XCNT(j)  (256  + 64 * (j))
#define XB_XSUB(j)  (1280 + 64 * (j))
#define XB_XGEN(j)  (2304 + 64 * (j))
#define XB_TOP      3328
#define XB_TOPGEN   3392
#define XCD_BAR_WORDS 3456
#define XB_SPIN_CAP (1u << 18)

__device__ __forceinline__ unsigned xb_ld(unsigned* p)              { return __hip_atomic_load(p, __ATOMIC_RELAXED, __HIP_MEMORY_SCOPE_AGENT); }
__device__ __forceinline__ unsigned xb_add(unsigned* p, unsigned v) { return __hip_atomic_fetch_add(p, v, __ATOMIC_RELAXED, __HIP_MEMORY_SCOPE_AGENT); }
__device__ __forceinline__ unsigned xb_xcc_id() { return (unsigned)__builtin_amdgcn_s_getreg((3 << 11) | 20) & 0xFu; }
#define XB_SPIN(cond, bar) do { unsigned _sp = 0; while (cond) { __builtin_amdgcn_s_sleep(1); \
    if ((++_sp & 255u) == 0u) { if (xb_ld(&(bar)[XB_TMO])) break; if (_sp > XB_SPIN_CAP) { atomicAdd(&(bar)[XB_TMO], 1u); break; } } } } while (0)

struct XcdBarrier {
    unsigned* bar; unsigned x;
    volatile LAS unsigned* st;
};

__device__ __forceinline__ XcdBarrier xcd_barrier_post(unsigned* bar, volatile LAS unsigned* st) {
    XcdBarrier b; b.bar = bar; b.x = xb_xcc_id(); b.st = st;
    if (threadIdx.x == 0) (void)xb_add(&bar[XB_XCNT(b.x)], 1u);
    return b;
}
__device__ __forceinline__ void xcd_barrier_complete(unsigned* bar, unsigned x, unsigned& nloc, unsigned& nx) {
    const unsigned G = gridDim.x * gridDim.y * gridDim.z;
    unsigned sum, cnt, mine, sp = 0u;
    for (;;) {
        sum = 0u; cnt = 0u; mine = 0u;
#pragma unroll
        for (unsigned j = 0; j < 16; ++j) { const unsigned c = xb_ld(&bar[XB_XCNT(j)]); sum += c; cnt += (c > 0u) ? 1u : 0u; mine = (j == x) ? c : mine; }
        if (sum == G) break;
        __builtin_amdgcn_s_sleep(1);
        if ((++sp & 255u) == 0u) { if (xb_ld(&bar[XB_TMO])) break; if (sp > XB_SPIN_CAP) { atomicAdd(&bar[XB_TMO], 1u); break; } }
    }
    nloc = mine > 0u ? mine : 1u; nx = cnt > 0u ? cnt : 1u;
}

__device__ __forceinline__ void xcd_barrier(const XcdBarrier& b) {
    asm volatile("s_waitcnt vmcnt(0)" ::: "memory");
    __syncthreads();
    if (threadIdx.x == 0) {
        unsigned* bar = b.bar;
        __builtin_amdgcn_s_waitcnt(0);
        unsigned nloc = b.st[0], nx = b.st[1];
        if (nloc == 0u) { xcd_barrier_complete(bar, b.x, nloc, nx); b.st[0] = nloc; b.st[1] = nx; }
        const unsigned old = xb_add(&bar[XB_XSUB(b.x)], 1u);
        const unsigned gen = old / nloc;
        if (old + 1u == (gen + 1u) * nloc) {
            __builtin_amdgcn_fence(__ATOMIC_RELEASE, "agent");
            asm volatile("s_waitcnt vmcnt(0)" ::: "memory");
            const unsigned og = xb_add(&bar[XB_TOP], 1u);
            const unsigned tg = og / nx;
            if (og + 1u == (tg + 1u) * nx) xb_add(&bar[XB_TOPGEN], 1u);
            else XB_SPIN(xb_ld(&bar[XB_TOPGEN]) == tg, bar);
            __builtin_amdgcn_fence(__ATOMIC_ACQUIRE, "agent");
            xb_add(&bar[XB_XGEN(b.x)], 1u);
            asm volatile("s_waitcnt vmcnt(0)" ::: "memory");
        } else {
            XB_SPIN(xb_ld(&bar[XB_XGEN(b.x)]) == gen, bar);
            __builtin_amdgcn_fence(__ATOMIC_ACQUIRE, "agent");
            asm volatile("s_waitcnt vmcnt(0)" ::: "memory");
        }
    }
    __syncthreads();
}

template <int NR, bool WITH_RSTD>
__device__ __forceinline__ void quant_rows(const u16* __restrict__ src, unsigned char* __restrict__ dst, float* __restrict__ fac, int r0, int rstride, int lane) {
    u32x4 v[NR][2];
#pragma unroll
    for (int i = 0; i < NR; ++i) { const u32x4* sp = (const u32x4*)(src + (size_t)(r0 + i * rstride) * 1024 + lane * 16); v[i][0] = sp[0]; v[i][1] = sp[1]; }
#pragma unroll
    for (int i = 0; i < NR; ++i) {
        float f[16];
#pragma unroll
        for (int h = 0; h < 2; ++h)
#pragma unroll
            for (int e = 0; e < 4; ++e) { const unsigned w_ = v[i][h][e]; const h16x2 t = __builtin_bit_cast(h16x2, w_);
                f[8 * h + 2 * e] = (float)t[0]; f[8 * h + 2 * e + 1] = (float)t[1]; }
        float mx = 0.f, ss = 0.f;
#pragma unroll
        for (int e = 0; e < 16; ++e) { mx = fmaxf(mx, fabsf(f[e])); ss += f[e] * f[e]; }
#pragma unroll
        for (int o = 1; o < 64; o <<= 1) { mx = fmaxf(mx, __shfl_xor(mx, o)); if (WITH_RSTD) ss += __shfl_xor(ss, o); }
        const float inv = mx > 0.f ? 127.f / mx : 0.f;
        u32x4 q;
        q.x = q8x4(f[0] * inv, f[1] * inv, f[2] * inv, f[3] * inv); q.y = q8x4(f[4] * inv, f[5] * inv, f[6] * inv, f[7] * inv);
        q.z = q8x4(f[8] * inv, f[9] * inv, f[10] * inv, f[11] * inv); q.w = q8x4(f[12] * inv, f[13] * inv, f[14] * inv, f[15] * inv);
        const int r = r0 + i * rstride;
        *(u32x4*)(dst + (size_t)r * 1024 + lane * 16) = q;
        if (lane == 0) fac[r] = WITH_RSTD ? mx * (1.0f / 127.f) * __builtin_amdgcn_rsqf(ss * (1.0f / DM) + EPS) * 2.8284271247461903f : mx * (1.0f / 127.f);
    }
}
constexpr float LOG2E = 1.4426950408889634f;
constexpr float OFF2 = 4.0f * LOG2E;
constexpr int AT_PITCH = 144;
constexpr int AT_TILE = 64 * AT_PITCH;
constexpr int AT_LDS = 4 * AT_TILE;
#define MFMA32H(a, b, c) __builtin_amdgcn_mfma_f32_32x32x16_f16((a), (b), (c), 0, 0, 0)
#define MFMA16H(a, b, c) __builtin_amdgcn_mfma_f32_16x16x32_f16((a), (b), (c), 0, 0, 0)
#define MFMA32B(a, b, c) __builtin_amdgcn_mfma_f32_32x32x16_bf16((a), (b), (c), 0, 0, 0)

#define AT_BAR() do { asm volatile("s_waitcnt lgkmcnt(0)" ::: "memory"); __builtin_amdgcn_s_barrier(); asm volatile("" ::: "memory"); } while (0)
template <int MODE>
__device__ __forceinline__ void attn_tiles(LAS unsigned char* lds, const u16* __restrict__ Kbg, const u16* __restrict__ VTbg, const h16x8 (&qf)[4], int qt, int j0, int qh, int wave, int lane,
                                           unsigned sw0, unsigned sw1, unsigned sw2, unsigned sw3, f32x16 (&o)[2], float& lsum) {
    const int tid = threadIdx.x, r32 = lane & 31, hi = lane >> 5;
    const int srow = tid >> 3, sch = tid & 7;
    const u16* ksrc = Kbg + (size_t)srow * 64 + 8 * sch;
    const u16* vsrc = VTbg + (size_t)srow * 64 + 8 * sch;
    const int sdst = srow * AT_PITCH + sch * 16;
    const int prow = (r32 & 0x13) | ((r32 & 8) >> 1) | ((r32 & 4) << 1);
    const int koff = prow * AT_PITCH + hi * 16;
    const int voff = r32 * AT_PITCH + hi * 16;
    const int qrel = 32 * qh + r32;
    u32x4 kA = *(const u32x4*)(ksrc + (size_t)j0 * 4096), vA = *(const u32x4*)(vsrc + (size_t)j0 * 4096);
    u32x4 kB = kA, vB = vA;
    if (j0 + 1 <= qt) { kB = *(const u32x4*)(ksrc + (size_t)(j0 + 1) * 4096); vB = *(const u32x4*)(vsrc + (size_t)(j0 + 1) * 4096); }
    *(LAS u32x4*)(lds + sdst) = kA; *(LAS u32x4*)(lds + 2 * AT_TILE + sdst) = vA;
    h16x8 qg0 = qf[0], qg1 = qf[1], qg2 = qf[2], qg3 = qf[3];
    asm volatile("" : "+v"(qg0), "+v"(qg1), "+v"(qg2), "+v"(qg3));
    const u32x4 onesw = {0x3c003c00u, 0x3c003c00u, 0x3c003c00u, 0x3c003c00u};
    f32x16 negoff;
#pragma unroll
    for (int i = 0; i < 16; ++i) negoff[i] = -OFF2;
    asm volatile("" : "+v"(negoff));
    f32x16 ol;
#pragma unroll
    for (int i = 0; i < 16; ++i) ol[i] = 0.f;
    AT_BAR();
    for (int j = j0; j <= qt; ++j) {
        const int buf = (j - j0) & 1;
        if (j + 2 <= qt) { kA = *(const u32x4*)(ksrc + (size_t)(j + 2) * 4096); vA = *(const u32x4*)(vsrc + (size_t)(j + 2) * 4096); }
        LAS unsigned char* kb = lds + buf * AT_TILE; LAS unsigned char* vb = lds + (2 + buf) * AT_TILE;
        bool sel = true;
        if (MODE == 1) { const unsigned w = j < 32 ? sw0 : (j < 64 ? sw1 : (j < 96 ? sw2 : sw3)); sel = (w >> (j & 31)) & 1u; }
        if (MODE == 0 || __any(sel)) {
            h16x8 kf[8];
#pragma unroll
            for (int kh = 0; kh < 2; ++kh)
#pragma unroll
                for (int d0 = 0; d0 < 4; ++d0) kf[kh * 4 + d0] = *(const LAS h16x8*)(kb + kh * 32 * AT_PITCH + koff + d0 * 32);
            __builtin_amdgcn_sched_barrier(0);
            f32x16 s[2];
#pragma unroll
            for (int kh = 0; kh < 2; ++kh) {
#pragma unroll
                for (int d0 = 0; d0 < 4; ++d0) s[kh] = MFMA32H(kf[kh * 4 + d0], (d0 == 0 ? qg0 : d0 == 1 ? qg1 : d0 == 2 ? qg2 : qg3), (d0 == 0 ? negoff : s[kh]));
            }
            h16x8 vfr[8];
#pragma unroll
            for (int dt = 0; dt < 2; ++dt)
#pragma unroll
                for (int kk = 0; kk < 4; ++kk) vfr[dt * 4 + kk] = *(const LAS h16x8*)(vb + dt * 32 * AT_PITCH + voff + kk * 32);
            __builtin_amdgcn_sched_barrier(0);
            const int dj = qt - j;
            const bool edge_hi = (dj == 0), edge_lo = (MODE == 0) && (dj == 8);
            u32x4 pw[2][2];
            if (edge_hi || edge_lo) {
#pragma unroll
                for (int kh = 0; kh < 2; ++kh)
#pragma unroll
                    for (int sp = 0; sp < 2; ++sp) {
                        float pv[8];
#pragma unroll
                        for (int e = 0; e < 8; ++e) {
                            const int kin = 32 * kh + 16 * sp + 8 * hi + e;
                            float pe = __builtin_amdgcn_exp2f(s[kh][8 * sp + e]);
                            if (edge_hi) pe = (kin <= qrel) ? pe : 0.f;
                            if (edge_lo) pe = (kin > qrel) ? pe : 0.f;
                            pv[e] = pe;
                        }
                        pw[kh][sp] = (u32x4){pkh(pv[0], pv[1]), pkh(pv[2], pv[3]), pkh(pv[4], pv[5]), pkh(pv[6], pv[7])};
                    }
            } else {
#pragma unroll
                for (int kh = 0; kh < 2; ++kh)
#pragma unroll
                    for (int sp = 0; sp < 2; ++sp) {
                        float pv[8];
#pragma unroll
                        for (int e = 0; e < 8; ++e) pv[e] = __builtin_amdgcn_exp2f(s[kh][8 * sp + e]);
                        pw[kh][sp] = (u32x4){pkh(pv[0], pv[1]), pkh(pv[2], pv[3]), pkh(pv[4], pv[5]), pkh(pv[6], pv[7])};
                    }
            }
            if (MODE == 1) {
                const unsigned mk = sel ? 0xffffffffu : 0u;
#pragma unroll
                for (int kh = 0; kh < 2; ++kh)
#pragma unroll
                    for (int sp = 0; sp < 2; ++sp) { pw[kh][sp].x &= mk; pw[kh][sp].y &= mk; pw[kh][sp].z &= mk; pw[kh][sp].w &= mk; }
            }
#pragma unroll
            for (int kh = 0; kh < 2; ++kh)
#pragma unroll
                for (int sp = 0; sp < 2; ++sp) {
                    const h16x8 pb = __builtin_bit_cast(h16x8, pw[kh][sp]);
#pragma unroll
                    for (int dt = 0; dt < 2; ++dt) o[dt] = MFMA32H(vfr[dt * 4 + 2 * kh + sp], pb, o[dt]);
                    ol = MFMA32H(__builtin_bit_cast(h16x8, onesw), pb, ol);
                }
        }
        if (j < qt) { *(LAS u32x4*)(lds + (buf ^ 1) * AT_TILE + sdst) = kB; *(LAS u32x4*)(lds + (2 + (buf ^ 1)) * AT_TILE + sdst) = vB; }
        kB = kA; vB = vA;
        AT_BAR();
    }
    lsum = 0.5f * ol[0];
}

__device__ __forceinline__ void win_unit(unsigned char* ws, LAS unsigned char* lds, int u, int wave, int lane) {
    const int qt = u & 127, bg = u >> 7, b = bg >> 1, g = bg & 1;
    const int h = wave >> 1, qh = wave & 1, r32 = lane & 31, hi = lane >> 5;
    const int t = 64 * qt + 32 * qh + r32;
    const size_t row = (size_t)b * SEQ + t;
    const u16* qp = (const u16*)(ws + WS_Q) + row * 512 + (4 * g + h) * 64 + 8 * hi;
    h16x8 qf[4];
#pragma unroll
    for (int d0 = 0; d0 < 4; ++d0) qf[d0] = *(const h16x8*)(qp + 16 * d0);
    f32x16 o[2]; float l = 0.f;
#pragma unroll
    for (int i = 0; i < 16; ++i) { o[0][i] = 0.f; o[1][i] = 0.f; }
    const int j0 = qt > 8 ? qt - 8 : 0;
    attn_tiles<0>(lds, (const u16*)(ws + WS_KW) + (size_t)bg * SEQ * 64, (const u16*)(ws + WS_VWT) + (size_t)bg * 64 * SEQ, qf, qt, j0, qh, wave, lane, 0u, 0u, 0u, 0u, o, l);
    l += __shfl_xor(l, 32);
    const float sc = ((const float*)(ws + WS_GATES))[row * 24 + (4 * g + h) * 3 + 2] / l;
    u16* dst = (u16*)(ws + WS_OWIN) + row * 512 + (4 * g + h) * 64 + 4 * hi;
#pragma unroll
    for (int dt = 0; dt < 2; ++dt)
#pragma unroll
        for (int r4 = 0; r4 < 4; ++r4) {
            u32x2 w; w.x = pkh(o[dt][4 * r4] * sc, o[dt][4 * r4 + 1] * sc); w.y = pkh(o[dt][4 * r4 + 2] * sc, o[dt][4 * r4 + 3] * sc);
            *(u32x2*)(dst + 32 * dt + 8 * r4) = w;
        }
}

constexpr int CM_SP = 132, CM_HP = 136;
__device__ __forceinline__ void cmp_mlp_unit(unsigned char* ws, LAS unsigned char* lds, int u, int wave, int lane) {
    const int mt = u & 31, bg = (u >> 5) & 3, kv = u >> 7;
    const int tid = threadIdx.x, r = lane & 15, quad = lane >> 4;
    LAS float* slab = (LAS float*)lds;
    LAS u16* hb = (LAS u16*)(lds + 8 * 16 * CM_SP * 4);
    const u16* src = (const u16*)(ws + (kv ? WS_VC : WS_KC)) + (size_t)bg * SEQ * 64;
    const u16* pe = (const u16*)(ws + (kv ? WS_PEV : WS_PEK));
    const u16* w1t = (const u16*)(ws + (kv ? WS_CW1V_T : WS_CW1K_T));
    const int n = 16 * mt + r;
    const int nc = n < NCMP ? n : NCMP - 1;
    const u16* arow = src + (size_t)nc * 1024 + 8 * quad;
    const u16* brow = w1t + (size_t)r * 2048 + 8 * quad;
    f32x4 acc[8];
#pragma unroll
    for (int c = 0; c < 8; ++c) acc[c] = (f32x4){0.f, 0.f, 0.f, 0.f};
    const int kbase = 256 * wave;
#pragma unroll 1
    for (int hf = 0; hf < 2; ++hf) {
#pragma unroll
        for (int st = 0; st < 4; ++st) {
            const int k0 = kbase + 32 * (4 * hf + st);
            const h16x8 av = *(const h16x8*)(arow + k0) + *(const h16x8*)(pe + k0 + 8 * quad);
#pragma unroll
            for (int c = 0; c < 8; ++c) { const h16x8 bf = *(const h16x8*)(brow + (size_t)(16 * c) * 2048 + k0); acc[c] = MFMA16H(av, bf, acc[c]); }
        }
    }
#pragma unroll
    for (int c = 0; c < 8; ++c)
#pragma unroll
        for (int i = 0; i < 4; ++i) slab[(wave * 16 + 4 * quad + i) * CM_SP + 16 * c + r] = acc[c][i];
    AT_BAR();
#pragma unroll
    for (int jj = 0; jj < 4; ++jj) {
        const int idx = tid + NTHREADS * jj, row = idx >> 7, col = idx & 127;
        float x = 0.f;
#pragma unroll
        for (int w8 = 0; w8 < 8; ++w8) x += slab[(w8 * 16 + row) * CM_SP + col];
        hb[row * CM_HP + col] = f2h(x * sigmoid_f(x));
    }
    AT_BAR();
    if (wave < 4) {
        const u16* w2t = (const u16*)(ws + (kv ? WS_CW2V_T : WS_CW2K_T)) + (size_t)(16 * wave + r) * 128 + 8 * quad;
        f32x4 oc = {0.f, 0.f, 0.f, 0.f};
#pragma unroll
        for (int ks = 0; ks < 4; ++ks) {
            const h16x8 af = *(const LAS h16x8*)(hb + r * CM_HP + 32 * ks + 8 * quad);
            const h16x8 bf = *(const h16x8*)(w2t + 32 * ks);
            oc = MFMA16H(af, bf, oc);
        }
        const int d = 16 * wave + r, n0 = 16 * mt + 4 * quad;
        if (kv == 0) {
            u16* dst = (u16*)(ws + WS_KCMP) + (size_t)bg * 512 * 64 + d;
#pragma unroll
            for (int i = 0; i < 4; ++i) dst[(size_t)(n0 + i) * 64] = (n0 + i) < NCMP ? f2h(oc[i]) : (u16)0;
        } else {
            u32x2 w; w.x = pkh(oc[0], oc[1]); w.y = pkh(oc[2], (n0 + 3) < NCMP ? oc[3] : 0.f);
            *(u32x2*)((u16*)(ws + WS_VCMPT) + ((size_t)bg * 64 + d) * 512 + n0) = w;
        }
    }
    AT_BAR();
}
constexpr int NS_IMP_P = 132, NS_MAXIT = 288, NS_SLOT = 32 * 144;
constexpr int NS_OFF_IMP = 0, NS_OFF_KC = 67584;
constexpr int NS_OFF_SLOT = 0, NS_OFF_SLOTL = 2 * 8 * NS_SLOT, NS_OFF_OA = NS_OFF_SLOTL + 2048;
constexpr int NS_OFF_BM = 141312, NS_OFF_ITEMS = 142336, NS_OFF_CNT = 145792;
static_assert(2 * 64 * NS_IMP_P * 4 <= NS_OFF_KC && NS_OFF_KC + 512 * 144 <= NS_OFF_BM && NS_OFF_OA + 4 * 512 * 16 <= NS_OFF_BM &&
              NS_OFF_ITEMS + NS_MAXIT * 12 <= NS_OFF_CNT && NS_OFF_CNT + 16 + 1024 <= LDS_BYTES - 256 && AT_LDS <= NS_OFF_BM, "nsa LDS map");
#define NS_BAR() do { asm volatile("s_waitcnt lgkmcnt(0)" ::: "memory"); __builtin_amdgcn_s_barrier(); asm volatile("" ::: "memory"); } while (0)

__device__ __forceinline__ void nsa_unit(unsigned char* ws, LAS unsigned char* lds, int bg, int qt, int wave, int lane) {
    const int tid = threadIdx.x; const int b = bg >> 1, g = bg & 1;
    LAS float* imp = (LAS float*)(lds + NS_OFF_IMP);
    LAS unsigned* bm = (LAS unsigned*)(lds + NS_OFF_BM);
    LAS unsigned char* kcl = lds + NS_OFF_KC;
    LAS unsigned* items = (LAS unsigned*)(lds + NS_OFF_ITEMS);
    LAS unsigned* cnt = (LAS unsigned*)(lds + NS_OFF_CNT);
    const float* gates = (const float*)(ws + WS_GATES);
    for (int i = tid; i < 2 * 64 * NS_IMP_P; i += NTHREADS) imp[i] = 0.f;
    if (tid == 0) cnt[0] = 0u;
    {
        const int amax = 4 * qt + 3;
        int nrows = 32 * ((amax + 31) >> 5); nrows = nrows > 512 ? 512 : nrows;
        const u16* kcg = (const u16*)(ws + WS_KCMP) + (size_t)bg * 512 * 64;
        u32x4 tmp[8];
#pragma unroll
        for (int ii = 0; ii < 8; ++ii) { const int i = tid + NTHREADS * ii; if (i < nrows * 8) tmp[ii] = *(const u32x4*)(kcg + (size_t)i * 8); }
#pragma unroll
        for (int ii = 0; ii < 8; ++ii) { const int i = tid + NTHREADS * ii; if (i < nrows * 8) *(LAS u32x4*)(kcl + (i >> 3) * 144 + (i & 7) * 16) = tmp[ii]; }
    }
    AT_BAR();
    {
        int ln1 = lane; asm volatile("" : "+v"(ln1));
        const int qg = wave & 3, hp = wave >> 2, qi = ln1 & 15, quad = ln1 >> 4;
        const int a = 4 * qt + qg;
        const int nlim = (qi == 15) ? a - 1 : a - 2;
        const int nT = (a + 15) >> 4, nP = (nT + 1) >> 1;
        const int q = 16 * qg + qi; const size_t row = (size_t)b * SEQ + 64 * qt + q;
        const u16* vtg = (const u16*)(ws + WS_VCMPT) + (size_t)bg * 64 * 512;
        const LAS unsigned char* kl = kcl + qi * 144 + quad * 16;
        LAS float* ir = imp + (hp * 64 + q) * NS_IMP_P + quad;
        h16x8 qf2[2][2];
#pragma unroll
        for (int hh = 0; hh < 2; ++hh)
#pragma unroll
            for (int ks = 0; ks < 2; ++ks) qf2[hh][ks] = *(const h16x8*)((const u16*)(ws + WS_Q) + row * 512 + (4 * g + 2 * hp + hh) * 64 + 32 * ks + 8 * quad);
        float m[2] = {-1e30f, -1e30f}, l[2] = {0.f, 0.f};
        for (int P = 0; P < nP; ++P) {
            h16x8 kp[2][2];
#pragma unroll
            for (int tt = 0; tt < 2; ++tt) { kp[tt][0] = *(const LAS h16x8*)(kl + (2 * P + tt) * 16 * 144); kp[tt][1] = *(const LAS h16x8*)(kl + (2 * P + tt) * 16 * 144 + 64); }
            f32x4 sv[2][2];
#pragma unroll
            for (int tt = 0; tt < 2; ++tt)
#pragma unroll
                for (int hh = 0; hh < 2; ++hh) { f32x4 z = {0.f, 0.f, 0.f, 0.f}; z = MFMA16H(kp[tt][0], qf2[hh][0], z); sv[tt][hh] = MFMA16H(kp[tt][1], qf2[hh][1], z); }
#pragma unroll
            for (int hh = 0; hh < 2; ++hh) {
                float mx = m[hh];
#pragma unroll
                for (int tt = 0; tt < 2; ++tt)
#pragma unroll
                    for (int i = 0; i < 4; ++i) mx = (16 * (2 * P + tt) + 4 * quad + i <= nlim) ? fmaxf(mx, sv[tt][hh][i]) : mx;
                float add = 0.f;
#pragma unroll
                for (int tt = 0; tt < 2; ++tt)
#pragma unroll
                    for (int i = 0; i < 4; ++i) add += (16 * (2 * P + tt) + 4 * quad + i <= nlim) ? __builtin_amdgcn_exp2f(sv[tt][hh][i] - mx) : 0.f;
                l[hh] = l[hh] * __builtin_amdgcn_exp2f(m[hh] - mx) + add; m[hh] = mx;
            }
        }
        float mall[2], inv[2];
#pragma unroll
        for (int hh = 0; hh < 2; ++hh) {
            float ma = fmaxf(m[hh], __shfl_xor(m[hh], 16)); ma = fmaxf(ma, __shfl_xor(ma, 32));
            float lw = l[hh] * __builtin_amdgcn_exp2f(m[hh] - ma); lw += __shfl_xor(lw, 16); lw += __shfl_xor(lw, 32);
            mall[hh] = ma; inv[hh] = lw > 0.f ? 1.0f / lw : 0.f;
        }
        f32x4 oc[2][4];
#pragma unroll
        for (int hh = 0; hh < 2; ++hh)
#pragma unroll
            for (int dt = 0; dt < 4; ++dt) oc[hh][dt] = (f32x4){0.f, 0.f, 0.f, 0.f};
        float cwrap = 0.f;
        u32x2 vn[4][2];
#pragma unroll
        for (int dt = 0; dt < 4; ++dt) { const u16* vp = vtg + (size_t)(16 * dt + qi) * 512 + 4 * quad; vn[dt][0] = *(const u32x2*)vp; vn[dt][1] = *(const u32x2*)(vp + 16); }
        for (int P = 0; P < nP; ++P) {
            u32x4 va4[4];
#pragma unroll
            for (int dt = 0; dt < 4; ++dt) va4[dt] = (u32x4){vn[dt][0].x, vn[dt][0].y, vn[dt][1].x, vn[dt][1].y};
            if (P + 1 < nP) {
#pragma unroll
                for (int dt = 0; dt < 4; ++dt) { const u16* vp = vtg + (size_t)(16 * dt + qi) * 512 + 32 * (P + 1) + 4 * quad; vn[dt][0] = *(const u32x2*)vp; vn[dt][1] = *(const u32x2*)(vp + 16); }
            }
            h16x8 kp[2][2];
#pragma unroll
            for (int tt = 0; tt < 2; ++tt) { kp[tt][0] = *(const LAS h16x8*)(kl + (2 * P + tt) * 16 * 144); kp[tt][1] = *(const LAS h16x8*)(kl + (2 * P + tt) * 16 * 144 + 64); }
            f32x4 sv[2][2];
#pragma unroll
            for (int tt = 0; tt < 2; ++tt)
#pragma unroll
                for (int hh = 0; hh < 2; ++hh) { f32x4 z = {0.f, 0.f, 0.f, 0.f}; z = MFMA16H(kp[tt][0], qf2[hh][0], z); sv[tt][hh] = MFMA16H(kp[tt][1], qf2[hh][1], z); }
            u32x4 pw[2];
            float A2[2], C2[2];
#pragma unroll
            for (int tt = 0; tt < 2; ++tt) {
                const int n0 = 16 * (2 * P + tt) + 4 * quad;
                float A = 0.f, C = 0.f;
#pragma unroll
                for (int hh = 0; hh < 2; ++hh) {
                    float pv[4];
#pragma unroll
                    for (int i = 0; i < 4; ++i) pv[i] = (n0 + i <= nlim) ? __builtin_amdgcn_exp2f(sv[tt][hh][i] - mall[hh]) * inv[hh] : 0.f;
                    A += (pv[0] + pv[1]) + (pv[2] + 0.5f * pv[3]); C += 0.5f * pv[3];
                    if (tt == 0) { pw[hh].x = pkh(pv[0], pv[1]); pw[hh].y = pkh(pv[2], pv[3]); } else { pw[hh].z = pkh(pv[0], pv[1]); pw[hh].w = pkh(pv[2], pv[3]); }
                }
                A2[tt] = A; C2[tt] = C;
            }
            const float cup0 = __shfl_up(C2[0], 16), cup1 = __shfl_up(C2[1], 16);
            const float cw0 = __shfl(C2[0], qi + 48), cw1 = __shfl(C2[1], qi + 48);
            ir[4 * (2 * P)] = A2[0] + (quad > 0 ? cup0 : cwrap);
            ir[4 * (2 * P + 1)] = A2[1] + (quad > 0 ? cup1 : cw0);
            cwrap = cw1;
#pragma unroll
            for (int dt = 0; dt < 4; ++dt) {
#pragma unroll
                for (int hh = 0; hh < 2; ++hh) oc[hh][dt] = MFMA16H(__builtin_bit_cast(h16x8, va4[dt]), __builtin_bit_cast(h16x8, pw[hh]), oc[hh][dt]);
            }
        }
        if (quad == 0 && 2 * nP < 32) ir[4 * (2 * nP)] = cwrap;
#pragma unroll
        for (int hh = 0; hh < 2; ++hh) {
            const int h = 2 * hp + hh;
            const float g0 = gates[row * 24 + (4 * g + h) * 3 + 0];
#pragma unroll
            for (int dt = 0; dt < 4; ++dt) {
                u32x2 w; w.x = pkh(oc[hh][dt][0] * g0, oc[hh][dt][1] * g0); w.y = pkh(oc[hh][dt][2] * g0, oc[hh][dt][3] * g0);
                *(u32x2*)((u16*)(ws + WS_Y) + row * DM + (4 * g + h) * 64 + 16 * dt + 4 * quad) = w;
            }
        }
    }
    __syncthreads();
    {
        const int cur = qt, nf = cur == 0 ? 1 : (cur == 1 ? 2 : 3), need = NTOP - nf, jhi = cur - 2;
        int ln2 = lane; asm volatile("" : "+v"(ln2));
        const int j1 = ln2, j2 = ln2 + 64;
        const bool c1 = (j1 >= 1 && j1 <= jhi), c2 = (j2 <= jhi);
        const bool f1 = (j1 == 0) || (j1 == cur) || (j1 == cur - 1), f2 = (j2 == cur) || (j2 == cur - 1);
#pragma unroll 1
        for (int q0 = 0; q0 < 8; q0 += 4) {
            unsigned u1[4], u2[4];
#pragma unroll
            for (int k = 0; k < 4; ++k) {
                const int q = 8 * wave + q0 + k;
                const LAS float* ir0 = imp + q * NS_IMP_P; const LAS float* ir1 = imp + (64 + q) * NS_IMP_P;
                u1[k] = __float_as_uint(ir0[j1] + ir1[j1]); u2[k] = __float_as_uint(ir0[j2] + ir1[j2]);
                u1[k] = c1 ? u1[k] : 0u; u2[k] = c2 ? u2[k] : 0u;
            }
            unsigned pre[4] = {0u, 0u, 0u, 0u};
            if (jhi > need) {
                for (int bit = 30; bit >= 0; --bit) {
#pragma unroll
                    for (int k = 0; k < 4; ++k) {
                        const unsigned tr = pre[k] | (1u << bit);
                        const int cge = __popcll(__ballot(u1[k] >= tr)) + __popcll(__ballot(u2[k] >= tr));
                        pre[k] = cge >= need ? tr : pre[k];
                    }
                }
            }
#pragma unroll
            for (int k = 0; k < 4; ++k) {
                const int q = 8 * wave + q0 + k;
                bool s1 = f1 || c1, s2 = f2 || c2;
                if (jhi > need) {
                    const unsigned long long g1 = __ballot(c1 && u1[k] > pre[k]), g2 = __ballot(c2 && u2[k] > pre[k]);
                    const unsigned long long e1 = __ballot(c1 && u1[k] == pre[k]), e2 = __ballot(c2 && u2[k] == pre[k]);
                    const int rem = need - (__popcll(g1) + __popcll(g2));
                    const int er1 = __builtin_amdgcn_mbcnt_hi((unsigned)(e1 >> 32), __builtin_amdgcn_mbcnt_lo((unsigned)e1, 0u));
                    const int er2 = __popcll(e1) + __builtin_amdgcn_mbcnt_hi((unsigned)(e2 >> 32), __builtin_amdgcn_mbcnt_lo((unsigned)e2, 0u));
                    s1 = f1 || (c1 && (u1[k] > pre[k] || (u1[k] == pre[k] && er1 < rem)));
                    s2 = f2 || (c2 && (u2[k] > pre[k] || (u2[k] == pre[k] && er2 < rem)));
                }
                const unsigned long long m1 = __ballot(s1), m2 = __ballot(s2);
                if (ln2 == 0) { bm[q * 4 + 0] = (unsigned)m1; bm[q * 4 + 1] = (unsigned)(m1 >> 32); bm[q * 4 + 2] = (unsigned)m2; bm[q * 4 + 3] = (unsigned)(m2 >> 32); }
            }
        }
    }
    AT_BAR();
    {
        constexpr int MB_QL = 0, MB_QP = 528, MB_KV = 33792, MB_SLOT = MB_KV + 8 * AT_TILE, MB_SP = 144, MB_SLOTL = MB_SLOT + 8 * 32 * MB_SP, MB_PERM = MB_SLOTL + 1024;
        static_assert(64 * MB_QP <= MB_KV && MB_PERM + 512 <= LDS_BYTES - 256, "mbr LDS map");
        int ln3 = lane, td3 = tid; asm volatile("" : "+v"(ln3), "+v"(td3));
        const int r32 = ln3 & 31, hi = ln3 >> 5, qi = r32 >> 2, h = r32 & 3;
        const int prow = (r32 & 0x13) | ((r32 & 8) >> 1) | ((r32 & 4) << 1);
        const int oq = td3 >> 3, oh = (td3 >> 1) & 3, ohf = td3 & 1;
        LAS unsigned char* ql = lds + MB_QL;
        LAS unsigned char* kvl = lds + MB_KV;
        LAS unsigned char* slots = lds + MB_SLOT;
        LAS float* slotl = (LAS float*)(lds + MB_SLOTL);
        LAS unsigned char* permw = lds + MB_PERM + wave * 64;
        {
            const u16* qsrc = (const u16*)(ws + WS_Q) + ((size_t)b * SEQ + 64 * qt) * 512 + 4 * g * 64;
#pragma unroll
            for (int i = 0; i < 4; ++i) { const int idx = td3 + NTHREADS * i, r = idx >> 5, pc = idx & 31; *(LAS u32x4*)(ql + r * MB_QP + pc * 16) = *(const u32x4*)(qsrc + (size_t)r * 512 + pc * 8); }
        }
        const int srow = td3 >> 3, sch = td3 & 7;
        const u16* ksrc = (const u16*)(ws + WS_KS) + (size_t)bg * SEQ * 64 + (size_t)srow * 64 + 8 * sch;
        const u16* vsrc = (const u16*)(ws + WS_VST) + (size_t)bg * 64 * SEQ + (size_t)srow * 64 + 8 * sch;
        const int sdst = srow * AT_PITCH + sch * 16;
        const int nrnd = (qt + 4) >> 2;
        u32x4 kr[4], vr[4];
#define MB_LOAD(R_) do { _Pragma("unroll") for (int bi = 0; bi < 4; ++bi) { const int jb_ = 4 * (R_) + bi; const int jc_ = jb_ <= qt ? jb_ : qt; \
            kr[bi] = *(const u32x4*)(ksrc + (size_t)jc_ * 4096); vr[bi] = *(const u32x4*)(vsrc + (size_t)jc_ * 4096); } } while (0)
#define MB_STORE() do { _Pragma("unroll") for (int bi = 0; bi < 4; ++bi) { *(LAS u32x4*)(kvl + bi * AT_TILE + sdst) = kr[bi]; *(LAS u32x4*)(kvl + (4 + bi) * AT_TILE + sdst) = vr[bi]; } } while (0)
        MB_LOAD(0);
        const unsigned mybm0 = bm[ln3 * 4 + 0], mybm1 = bm[ln3 * 4 + 1], mybm2 = bm[ln3 * 4 + 2], mybm3 = bm[ln3 * 4 + 3];
        MB_STORE();
        h16x2 oa[16]; float la = 0.f;
#pragma unroll
        for (int e = 0; e < 16; ++e) oa[e] = (h16x2){(h16)0.f, (h16)0.f};
        const u32x4 onesw = {0x3c003c00u, 0x3c003c00u, 0x3c003c00u, 0x3c003c00u};
        const int koff = prow * AT_PITCH + hi * 16, voff = 4 * AT_TILE + r32 * AT_PITCH + hi * 16;
        const unsigned blo = oq >= 32 ? 0xffffffffu : ((1u << oq) - 1u), bhi = oq >= 32 ? ((1u << (oq - 32)) - 1u) : 0u;
        const unsigned obit = 1u << (oq & 31); const bool ohigh = oq >= 32;
        AT_BAR();
        for (int R = 0; R < nrnd; ++R) {
            if (R + 1 < nrnd) MB_LOAD(R + 1);
            unsigned long long mk[4]; int cb[4], base[4]; int NI = 0;
#pragma unroll
            for (int bi = 0; bi < 4; ++bi) {
                const int j = 4 * R + bi;
                const unsigned mw = j < 32 ? mybm0 : (j < 64 ? mybm1 : (j < 96 ? mybm2 : mybm3));
                const bool bit = (j <= qt) && ((mw >> (j & 31)) & 1u);
                mk[bi] = __ballot(bit); cb[bi] = __popcll(mk[bi]); base[bi] = NI; NI += (cb[bi] + 7) >> 3;
            }
            const int nsub = (NI + 7) >> 3;
            for (int sr = 0; sr < nsub; ++sr) {
                const int it = 8 * sr + wave;
                if (it < NI) {
                    int bi = 0;
                    if (it >= base[1]) bi = 1;
                    if (it >= base[2]) bi = 2;
                    if (it >= base[3]) bi = 3;
                    const unsigned long long mkb = bi == 0 ? mk[0] : (bi == 1 ? mk[1] : (bi == 2 ? mk[2] : mk[3]));
                    const int cbb = bi == 0 ? cb[0] : (bi == 1 ? cb[1] : (bi == 2 ? cb[2] : cb[3]));
                    const int sub = it - (bi == 0 ? base[0] : (bi == 1 ? base[1] : (bi == 2 ? base[2] : base[3])));
                    const int j = 4 * R + bi;
                    const unsigned mwj = j < 32 ? mybm0 : (j < 64 ? mybm1 : (j < 96 ? mybm2 : mybm3));
                    const bool bit = (mwj >> (j & 31)) & 1u;
                    const int rank = __builtin_amdgcn_mbcnt_hi((unsigned)(mkb >> 32), __builtin_amdgcn_mbcnt_lo((unsigned)mkb, 0u));
                    if (bit) permw[rank] = (unsigned char)ln3;
                    h16x8 qf[4], kf[8];
#pragma unroll
                    for (int kh = 0; kh < 2; ++kh)
#pragma unroll
                        for (int d0 = 0; d0 < 4; ++d0) kf[kh * 4 + d0] = *(const LAS h16x8*)(kvl + bi * AT_TILE + kh * 32 * AT_PITCH + koff + d0 * 32);
                    const int slotq = 8 * sub + qi;
                    const bool valid = slotq < cbb;
                    const int q = valid ? (int)permw[slotq] : 0;
#pragma unroll
                    for (int d0 = 0; d0 < 4; ++d0) qf[d0] = *(const LAS h16x8*)(ql + q * MB_QP + h * 128 + d0 * 32 + hi * 16);
                    __builtin_amdgcn_sched_barrier(0);
                    f32x16 sx[2];
#pragma unroll
                    for (int kh = 0; kh < 2; ++kh) {
#pragma unroll
                        for (int e = 0; e < 16; ++e) sx[kh][e] = -(OFF2 + 4.0f);
#pragma unroll
                        for (int d0 = 0; d0 < 4; ++d0) sx[kh] = MFMA32H(kf[kh * 4 + d0], qf[d0], sx[kh]);
                    }
                    h16x8 vfr[8];
#pragma unroll
                    for (int dt = 0; dt < 2; ++dt)
#pragma unroll
                        for (int kk = 0; kk < 4; ++kk) vfr[dt * 4 + kk] = *(const LAS h16x8*)(kvl + bi * AT_TILE + voff + dt * 32 * AT_PITCH + kk * 32);
                    __builtin_amdgcn_sched_barrier(0);
                    const bool diag = (j == qt);
                    const unsigned vmk = valid ? 0xffffffffu : 0u;
                    u32x4 pw[4];
#pragma unroll
                    for (int kk = 0; kk < 4; ++kk) {
                        float pv[8];
#pragma unroll
                        for (int e = 0; e < 8; ++e) {
                            float pe = __builtin_amdgcn_exp2f(sx[kk >> 1][8 * (kk & 1) + e]);
                            if (diag) pe = (16 * kk + 8 * hi + e <= q) ? pe : 0.f;
                            pv[e] = pe;
                        }
                        pw[kk] = (u32x4){pkh(pv[0], pv[1]) & vmk, pkh(pv[2], pv[3]) & vmk, pkh(pv[4], pv[5]) & vmk, pkh(pv[6], pv[7]) & vmk};
                    }
                    f32x16 o[2], ol;
#pragma unroll
                    for (int e = 0; e < 16; ++e) { o[0][e] = 0.f; o[1][e] = 0.f; ol[e] = 0.f; }
#pragma unroll
                    for (int kk = 0; kk < 4; ++kk) {
                        const h16x8 pb2 = __builtin_bit_cast(h16x8, pw[kk]);
#pragma unroll
                        for (int dt = 0; dt < 2; ++dt) o[dt] = MFMA32H(vfr[dt * 4 + kk], pb2, o[dt]);
                        ol = MFMA32H(__builtin_bit_cast(h16x8, onesw), pb2, ol);
                    }
                    LAS unsigned char* sp = slots + (wave * 32 + r32) * MB_SP + hi * 8;
#pragma unroll
                    for (int dt = 0; dt < 2; ++dt)
#pragma unroll
                        for (int r4 = 0; r4 < 4; ++r4) { u32x2 w; w.x = pkh(o[dt][4 * r4], o[dt][4 * r4 + 1]); w.y = pkh(o[dt][4 * r4 + 2], o[dt][4 * r4 + 3]); *(LAS u32x2*)(sp + dt * 64 + r4 * 16) = w; }
                    if (hi == 0) slotl[wave * 32 + r32] = ol[0];
                }
                AT_BAR();
                if (sr == nsub - 1 && R + 1 < nrnd) MB_STORE();
#pragma unroll
                for (int bi = 0; bi < 4; ++bi) {
                    const unsigned mlo = (unsigned)mk[bi], mhi = (unsigned)(mk[bi] >> 32);
                    if ((ohigh ? mhi : mlo) & obit) {
                        const int rk = __builtin_popcount(mlo & blo) + __builtin_popcount(mhi & bhi);
                        const int itb = base[bi] + (rk >> 3);
                        if ((itb >> 3) == sr) {
                            const int sl = itb & 7, col = 4 * (rk & 7) + oh;
                            const LAS unsigned char* sp = slots + (sl * 32 + col) * MB_SP + ohf * 64;
#pragma unroll
                            for (int c8 = 0; c8 < 4; ++c8) {
                                const h16x8 v = *(const LAS h16x8*)(sp + c8 * 16);
#pragma unroll
                                for (int e = 0; e < 4; ++e) oa[4 * c8 + e] += (h16x2){v[2 * e], v[2 * e + 1]};
                            }
                            la += slotl[sl * 32 + col];
                        }
                    }
                }
                AT_BAR();
            }
            if (nsub == 0 && R + 1 < nrnd) { MB_STORE(); AT_BAR(); }
        }
#undef MB_LOAD
#undef MB_STORE
        {
            const size_t row = (size_t)b * SEQ + 64 * qt + oq;
            const float g1 = gates[row * 24 + (4 * g + oh) * 3 + 1];
            const float sc = g1 / la;
            const u16* owp = (const u16*)(ws + WS_OWIN) + row * 512 + (4 * g + oh) * 64 + 32 * ohf;
            u16* yp = (u16*)(ws + WS_Y) + row * DM + (4 * g + oh) * 64 + 32 * ohf;
            float ssq = 0.f;
#pragma unroll
            for (int c8 = 0; c8 < 4; ++c8) {
                const h16x8 cw = *(const h16x8*)(yp + 8 * c8), ww = *(const h16x8*)(owp + 8 * c8);
                float y[8];
#pragma unroll
                for (int e = 0; e < 8; ++e) { y[e] = (float)oa[4 * c8 + (e >> 1)][e & 1] * sc + (float)cw[e] + (float)ww[e]; ssq += y[e] * y[e]; }
                const u32x4 w = {pkh(y[0], y[1]), pkh(y[2], y[3]), pkh(y[4], y[5]), pkh(y[6], y[7])};
                *(u32x4*)(yp + 8 * c8) = w;
            }
            ssq += __shfl_xor(ssq, 1); ssq += __shfl_xor(ssq, 2); ssq += __shfl_xor(ssq, 4);
            if ((td3 & 7) == 0) ((float*)(ws + WS_SSQ))[row * 2 + g] = ssq;
        }
    }
    __syncthreads();
}

__device__ __forceinline__ void nsa_finalize_unit(unsigned char* ws, const float* gain, int u, int wave, int lane) {
    const f32x4 g0 = *(const f32x4*)(gain + 8 * lane), g1 = *(const f32x4*)(gain + 8 * lane + 4);
#pragma unroll 1
    for (int i0 = 0; i0 < 16; i0 += 8) {
        f32x2 sq[8]; h16x8 v[8];
#pragma unroll
        for (int i = 0; i < 8; ++i) {
            const size_t row = (size_t)u * 128 + wave * 16 + i0 + i;
            sq[i] = *(const f32x2*)((const float*)(ws + WS_SSQ) + row * 2);
            v[i] = *(const h16x8*)((const u16*)(ws + WS_Y) + row * DM + 8 * lane);
        }
#pragma unroll
        for (int i = 0; i < 8; ++i) {
            const size_t row = (size_t)u * 128 + wave * 16 + i0 + i;
            const float rs = 1.0f / sqrtf((sq[i][0] + sq[i][1]) * (1.0f / 512.f) + EPS);
            u32x4 w;
            w.x = pkh((float)v[i][0] * rs * g0[0], (float)v[i][1] * rs * g0[1]); w.y = pkh((float)v[i][2] * rs * g0[2], (float)v[i][3] * rs * g0[3]);
            w.z = pkh((float)v[i][4] * rs * g1[0], (float)v[i][5] * rs * g1[1]); w.w = pkh((float)v[i][6] * rs * g1[2], (float)v[i][7] * rs * g1[3]);
            *(u32x4*)((u16*)(ws + WS_Y) + row * DM + 8 * lane) = w;
        }
    }
}
constexpr int HG_LFP = 129;
constexpr int HG_OFF_LF = 0, HG_OFF_SEG = 33024, HG_OFF_KT = 35072, HG_OFF_VT = 35072 + 18432;
constexpr int H3_OFF_QT = 35072, H3_OFF_KH = H3_OFF_QT + 17408, H3_OFF_VT = H3_OFF_KH + 17408, H3_OFF_SSQ = H3_OFF_VT + 18432;
static_assert(H3_OFF_SSQ + 256 <= LDS_BYTES, "hgrn LDS map");

__device__ __forceinline__ void hg_load_logf(const unsigned char* ws, LAS float* lf, size_t row0, int h, int tid) {
#pragma unroll
    for (int i = 0; i < 2; ++i) {
        const int idx = tid + NTHREADS * i, s = idx >> 4, ch = idx & 15;
        const h16x8 v = *(const h16x8*)((const u16*)(ws + WS_HLOGF) + (row0 + s) * 512 + h * 128 + 8 * ch);
#pragma unroll
        for (int e = 0; e < 8; ++e) lf[s * HG_LFP + 8 * ch + e] = (float)v[e];
    }
}
__device__ __forceinline__ void hg_stage_vt(const unsigned char* ws, LAS u16* vt, size_t row0, int h, int tid) {
#pragma unroll
    for (int i = 0; i < 2; ++i) {
        const int idx = tid + NTHREADS * i, s = idx & 63, ch = idx >> 6;
        const s16x8 v = *(const s16x8*)((const u16*)(ws + WS_HV) + (row0 + s) * 512 + h * 128 + 8 * ch);
#pragma unroll
        for (int e = 0; e < 8; ++e) vt[(8 * ch + e) * 72 + s] = (u16)v[e];
    }
}

__device__ __forceinline__ void hgrn_h1_units(unsigned char* ws, LAS unsigned char* lds, int u0, int stride, int nu, int wave, int lane) {
    if (u0 >= nu) return;
    const int tid = threadIdx.x, r32 = lane & 31, hi = lane >> 5;
    LAS float* lf = (LAS float*)(lds + HG_OFF_LF);
    LAS float* seg = (LAS float*)(lds + HG_OFF_SEG);
    LAS u16* kt = (LAS u16*)(lds + HG_OFF_KT);
    LAS u16* vt = (LAS u16*)(lds + HG_OFF_VT);
    h16x8 lfr[2]; s16x8 vvr[2];
#define H1_LOAD(uu) do { const int c_ = (uu) & 127, bh_ = (uu) >> 7; const size_t r0_ = (size_t)(bh_ >> 2) * SEQ + 64 * c_; const int h_ = bh_ & 3; \
        _Pragma("unroll") for (int i = 0; i < 2; ++i) { const int idx = tid + NTHREADS * i; \
            lfr[i] = *(const h16x8*)((const u16*)(ws + WS_HLOGF) + (r0_ + (idx >> 4)) * 512 + h_ * 128 + 8 * (idx & 15)); \
            vvr[i] = *(const s16x8*)((const u16*)(ws + WS_HV) + (r0_ + (idx & 63)) * 512 + h_ * 128 + 8 * (idx >> 6)); } } while (0)
    H1_LOAD(u0);
    for (int u = u0; u < nu; u += stride) {
        const int c = u & 127, bh = u >> 7;
#pragma unroll
        for (int i = 0; i < 2; ++i) {
            const int idx = tid + NTHREADS * i;
            { const int s = idx >> 4, ch = idx & 15;
#pragma unroll
              for (int e = 0; e < 8; ++e) lf[s * HG_LFP + 8 * ch + e] = (float)lfr[i][e]; }
            { const int s = idx & 63, ch = idx >> 6;
#pragma unroll
              for (int e = 0; e < 8; ++e) vt[(8 * ch + e) * 72 + s] = (u16)vvr[i][e]; }
        }
        if (u + stride < nu) H1_LOAD(u + stride);
        AT_BAR();
        const int d = tid & 127, sg = tid >> 7;
        float lg[16]; float tot = 0.f;
#pragma unroll
        for (int i = 0; i < 16; ++i) { lg[i] = lf[(16 * sg + i) * HG_LFP + d]; tot += lg[i]; }
        seg[sg * 128 + d] = tot;
        AT_BAR();
        {
            float R = 0.f;
            for (int s2 = sg + 1; s2 < 4; ++s2) R += seg[s2 * 128 + d];
#pragma unroll
            for (int i = 15; i >= 0; --i) {
                const float ke = (1.0f - __expf(lg[i])) * __expf(R);
                kt[d * 72 + 16 * sg + i] = f2b(ke);
                R += lg[i];
            }
            if (sg == 0) ((float*)(ws + WS_HD))[((size_t)bh * 128 + c) * 128 + d] = __expf(R);
        }
        AT_BAR();
        {
            const int vtile = wave & 3;
            s16x8 bfr[4];
#pragma unroll
            for (int ks = 0; ks < 4; ++ks) bfr[ks] = *(const LAS s16x8*)(vt + (32 * vtile + r32) * 72 + 16 * ks + 8 * hi);
            u16* dst = (u16*)(ws + WS_HL) + (((size_t)bh * 128 + c) * 128 + 32 * vtile + r32) * 128;
#pragma unroll
            for (int dd = 0; dd < 2; ++dd) {
                const int dtile = 2 * (wave >> 2) + dd;
                f32x16 acc;
#pragma unroll
                for (int i = 0; i < 16; ++i) acc[i] = 0.f;
                s16x8 afr[4];
#pragma unroll
                for (int ks = 0; ks < 4; ++ks) afr[ks] = *(const LAS s16x8*)(kt + (32 * dtile + r32) * 72 + 16 * ks + 8 * hi);
#pragma unroll
                for (int ks = 0; ks < 4; ++ks) acc = MFMA32B(afr[ks], bfr[ks], acc);
#pragma unroll
                for (int r4 = 0; r4 < 4; ++r4) {
                    u32x2 w; w.x = pkb(acc[4 * r4], acc[4 * r4 + 1]); w.y = pkb(acc[4 * r4 + 2], acc[4 * r4 + 3]);
                    *(u32x2*)(dst + 32 * dtile + 8 * r4 + 4 * hi) = w;
                }
            }
        }
        AT_BAR();
    }
#undef H1_LOAD
}

__device__ __forceinline__ void hgrn_h2_unit(unsigned char* ws, int u, int wave, int lane) {
    if (wave >= 2) return;
    const int gt = u * 128 + wave * 64 + lane;
    const int bh = gt >> 12, v = (gt >> 5) & 127, d0 = 4 * (gt & 31);
    const u16* lp = (const u16*)(ws + WS_HL) + ((size_t)bh * 128 * 128 + v) * 128 + d0;
    u16* sp = (u16*)(ws + WS_HS) + ((size_t)bh * 128 * 128 + v) * 128 + d0;
    const float* dp = (const float*)(ws + WS_HD) + (size_t)bh * 128 * 128 + d0;
    float S0 = 0.f, S1 = 0.f, S2 = 0.f, S3 = 0.f;
#pragma unroll 1
    for (int c0 = 0; c0 < 128; c0 += 16) {
        u32x2 lw[16]; f32x4 dv[16];
#pragma unroll
        for (int i = 0; i < 16; ++i) { lw[i] = *(const u32x2*)(lp + (size_t)(c0 + i) * 16384); dv[i] = *(const f32x4*)(dp + (c0 + i) * 128); }
#pragma unroll
        for (int i = 0; i < 16; ++i) {
            u32x2 w; w.x = pkb(S0, S1); w.y = pkb(S2, S3);
            *(u32x2*)(sp + (size_t)(c0 + i) * 16384) = w;
            S0 = dv[i][0] * S0 + __builtin_bit_cast(float, lw[i].x << 16); S1 = dv[i][1] * S1 + __builtin_bit_cast(float, lw[i].x & 0xffff0000u);
            S2 = dv[i][2] * S2 + __builtin_bit_cast(float, lw[i].y << 16); S3 = dv[i][3] * S3 + __builtin_bit_cast(float, lw[i].y & 0xffff0000u);
        }
    }
}

constexpr int H3_OFF_QR = H3_OFF_SSQ + 256;
static_assert(H3_OFF_QR + 64 * 136 * 2 <= LDS_BYTES - 256, "hgrn h3 LDS map");
__device__ __forceinline__ void hgrn_h3_units(unsigned char* ws, LAS unsigned char* lds, const float* ogain, int u0, int stride, int nu, int wave, int lane) {
    if (u0 >= nu) return;
    const int tid = threadIdx.x, r32 = lane & 31, hi = lane >> 5;
    LAS float* lf = (LAS float*)(lds + HG_OFF_LF);
    LAS float* seg = (LAS float*)(lds + HG_OFF_SEG);
    LAS u16* qt = (LAS u16*)(lds + H3_OFF_QT);
    LAS u16* kh = (LAS u16*)(lds + H3_OFF_KH);
    LAS u16* vt = (LAS u16*)(lds + H3_OFF_VT);
    LAS float* ssq = (LAS float*)(lds + H3_OFF_SSQ);
    LAS u16* qr = (LAS u16*)(lds + H3_OFF_QR);
    h16x8 lfr[2]; s16x8 vvr[2], qqr[2];
#define H3_LOAD(uu) do { const int c_ = (uu) & 127, bh_ = (uu) >> 7; const size_t r0_ = (size_t)(bh_ >> 2) * SEQ + 64 * c_; const int h_ = bh_ & 3; \
        _Pragma("unroll") for (int i = 0; i < 2; ++i) { const int idx = tid + NTHREADS * i; \
            lfr[i] = *(const h16x8*)((const u16*)(ws + WS_HLOGF) + (r0_ + (idx >> 4)) * 512 + h_ * 128 + 8 * (idx & 15)); \
            qqr[i] = *(const s16x8*)((const u16*)(ws + WS_HQ) + (r0_ + (idx >> 4)) * 512 + h_ * 128 + 8 * (idx & 15)); \
            vvr[i] = *(const s16x8*)((const u16*)(ws + WS_HV) + (r0_ + (idx & 63)) * 512 + h_ * 128 + 8 * (idx >> 6)); } } while (0)
    H3_LOAD(u0);
    for (int u = u0; u < nu; u += stride) {
        const int c = u & 127, bh = u >> 7, b = bh >> 2, h = bh & 3;
        const size_t row0 = (size_t)b * SEQ + 64 * c;
#pragma unroll
        for (int i = 0; i < 2; ++i) {
            const int idx = tid + NTHREADS * i;
            { const int s = idx >> 4, ch = idx & 15;
#pragma unroll
              for (int e = 0; e < 8; ++e) lf[s * HG_LFP + 8 * ch + e] = (float)lfr[i][e];
              *(LAS s16x8*)(qr + s * 136 + 8 * ch) = qqr[i]; }
            { const int s = idx & 63, ch = idx >> 6;
#pragma unroll
              for (int e = 0; e < 8; ++e) vt[(8 * ch + e) * 72 + s] = (u16)vvr[i][e]; }
        }
        if (tid < 64) ssq[tid] = 0.f;
        if (u + stride < nu) H3_LOAD(u + stride);
        s16x8 sfr[8];
        {
            const u16* sp = (const u16*)(ws + WS_HS) + (((size_t)bh * 128 + c) * 128 + 32 * (wave >> 1) + r32) * 128 + 8 * hi;
#pragma unroll
            for (int ks = 0; ks < 8; ++ks) sfr[ks] = *(const s16x8*)(sp + 16 * ks);
        }
        AT_BAR();
        const int d = tid & 127, sg = tid >> 7;
        float lg[16]; float tot = 0.f;
#pragma unroll
        for (int i = 0; i < 16; ++i) { lg[i] = lf[(16 * sg + i) * HG_LFP + d]; tot += lg[i]; }
        seg[sg * 128 + d] = tot;
        AT_BAR();
        {
            float Bc = 0.f;
            for (int s2 = 0; s2 < sg; ++s2) Bc += seg[s2 * 128 + d];
#pragma unroll
            for (int i = 0; i < 16; ++i) {
                Bc += lg[i];
                const float qv = b2f(qr[(16 * sg + i) * 136 + d]);
                qt[(16 * sg + i) * 136 + d] = f2b(qv * __expf(Bc));
                kh[(16 * sg + i) * 136 + d] = f2b((1.0f - __expf(lg[i])) * __expf(fminf(-Bc, 80.f)));
            }
        }
        AT_BAR();
        {
            const int th = wave & 1, vtile = wave >> 1;
            s16x8 qf[8];
#pragma unroll
            for (int ks = 0; ks < 8; ++ks) qf[ks] = *(const LAS s16x8*)(qt + (32 * th + r32) * 136 + 16 * ks + 8 * hi);
            f32x16 acc;
#pragma unroll
            for (int i = 0; i < 16; ++i) acc[i] = 0.f;
            {
#pragma unroll
                for (int ks = 0; ks < 8; ++ks) acc = MFMA32B(sfr[ks], qf[ks], acc);
            }
            const int prow = (r32 & 0x13) | ((r32 & 8) >> 1) | ((r32 & 4) << 1);
            for (int sh = 0; sh <= th; ++sh) {
                f32x16 x;
#pragma unroll
                for (int i = 0; i < 16; ++i) x[i] = 0.f;
                s16x8 kfr[8], vfr2[2];
#pragma unroll
                for (int ks = 0; ks < 8; ++ks) kfr[ks] = *(const LAS s16x8*)(kh + (32 * sh + prow) * 136 + 16 * ks + 8 * hi);
#pragma unroll
                for (int sp2 = 0; sp2 < 2; ++sp2) vfr2[sp2] = *(const LAS s16x8*)(vt + (32 * vtile + r32) * 72 + 32 * sh + 16 * sp2 + 8 * hi);
#pragma unroll
                for (int ks = 0; ks < 8; ++ks) x = MFMA32B(kfr[ks], qf[ks], x);
                u32x4 pw[2];
#pragma unroll
                for (int sp2 = 0; sp2 < 2; ++sp2) {
                    float xv[8];
#pragma unroll
                    for (int e = 0; e < 8; ++e) { const int sin_ = 16 * sp2 + 8 * hi + e; const bool ok = (sh < th) || (sin_ <= r32); xv[e] = ok ? x[8 * sp2 + e] : 0.f; }
                    pw[sp2] = (u32x4){pkb(xv[0], xv[1]), pkb(xv[2], xv[3]), pkb(xv[4], xv[5]), pkb(xv[6], xv[7])};
                }
#pragma unroll
                for (int sp2 = 0; sp2 < 2; ++sp2) acc = MFMA32B(vfr2[sp2], __builtin_bit_cast(s16x8, pw[sp2]), acc);
            }
            const int t = 32 * th + r32;
            const u16* gp = (const u16*)(ws + WS_HG) + (row0 + t) * 512 + h * 128 + 32 * vtile + 4 * hi;
            u32x2 gw4[4];
#pragma unroll
            for (int r4 = 0; r4 < 4; ++r4) gw4[r4] = *(const u32x2*)(gp + 8 * r4);
            float sq = 0.f;
#pragma unroll
            for (int i = 0; i < 16; ++i) sq += acc[i] * acc[i];
            sq += __shfl_xor(sq, 32);
            if (hi == 0) (void)__hip_atomic_fetch_add(ssq + t, sq, __ATOMIC_RELAXED, __HIP_MEMORY_SCOPE_WORKGROUP);
            AT_BAR();
            const float rs = 1.0f / sqrtf(ssq[t] * (1.0f / 128.f) + EPS);
            u16* yp = (u16*)(ws + WS_Y) + (row0 + t) * DM + 512 + h * 128 + 32 * vtile + 4 * hi;
            const float* gn = ogain + 32 * vtile + 4 * hi;
#pragma unroll
            for (int r4 = 0; r4 < 4; ++r4) {
                const h16x4 gv = __builtin_bit_cast(h16x4, gw4[r4]);
                const f32x4 gg = *(const f32x4*)(gn + 8 * r4);
                u32x2 w;
                w.x = pkh(acc[4 * r4] * rs * gg[0] * (float)gv[0], acc[4 * r4 + 1] * rs * gg[1] * (float)gv[1]);
                w.y = pkh(acc[4 * r4 + 2] * rs * gg[2] * (float)gv[2], acc[4 * r4 + 3] * rs * gg[3] * (float)gv[3]);
                *(u32x2*)(yp + 8 * r4) = w;
            }
        }
        AT_BAR();
    }
#undef H3_LOAD
}
__global__ void __launch_bounds__(NTHREADS, 2) mk_fwd(Params p) {
    extern __shared__ __attribute__((aligned(16))) unsigned char lds_raw[];
    LAS unsigned char* lds = (LAS unsigned char*)lds_raw;
    const int tid = threadIdx.x, lane = tid & 63, wave = __builtin_amdgcn_readfirstlane(tid >> 6);
    const int G = gridDim.x, bx = blockIdx.x;
    const int vcu = (G % 8 == 0) ? (bx % 8) * (G / 8) + bx / 8 : bx;
    const int gw = vcu * NWAVES + wave, NGW = G * NWAVES;
    unsigned char* ws = p.ws;
#define IN(k) (p.ph_lo <= (k) && (k) < p.ph_hi)
    volatile LAS unsigned* xst = (volatile LAS unsigned*)(lds + LDS_BYTES - 256);
    unsigned* barw = (unsigned*)(ws + WS_CTL);
    XcdBarrier xbar; xbar.bar = barw; xbar.x = 0; xbar.st = xst;
    const bool fused = (p.ph_hi - p.ph_lo) > 1;
    if (fused) {
        if (tid < 2) xst[tid] = 0u;
        __syncthreads();
        xbar = xcd_barrier_post(barw, xst);
    }
#define SEAM(k) do { if (IN(k) && IN((k) + 1)) xcd_barrier(xbar); } while (0)

    if (IN(0)) { p0_prologue(p, lds, gw, NGW, wave, lane); }
    SEAM(0);
    if (IN(1)) {
        pg8::Gemm g{(const u16*)(ws + WS_XQ), (const u16*)(ws + WS_WINQ), MT, DINP, DM / 2}; pg8::StaticOrder S; S.init(MT, DINP, G, bx);
        pg8::EpiInProj E{ws, p.in[3], p.in[4]};
        pg8::gemm_phase<pg8::EpiInProj, pg8::StaticOrder, true, true, 2>(lds, g, S, E, wave);
        const int nfull = (MT / 256) * (DINP / 256) - 3 * G;
        if (nfull < 0 || nfull >= G) p0_late_transposes(p, lds, gw, NGW, wave, lane);
        else if (bx >= nfull) p0_late_transposes(p, lds, (bx - nfull) * NWAVES + wave, (G - nfull) * NWAVES, wave, lane);
    }
    SEAM(1);
    if (IN(2)) {
        constexpr int NU_WIN = 512, NU_CMP = 256, NU_H1 = 1024;
        for (int u = bx; u < NU_WIN + NU_CMP + NU_H1; u += G) {
            if (u < NU_WIN) win_unit(ws, lds, u, wave, lane);
            else if (u < NU_WIN + NU_CMP) cmp_mlp_unit(ws, lds, u - NU_WIN, wave, lane);
            else { hgrn_h1_units(ws, lds, u - NU_WIN - NU_CMP, G, NU_H1, wave, lane); break; }
        }
    }
    SEAM(2);
    if (IN(3)) {
        if (G * 16 != FF) for (int n = gw; n < FF; n += NGW) quant_rows<1, false>((const u16*)(ws + WS_W1_T), ws + WS_W1Q, (float*)(ws + WS_T1COL), n, NGW, lane);
        for (int v = bx; v < 512 + 256; v += G) {
            if (v < 512) {
                int bg, qt;
                if (G == 256) { const int c = v & 255, mem = (c & 1) * 32 + (c >> 3); bg = (c & 7) >> 1; qt = (v < 256) ? mem : 127 - mem; }
                else { const int vv = v & 255; bg = vv >> 6; qt = (v < 256) ? (vv & 63) : 127 - (vv & 63); }
                nsa_unit(ws, lds, bg, qt, wave, lane);
            }
            else {
                if (G * 16 == FF) { if (wave >= 2 && wave < 6) quant_rows<4, false>((const u16*)(ws + WS_W1_T), ws + WS_W1Q, (float*)(ws + WS_T1COL), (v - 512) * 16 + (wave - 2) * 4, 1, lane); }
                hgrn_h2_unit(ws, v - 512, wave, lane);
            }
        }
    }
    SEAM(3);
    if (IN(4)) {
        for (int u = bx; u < 128 + 1024; u += G) {
            if (u < 128) nsa_finalize_unit(ws, p.in[11], u, wave, lane);
            else { hgrn_h3_units(ws, lds, p.in[13], u - 128, G, 1024, wave, lane); break; }
        }
    }
    SEAM(4);
    if (IN(5)) {
        pg8::Gemm g{(const u16*)(ws + WS_Y), (const u16*)(ws + WS_WOUT_T), MT, DM, DM}; pg8::StaticOrder S; S.init(MT, DM, G, bx);
        pg8::EpiOutProj E{p.in[0], (u16*)(ws + WS_X1H)};
        pg8::gemm_phase<pg8::EpiOutProj, pg8::StaticOrder, true, true>(lds, g, S, E, wave);
    }
    SEAM(5);
    if (IN(6)) {
        if (G == 256) quant_rows<8, true>((const u16*)(ws + WS_X1H), ws + WS_X1Q, (float*)(ws + WS_ROWFAC), (8 * (bx & 7) + ((bx >> 3) & 7)) * 256 + (bx >> 6) * 64 + wave * 8, 1, lane);
        else for (int r = gw; r < MT; r += NGW) quant_rows<1, true>((const u16*)(ws + WS_X1H), ws + WS_X1Q, (float*)(ws + WS_ROWFAC), r, NGW, lane);
        if (fused) xcd_barrier(xbar);
        pg8::Gemm g{(const u16*)(ws + WS_X1Q), (const u16*)(ws + WS_W1Q), MT, FF, DM / 2}; pg8::StaticOrder S; S.init(MT, FF, G, bx);
        pg8::EpiUp E{(unsigned char*)(ws + WS_HID), (const float*)(ws + WS_ROWFAC), (const float*)(ws + WS_T1COL)};
        pg8::gemm_phase<pg8::EpiUp, pg8::StaticOrder, true, true, 2>(lds, g, S, E, wave);
    }
    SEAM(6);
    if (IN(7)) {
        pg8::Gemm g{(const u16*)(ws + WS_HID), (const u16*)(ws + WS_W2_T), MT, DM, FF / 2}; pg8::StaticOrder S; S.init(MT, DM, G, bx);
        pg8::EpiDown E{p.out, (const u16*)(ws + WS_X1H)};
        pg8::gemm_phase<pg8::EpiDown, pg8::StaticOrder, true, true, 1>(lds, g, S, E, wave);
    }
#undef IN
#undef SEAM
}
static int g_grid = 0;
extern "C" void kernel_launch(void* const* d_in, const int* in_sizes, int n_in, void* d_out, int out_size, void* d_ws, size_t ws_size, hipStream_t stream) {
    if (g_grid == 0) {
        int dev = 0, cus = 0, per_cu = 0;
        (void)hipGetDevice(&dev); (void)hipDeviceGetAttribute(&cus, hipDeviceAttributeMultiprocessorCount, dev);
        (void)hipFuncSetAttribute((const void*)mk_fwd, hipFuncAttributeMaxDynamicSharedMemorySize, LDS_BYTES);
        if (hipOccupancyMaxActiveBlocksPerMultiprocessor(&per_cu, (const void*)mk_fwd, NTHREADS, LDS_BYTES) != hipSuccess || per_cu < 1) { per_cu = 1; (void)hipGetLastError(); }
        if (cus <= 0) cus = 256;
        g_grid = cus;
    }
    Params P{};
    for (int i = 0; i < 18; ++i) P.in[i] = (const float*)d_in[i];
    P.out = (float*)d_out; P.ws = (unsigned char*)d_ws;
    for (int i = 0; i < 8; ++i) P.invf[i] = (float)pow(500000.0, -(double)(2 * i) / 16.0);
    P.ph_lo = 0; P.ph_hi = 8;
    (void)hipMemsetAsync((char*)d_ws + WS_CTL, 0, XCD_BAR_WORDS * sizeof(unsigned), stream);
    void* args[] = {&P};
    hipError_t e = hipLaunchCooperativeKernel((const void*)mk_fwd, dim3(g_grid), dim3(NTHREADS), args, LDS_BYTES, stream);
    if (e != hipSuccess) fprintf(stderr, "cooperative launch failed: %s (grid %d)\n", hipGetErrorString(e), g_grid);
}
```
